# Optimizing an MI355X kernel written in HIP

```python
import jax
import jax.numpy as jnp
from jax import lax
import numpy as np

D_MODEL = 2048
BATCH = 16
SEQ = 256
DEPTH = 4
DEC_BATCH = 8
DEC_SEQ = 4096
PAST_LEN = 256

GRID_W = 64
HEAD_DIM = 128
A_HEADS = D_MODEL // 4 // HEAD_DIM
A_KV = 2
B_HEADS = D_MODEL // 2 // HEAD_DIM
B_KV = 2
C_CH = D_MODEL // 4
MIX_W = (A_HEADS + B_HEADS) * HEAD_DIM + C_CH
CONV_W = 31
WINDOW = 128
BLOCK = 128
ROPE_BASE = 10000.0
AXIS_PAIRS = HEAD_DIM // 4
D_FF = -(-(8 * D_MODEL) // (3 * 256)) * 256
N_MOD = 6
EPS = 1e-6
A_Q_W = A_HEADS * HEAD_DIM
A_KV_W = A_KV * HEAD_DIM
B_Q_W = B_HEADS * HEAD_DIM
B_KV_W = B_KV * HEAD_DIM
C_IN_W = 2 * C_CH
IN_W = A_Q_W + 2 * A_KV_W + B_Q_W + 2 * B_KV_W + C_IN_W
IN_SPLITS = (A_Q_W,
             A_Q_W + A_KV_W,
             A_Q_W + 2 * A_KV_W,
             A_Q_W + 2 * A_KV_W + B_Q_W,
             A_Q_W + 2 * A_KV_W + B_Q_W + B_KV_W,
             A_Q_W + 2 * A_KV_W + B_Q_W + 2 * B_KV_W)

kernel_name = "hybrid_prefix_diffusion_step"


def rms_norm(x, g):
    xf = x.astype(jnp.float32)
    y = xf * lax.rsqrt(jnp.mean(xf * xf, axis=-1, keepdims=True) + EPS)
    return (y * g.astype(jnp.float32)).astype(x.dtype)


def layer_norm(x, g, b):
    xf = x.astype(jnp.float32)
    mu = jnp.mean(xf, axis=-1, keepdims=True)
    xc = xf - mu
    y = xc * lax.rsqrt(jnp.mean(xc * xc, axis=-1, keepdims=True) + EPS)
    return (y * g.astype(jnp.float32) + b.astype(jnp.float32)).astype(x.dtype)


def modulate(h, shift, scale):
    return h * (1 + scale[:, None, :]) + shift[:, None, :]


def axial_rope(n_tokens):
    rows = n_tokens // GRID_W
    t = jnp.arange(rows * GRID_W)
    row = (t // GRID_W).astype(jnp.float32)
    col = (t % GRID_W).astype(jnp.float32)
    inv = jnp.power(ROPE_BASE, -jnp.arange(AXIS_PAIRS, dtype=jnp.float32) / AXIS_PAIRS)
    ang = jnp.concatenate([row[:, None] * inv, col[:, None] * inv], axis=-1)
    return jnp.cos(ang), jnp.sin(ang)


def apply_rope(x, cos, sin):
    xf = x.astype(jnp.float32)
    x1, x2 = jnp.split(xf, 2, axis=-1)
    c = cos[None, :, None, :]
    s = sin[None, :, None, :]
    return jnp.concatenate([x1 * c - x2 * s, x2 * c + x1 * s], axis=-1).astype(x.dtype)


def sink_softmax(s, sink):
    m = jnp.maximum(jnp.max(s, axis=-1, keepdims=True), sink)
    p = jnp.exp(s - m)
    return p / (jnp.sum(p, axis=-1, keepdims=True) + jnp.exp(sink - m))


def attend_blocks(q, k, v, sink):
    b, t, h, d = q.shape
    kv = k.shape[2]
    g = h // kv
    nb = t // BLOCK
    scale = d ** -0.5
    qb = jnp.moveaxis(q.reshape(b, nb, BLOCK, kv, g, d), 1, 0)

    def one(qblk):
        s = jnp.einsum('bqkgd,bskd->bkgqs', qblk, k, preferred_element_type=jnp.float32) * scale
        if sink is None:
            p = jax.nn.softmax(s, axis=-1)
        else:
            p = sink_softmax(s, sink.astype(jnp.float32).reshape(kv, g)[None, :, :, None, None])
        return jnp.einsum('bkgqs,bskd->bqkgd', p.astype(v.dtype), v)

    out = lax.map(one, qb)
    return jnp.moveaxis(out, 0, 1).reshape(b, t, h, d)


def banded_attention_with_ctx(q, k, v, k_ctx, v_ctx, sink):
    b, t, h, d = q.shape
    kv = k.shape[2]
    g = h // kv
    nb = t // BLOCK
    scale = d ** -0.5
    qb = q.reshape(b, nb, BLOCK, kv, g, d)
    pad = ((0, 0), (BLOCK, BLOCK), (0, 0), (0, 0))
    kp = jnp.pad(k, pad).reshape(b, nb + 2, BLOCK, kv, d)
    vp = jnp.pad(v, pad).reshape(b, nb + 2, BLOCK, kv, d)
    kw = jnp.concatenate([kp[:, :-2], kp[:, 1:-1], kp[:, 2:]], axis=2)
    vw = jnp.concatenate([vp[:, :-2], vp[:, 1:-1], vp[:, 2:]], axis=2)
    s_win = jnp.einsum('bnqkgd,bnskd->bnkgqs', qb, kw, preferred_element_type=jnp.float32) * scale
    qpos = jnp.arange(BLOCK)[:, None]
    kpos = jnp.arange(3 * BLOCK)[None, :] - BLOCK
    kabs = jnp.arange(nb)[:, None, None] * BLOCK + kpos
    valid = (jnp.abs(kpos - qpos) <= WINDOW)[None] & (kabs >= 0) & (kabs < t)
    s_win = jnp.where(valid[None, :, None, None, :, :], s_win, -jnp.inf)
    s_ctx = jnp.einsum('bnqkgd,bskd->bnkgqs', qb, k_ctx, preferred_element_type=jnp.float32) * scale
    s = jnp.concatenate([s_win, s_ctx], axis=-1)
    p = sink_softmax(s, sink.astype(jnp.float32).reshape(kv, g)[None, None, :, :, None, None]).astype(v.dtype)
    p_win = p[..., :3 * BLOCK]
    p_ctx = p[..., 3 * BLOCK:]
    o = (jnp.einsum('bnkgqs,bnskd->bnqkgd', p_win, vw)
         + jnp.einsum('bnkgqs,bskd->bnqkgd', p_ctx, v_ctx))
    return o.reshape(b, t, h, d)


def conformer_conv(cz, conv_w, conv_b, ln_g, ln_b):
    u = cz[..., :C_CH] * jax.nn.sigmoid(cz[..., C_CH:])
    y = lax.conv_general_dilated(u, conv_w[:, None, :].astype(u.dtype), window_strides=(1,),
                                 padding=((CONV_W // 2, CONV_W // 2),),
                                 dimension_numbers=('NWC', 'WIO', 'NWC'),
                                 feature_group_count=C_CH)
    y = y + conv_b
    return jax.nn.silu(layer_norm(y, ln_g, ln_b))


def ada_mod(cvec, w_ada, b_ada):
    return jnp.split(jax.nn.silu(cvec) @ w_ada + b_ada, N_MOD, axis=-1)


def trunk_layer(x, mod, lw, rope=None, ctx_kv=None):
    (w_in, w_out, w_gate, w_up, w_down, g1, g2, qg_a, kg_a, qg_b, kg_b,
     sink, conv_w, conv_b, cln_g, cln_b) = lw
    sh1, sc1, gt1, sh2, sc2, gt2 = mod
    b, t, _ = x.shape
    h = modulate(rms_norm(x, g1), sh1, sc1)
    z = h @ w_in
    qa, ka, va, qb, kb, vb, cz = jnp.split(z, IN_SPLITS, axis=-1)
    qa = rms_norm(qa.reshape(b, t, A_HEADS, HEAD_DIM), qg_a)
    ka = rms_norm(ka.reshape(b, t, A_KV, HEAD_DIM), kg_a)
    va = va.reshape(b, t, A_KV, HEAD_DIM)
    qb = rms_norm(qb.reshape(b, t, B_HEADS, HEAD_DIM), qg_b)
    kb = rms_norm(kb.reshape(b, t, B_KV, HEAD_DIM), kg_b)
    vb = vb.reshape(b, t, B_KV, HEAD_DIM)
    if ctx_kv is None:
        oa = attend_blocks(qa, ka, va, sink)
        ob = attend_blocks(qb, kb, vb, None)
        new_kv = (ka, va, kb, vb)
    else:
        cos, sin = rope
        ka_c, va_c, kb_c, vb_c = ctx_kv
        qa = apply_rope(qa, cos, sin)
        ka = apply_rope(ka, cos, sin)
        qb = apply_rope(qb, cos, sin)
        kb = apply_rope(kb, cos, sin)
        oa = banded_attention_with_ctx(qa, ka, va, ka_c, va_c, sink)
        ob = attend_blocks(qb, jnp.concatenate([kb_c, kb], axis=1),
                           jnp.concatenate([vb_c, vb], axis=1), None)
        new_kv = None
    oc = conformer_conv(cz, conv_w, conv_b, cln_g, cln_b)
    mix = jnp.concatenate([oa.reshape(b, t, A_Q_W), ob.reshape(b, t, B_Q_W), oc], axis=-1)
    x = x + gt1[:, None, :] * (mix @ w_out)
    h2 = modulate(rms_norm(x, g2), sh2, sc2)
    x = x + gt2[:, None, :] * ((jax.nn.silu(h2 @ w_gate) * (h2 @ w_up)) @ w_down)
    return x, new_kv


def setup_inputs(seed: int = 0) -> dict:
    key = jax.random.key(seed)
    ks = jax.random.split(key, 32)
    f = jnp.float32

    def nrm(k, shape, scale):
        return jax.random.normal(k, shape, f) * scale

    def gain(k, shape):
        return 1.0 + 0.02 * jax.random.normal(k, shape, f)

    a_cache = (DEC_BATCH, DEPTH, PAST_LEN, A_KV, HEAD_DIM)
    b_cache = (DEC_BATCH, DEPTH, PAST_LEN, B_KV, HEAD_DIM)
    return {
        "x_prompt": nrm(ks[0], (BATCH, SEQ, D_MODEL), 1.0),
        "x_sample": nrm(ks[1], (DEC_BATCH, DEC_SEQ, D_MODEL), 1.0),
        "cache_a_k": nrm(ks[2], a_cache, 1.0),
        "cache_a_v": nrm(ks[3], a_cache, 1.0),
        "cache_b_k": nrm(ks[4], b_cache, 1.0),
        "cache_b_v": nrm(ks[5], b_cache, 1.0),
        "c": nrm(ks[6], (DEC_BATCH, D_MODEL), 1.0),
        "c_ctx": nrm(ks[7], (D_MODEL,), 1.0),
        "w_ada": nrm(ks[8], (DEPTH, D_MODEL, N_MOD * D_MODEL), 0.5 * D_MODEL ** -0.5),
        "b_ada": nrm(ks[9], (DEPTH, N_MOD * D_MODEL), 0.01),
        "w_in": nrm(ks[10], (DEPTH, D_MODEL, IN_W), D_MODEL ** -0.5),
        "w_out": nrm(ks[11], (DEPTH, MIX_W, D_MODEL), MIX_W ** -0.5),
        "w_gate": nrm(ks[12], (DEPTH, D_MODEL, D_FF), D_MODEL ** -0.5),
        "w_up": nrm(ks[13], (DEPTH, D_MODEL, D_FF), D_MODEL ** -0.5),
        "w_down": nrm(ks[14], (DEPTH, D_FF, D_MODEL), D_FF ** -0.5),
        "norm1_g": gain(ks[15], (DEPTH, D_MODEL)),
        "norm2_g": gain(ks[16], (DEPTH, D_MODEL)),
        "qnorm_a_g": gain(ks[17], (DEPTH, HEAD_DIM)),
        "knorm_a_g": gain(ks[18], (DEPTH, HEAD_DIM)),
        "qnorm_b_g": gain(ks[19], (DEPTH, HEAD_DIM)),
        "knorm_b_g": gain(ks[20], (DEPTH, HEAD_DIM)),
        "sink_a": nrm(ks[21], (DEPTH, A_HEADS), 0.5),
        "conv_w": nrm(ks[22], (DEPTH, CONV_W, C_CH), CONV_W ** -0.5),
        "conv_b": nrm(ks[23], (DEPTH, C_CH), 0.01),
        "conv_ln_g": gain(ks[24], (DEPTH, C_CH)),
        "conv_ln_b": nrm(ks[25], (DEPTH, C_CH), 0.01),
    }


def reference(x_prompt, x_sample, cache_a_k, cache_a_v, cache_b_k, cache_b_v, c, c_ctx,
              w_ada, b_ada, w_in, w_out, w_gate, w_up, w_down, norm1_g, norm2_g,
              qnorm_a_g, knorm_a_g, qnorm_b_g, knorm_b_g, sink_a,
              conv_w, conv_b, conv_ln_g, conv_ln_b):
    rope = axial_rope(x_sample.shape[1])
    y_prompt = x_prompt
    y_sample = x_sample
    ak, av, bk, bv = [], [], [], []
    for l in range(DEPTH):
        lw = (w_in[l], w_out[l], w_gate[l], w_up[l], w_down[l], norm1_g[l], norm2_g[l],
              qnorm_a_g[l], knorm_a_g[l], qnorm_b_g[l], knorm_b_g[l], sink_a[l],
              conv_w[l], conv_b[l], conv_ln_g[l], conv_ln_b[l])
        mod_ctx = ada_mod(c_ctx[None, :], w_ada[l], b_ada[l])
        mod_lat = ada_mod(c, w_ada[l], b_ada[l])
        y_prompt, kv = trunk_layer(y_prompt, mod_ctx, lw)
        ak.append(kv[0])
        av.append(kv[1])
        bk.append(kv[2])
        bv.append(kv[3])
        y_sample, _ = trunk_layer(y_sample, mod_lat, lw, rope,
                                  (cache_a_k[:, l], cache_a_v[:, l], cache_b_k[:, l], cache_b_v[:, l]))
    new_a_k = jnp.stack(ak, axis=1)
    new_a_v = jnp.stack(av, axis=1)
    new_b_k = jnp.stack(bk, axis=1)
    new_b_v = jnp.stack(bv, axis=1)
    return (y_prompt, y_sample, new_a_k, new_a_v, new_b_k, new_b_v)
```

```cpp
#include <hip/hip_runtime.h>
#include <cstdio>
#include <cstdint>
namespace pg8 {
#define PG8_LAS __attribute__((address_space(3)))
typedef unsigned short bf16_t;
typedef short bf16x8 __attribute__((ext_vector_type(8)));
typedef float f32x4 __attribute__((ext_vector_type(4)));
typedef unsigned u32x4 __attribute__((ext_vector_type(4)));
constexpr int BM = 256, BK = 64, HALF = 128, HTB = HALF * BK * 2  , STAGE_BYTES = 8 * HTB, NXCD = 8, WGM = 8;

__host__ __device__ __forceinline__ int lds_byte(int r, int c) { const int st = (r >> 4) * 2 + (c >> 5), rr = r & 15, cc = c & 31, ob = rr * 64 + cc * 2; return st * 1024 + (ob ^ (((ob >> 9) & 1) << 5)); }
__host__ __device__ __forceinline__ void stage_rc(int b, int& R, int& C) { const int st = b / 1024, sb = b % 1024, swz = sb ^ (((sb >> 9) & 1) << 5); R = (st >> 1) * 16 + swz / 64; C = (st & 1) * 32 + (swz % 64) / 2; }
__host__ __device__ __forceinline__ int perm32(int rho) { const int n = rho >> 4, i = rho & 15; return 8 * (i >> 2) + 4 * n + (i & 3); }

struct Unit { int pm, pn; };
struct Gemm { const bf16_t* A; const bf16_t* Bt; int M, N, K; };

struct StaticOrder {
    int nM, nN, nwg, G, c;
    __host__ __device__ void init(int M, int N, int G_, int c_) { nM = M / BM; nN = N / BM; nwg = nM * nN; G = G_; c = c_; }
    __host__ __device__ bool next(int i, Unit& u) const {
        const long L = (long)i * G + c; if (L >= nwg) return false;
        int wgid = (int)L; { const int q = nwg / NXCD, r = nwg % NXCD, xcd = wgid % NXCD, off = wgid / NXCD; wgid = (xcd < r ? xcd * (q + 1) : r * (q + 1) + (xcd - r) * q) + off; }
        const int nig = WGM * nN, gid = wgid / nig, fm = gid * WGM, gsz = (nM - fm) < WGM ? (nM - fm) : WGM;
        u.pm = fm + ((wgid % nig) % gsz); u.pn = (wgid % nig) / gsz; return true;
    }
    __device__ __forceinline__ void a_ready(const Unit&) const {}
    __device__ __forceinline__ void done(const Unit&) const {}
};

__device__ __forceinline__ unsigned cvt_pk_bf16(float lo, float hi) { unsigned r; asm volatile("v_cvt_pk_bf16_f32 %0, %1, %2" : "=v"(r) : "v"(lo), "v"(hi)); return r; }
typedef float f32x2 __attribute__((ext_vector_type(2)));
#ifdef EPI_NT
#define EPI_ST16(p, v) __builtin_nontemporal_store((v), (p))
#else
#define EPI_ST16(p, v) (*(p) = (v))
#endif
struct EpiZ {
    static constexpr bool PERM = true, AFTER_DRAIN = false;
    bf16_t* O; int ldc;
    __device__ __forceinline__ void operator()(const f32x4 (&acc)[2][2][4][2], const Unit& u, int wr, int wc, int fr, int fq) const {
        const int row0 = u.pm * BM + wr * 64 + fr, col0 = u.pn * BM + wc * 32 + 8 * fq;
#pragma unroll
        for (int ai = 0; ai < 2; ++ai)
#pragma unroll
            for (int m = 0; m < 4; ++m) { bf16_t* rowp = O + (size_t)(row0 + ai * HALF + m * 16) * ldc + col0;
#pragma unroll
                for (int bj = 0; bj < 2; ++bj) { const f32x4 v0 = acc[ai][bj][m][0], v1 = acc[ai][bj][m][1];
                    u32x4 w; w.x = cvt_pk_bf16(v0[0], v0[1]); w.y = cvt_pk_bf16(v0[2], v0[3]); w.z = cvt_pk_bf16(v1[0], v1[1]); w.w = cvt_pk_bf16(v1[2], v1[3]);
                    EPI_ST16((u32x4*)(rowp + bj * HALF), w); } }
    }
};
__device__ __forceinline__ float silu_mul(float g, float u) { return g * __builtin_amdgcn_rcpf(1.0f + __builtin_amdgcn_exp2f(g * -1.4426950408889634f)) * u; }
struct EpiSwiGLU {
    static constexpr bool PERM = true, AFTER_DRAIN = false;
    bf16_t* O; int ldc;
    __device__ __forceinline__ void operator()(const f32x4 (&acc)[2][2][4][2], const Unit& u, int wr, int wc, int fr, int fq) const {
        const int row0 = u.pm * BM + wr * 64 + fr, col0 = u.pn * HALF + wc * 32 + 8 * fq;
#pragma unroll
        for (int ai = 0; ai < 2; ++ai)
#pragma unroll
            for (int m = 0; m < 4; ++m) { bf16_t* rowp = O + (size_t)(row0 + ai * HALF + m * 16) * ldc + col0;
                const f32x4 g0 = acc[ai][0][m][0], g1 = acc[ai][0][m][1], u0 = acc[ai][1][m][0], u1 = acc[ai][1][m][1];
                u32x4 w; w.x = cvt_pk_bf16(silu_mul(g0[0], u0[0]), silu_mul(g0[1], u0[1])); w.y = cvt_pk_bf16(silu_mul(g0[2], u0[2]), silu_mul(g0[3], u0[3]));
                w.z = cvt_pk_bf16(silu_mul(g1[0], u1[0]), silu_mul(g1[1], u1[1])); w.w = cvt_pk_bf16(silu_mul(g1[2], u1[2]), silu_mul(g1[3], u1[3]));
                EPI_ST16((u32x4*)rowp, w); }
    }
};
template <bool HALFN> struct EpiResid {
    static constexpr bool PERM = false, AFTER_DRAIN = false;
    const float* base_c; const float* base_l; float* out; const float* gate;
    __device__ __forceinline__ void operator()(const f32x4 (&acc)[2][2][4][2], const Unit& u, int wr, int wc, int fr, int fq) const {
        constexpr int NBJ = HALFN ? 1 : 2;
        const int row0 = u.pm * BM + wr * 64 + fr, col0 = u.pn * (HALFN ? HALF : BM) + wc * 32 + 4 * fq;
        const int mb = u.pm < 16 ? 0 : 1 + ((u.pm - 16) >> 4);
        const float* gp = gate + (size_t)mb * 12288 + col0; const float* bp = u.pm < 16 ? base_c : base_l;
        f32x4 gv[NBJ][2];
#pragma unroll
        for (int bj = 0; bj < NBJ; ++bj)
#pragma unroll
            for (int n = 0; n < 2; ++n) gv[bj][n] = *(const f32x4*)(gp + bj * HALF + n * 16);
        constexpr int NB = 4, PER = 2 * NBJ * 2;
        f32x4 bs[2][PER];
#define EPR_LOAD(b_, buf_) do { _Pragma("unroll") for (int g2 = 0; g2 < 2; ++g2) { const int grp = (b_) * 2 + g2, ai = grp >> 2, m = grp & 3; const size_t off = (size_t)(row0 + ai * HALF + m * 16) * 2048 + col0; \
        _Pragma("unroll") for (int bj = 0; bj < NBJ; ++bj) _Pragma("unroll") for (int n = 0; n < 2; ++n) bs[buf_][(g2 * NBJ + bj) * 2 + n] = *(const f32x4*)(bp + off + bj * HALF + n * 16); } } while (0)
#define EPR_STORE(b_, buf_) do { _Pragma("unroll") for (int g2 = 0; g2 < 2; ++g2) { const int grp = (b_) * 2 + g2, ai = grp >> 2, m = grp & 3; const size_t off = (size_t)(row0 + ai * HALF + m * 16) * 2048 + col0; \
        _Pragma("unroll") for (int bj = 0; bj < NBJ; ++bj) _Pragma("unroll") for (int n = 0; n < 2; ++n) *(f32x4*)(out + off + bj * HALF + n * 16) = bs[buf_][(g2 * NBJ + bj) * 2 + n] + gv[bj][n] * acc[ai][bj][m][n]; } } while (0)
        EPR_LOAD(0, 0);
        EPR_LOAD(1, 1); EPR_STORE(0, 0);
        EPR_LOAD(2, 0); EPR_STORE(1, 1);
        EPR_LOAD(3, 1); EPR_STORE(2, 0);
        EPR_STORE(3, 1);
        static_assert(NB == 4, "pipeline written out for 4 batches");
#undef EPR_LOAD
#undef EPR_STORE
    }
};
struct HeadOrder : StaticOrder {
    int Lmax;
    __host__ __device__ bool next(int i, Unit& u) const { const long L = (long)i * G + c; if (L >= Lmax) return false; return StaticOrder::next(i, u); }
};
struct TailHalfOrder : StaticOrder {
    int Lmin;
    __host__ __device__ bool next(int i, Unit& u) const {
        const int nrem = nwg - Lmin; const long idx = (long)i * G + c; if (idx >= 2L * nrem) return false;
        const int L = Lmin + (int)(idx % nrem), half = (int)(idx / nrem);
        StaticOrder t = *this; t.G = 1; t.c = 0; Unit f; t.StaticOrder::next(L, f);
        u.pm = f.pm; u.pn = 2 * f.pn + half; return true;
    }
};

struct EpiResidB {
    static constexpr bool PERM = true, AFTER_DRAIN = false;
    const float* basef_c; const float* basef_l; const bf16_t* baseb; bf16_t* outb; float* outf; const float* gate; int mode;
    template <bool BF32, bool OF32> __device__ __forceinline__ void run(const f32x4 (&acc)[2][2][4][2], const Unit& u, int wr, int wc, int fr, int fq) const {
        const int row0 = u.pm * BM + wr * 64 + fr, col0 = u.pn * BM + wc * 32 + 8 * fq;
        const int mb = u.pm < 16 ? 0 : 1 + ((u.pm - 16) >> 4);
        const float* gp = gate + (size_t)mb * 12288 + col0; const float* bp = u.pm < 16 ? basef_c : basef_l;
        f32x4 gv[2][2];
#pragma unroll
        for (int bj = 0; bj < 2; ++bj)
#pragma unroll
            for (int n = 0; n < 2; ++n) gv[bj][n] = *(const f32x4*)(gp + bj * HALF + 4 * n);
        constexpr int NV = BF32 ? 8 : 4;
        u32x4 raw[2][NV];
#define EPB_LOAD(b_, buf_) do { _Pragma("unroll") for (int g2 = 0; g2 < 2; ++g2) { const int grp = (b_) * 2 + g2, ai = grp >> 2, m = grp & 3; const size_t off = (size_t)(row0 + ai * HALF + m * 16) * 2048 + col0; \
        _Pragma("unroll") for (int bj = 0; bj < 2; ++bj) { if constexpr (BF32) { raw[buf_][(g2 * 2 + bj) * 2] = *(const u32x4*)(bp + off + bj * HALF); raw[buf_][(g2 * 2 + bj) * 2 + 1] = *(const u32x4*)(bp + off + bj * HALF + 4); } \
                                                         else raw[buf_][g2 * 2 + bj] = *(const u32x4*)(baseb + off + bj * HALF); } } } while (0)
#define EPB_STORE(b_, buf_) do { _Pragma("unroll") for (int g2 = 0; g2 < 2; ++g2) { const int grp = (b_) * 2 + g2, ai = grp >> 2, m = grp & 3; const size_t off = (size_t)(row0 + ai * HALF + m * 16) * 2048 + col0; \
        _Pragma("unroll") for (int bj = 0; bj < 2; ++bj) { f32x4 b0, b1; \
            if constexpr (BF32) { b0 = __builtin_bit_cast(f32x4, raw[buf_][(g2 * 2 + bj) * 2]); b1 = __builtin_bit_cast(f32x4, raw[buf_][(g2 * 2 + bj) * 2 + 1]); } \
            else { const u32x4 w_ = raw[buf_][g2 * 2 + bj]; b0 = (f32x4){__uint_as_float(w_.x << 16), __uint_as_float(w_.x & 0xffff0000u), __uint_as_float(w_.y << 16), __uint_as_float(w_.y & 0xffff0000u)}; \
                   b1 = (f32x4){__uint_as_float(w_.z << 16), __uint_as_float(w_.z & 0xffff0000u), __uint_as_float(w_.w << 16), __uint_as_float(w_.w & 0xffff0000u)}; } \
            const f32x4 r0 = b0 + gv[bj][0] * acc[ai][bj][m][0], r1 = b1 + gv[bj][1] * acc[ai][bj][m][1]; \
            if constexpr (OF32) { *(f32x4*)(outf + off + bj * HALF) = r0; *(f32x4*)(outf + off + bj * HALF + 4) = r1; } \
            else { u32x4 o_; o_.x = cvt_pk_bf16(r0[0], r0[1]); o_.y = cvt_pk_bf16(r0[2], r0[3]); o_.z = cvt_pk_bf16(r1[0], r1[1]); o_.w = cvt_pk_bf16(r1[2], r1[3]); EPI_ST16((u32x4*)(outb + off + bj * HALF), o_); } } } } while (0)
        EPB_LOAD(0, 0);
        EPB_LOAD(1, 1); EPB_STORE(0, 0);
        EPB_LOAD(2, 0); EPB_STORE(1, 1);
        EPB_LOAD(3, 1); EPB_STORE(2, 0);
        EPB_STORE(3, 1);
#undef EPB_LOAD
#undef EPB_STORE
    }
    __device__ __forceinline__ void operator()(const f32x4 (&acc)[2][2][4][2], const Unit& u, int wr, int wc, int fr, int fq) const {
        if (mode == 0) run<true, false>(acc, u, wr, wc, fr, fq); else if (mode == 1) run<false, false>(acc, u, wr, wc, fr, fq); else run<false, true>(acc, u, wr, wc, fr, fq);
    }
};

template <int NM, int NN, int GM = WGM> struct StaticOrderC {
    static_assert(NM % GM == 0, "row tiles in whole groups");
    int G, c;
    __host__ __device__ void init(int G_, int c_) { G = G_; c = c_; }
    __host__ __device__ bool next(int i, Unit& u) const {
        constexpr int nwg = NM * NN, q = nwg / NXCD, r = nwg % NXCD, nig = GM * NN;
        const long L = (long)i * G + c; if (L >= nwg) return false;
        int wgid = (int)L; { const int xcd = wgid % NXCD, off = wgid / NXCD; wgid = (xcd < r ? xcd * (q + 1) : r * (q + 1) + (xcd - r) * q) + off; }
        const int gid = wgid / nig, fm = gid * GM, rem = wgid % nig;
        u.pm = fm + (rem % GM); u.pn = rem / GM; return true;
    }
    __device__ __forceinline__ void a_ready(const Unit&) const {}
    __device__ __forceinline__ void done(const Unit&) const {}
};

struct EpiQKV {
    static constexpr bool PERM = true, AFTER_DRAIN = false;
    bf16_t* Z; float* out; const float* gains; int l; PG8_LAS float* part;
    static constexpr unsigned OFF_AK = 75497472u, OFF_AV = 79691776u, OFF_BK = 83886080u, OFF_BV = 88080384u;
    __device__ __forceinline__ void operator()(const f32x4 (&acc)[2][2][4][2], const Unit& u, int wr, int wc, int fr_in, int fq_in) const {
        int fr = fr_in, fq = fq_in; asm volatile("" : "+v"(fr), "+v"(fq));
        const int pn = u.pn, row0 = u.pm * BM + wr * 64 + fr;
        const bool ctx = u.pm < 16;
        if (pn >= 10) {
#pragma unroll
            for (int ai = 0; ai < 2; ++ai)
#pragma unroll
                for (int m = 0; m < 4; ++m) { bf16_t* rowp = Z + (size_t)(row0 + ai * HALF + m * 16) * 3584 + 2560 + (pn - 10) * HALF + wc * 32 + 8 * fq;
                    const f32x4 a0 = acc[ai][0][m][0], a1 = acc[ai][0][m][1], g0 = acc[ai][1][m][0], g1 = acc[ai][1][m][1];
                    float r[8];
#pragma unroll
                    for (int e = 0; e < 4; ++e) { r[e] = a0[e] * __builtin_amdgcn_rcpf(1.0f + __builtin_amdgcn_exp2f(g0[e] * -1.4426950408889634f)); r[4 + e] = a1[e] * __builtin_amdgcn_rcpf(1.0f + __builtin_amdgcn_exp2f(g1[e] * -1.4426950408889634f)); }
                    u32x4 w; w.x = cvt_pk_bf16(r[0], r[1]); w.y = cvt_pk_bf16(r[2], r[3]); w.z = cvt_pk_bf16(r[4], r[5]); w.w = cvt_pk_bf16(r[6], r[7]);
                    *(u32x4*)rowp = w; }
        } else if (pn == 3 || pn == 9) {
#pragma unroll
            for (int ai = 0; ai < 2; ++ai)
#pragma unroll
                for (int m = 0; m < 4; ++m) { const int R = row0 + ai * HALF + m * 16; bf16_t* rowp = Z + (size_t)R * 3584 + pn * BM + wc * 32 + 8 * fq;
#pragma unroll
                    for (int bj = 0; bj < 2; ++bj) { const f32x4 v0 = acc[ai][bj][m][0], v1 = acc[ai][bj][m][1];
                        u32x4 w; w.x = cvt_pk_bf16(v0[0], v0[1]); w.y = cvt_pk_bf16(v0[2], v0[3]); w.z = cvt_pk_bf16(v1[0], v1[1]); w.w = cvt_pk_bf16(v1[2], v1[3]);
                        *(u32x4*)(rowp + bj * HALF) = w;
                        if (ctx) { const unsigned oo = (pn == 3 ? OFF_AV : OFF_BV) + (unsigned)(((((R >> 8) * 4 + l) * 256 + (R & 255)) * 2 + bj) * 128 + wc * 32 + 8 * fq); float* op = out + oo; *(f32x4*)op = v0; *(f32x4*)(op + 4) = v1; } } }
        } else {
            const bool isK = (pn == 2 || pn == 8);
            const float* g = gains + (pn < 2 ? 0 : pn == 2 ? 128 : pn < 8 ? 256 : 384);
#pragma unroll
            for (int ai = 0; ai < 2; ++ai)
#pragma unroll
                for (int m = 0; m < 4; ++m)
#pragma unroll
                    for (int bj = 0; bj < 2; ++bj) { const f32x4 a = acc[ai][bj][m][0], b = acc[ai][bj][m][1];
                        float s = (a[0] * a[0] + a[1] * a[1]) + (a[2] * a[2] + a[3] * a[3]) + (b[0] * b[0] + b[1] * b[1]) + (b[2] * b[2] + b[3] * b[3]);
                        s += __shfl_xor(s, 16); s += __shfl_xor(s, 32);
                        if (fq == 0) part[((ai * HALF + wr * 64 + m * 16 + fr) * 2 + bj) * 4 + wc] = s; }
            __builtin_amdgcn_sched_barrier(0);
            asm volatile("s_waitcnt lgkmcnt(0)" ::: "memory"); __builtin_amdgcn_s_barrier(); asm volatile("" ::: "memory");
            const f32x4 g1 = *(const f32x4*)(g + 16 * wc + 4 * fq), g2 = *(const f32x4*)(g + 64 + 16 * wc + 4 * fq);
            float invr[4];
#pragma unroll
            for (int e = 0; e < 4; ++e) { const int jj = (16 * wc + 4 * fq + e) & 31; invr[e] = __builtin_amdgcn_exp2f(-(float)jj * (13.287712379549449f / 32.0f)) * 0.15915494309189535f; }
#pragma unroll
            for (int ai = 0; ai < 2; ++ai)
#pragma unroll
                for (int m = 0; m < 4; ++m) { const int rl = ai * HALF + wr * 64 + m * 16 + fr, R = u.pm * BM + rl;
                    float cs[4] = {1.f, 1.f, 1.f, 1.f}, sn[4] = {0.f, 0.f, 0.f, 0.f};
                    if (!ctx) { const int t = (R - 4096) & 4095; const float pos = (float)(wc < 2 ? (t >> 6) : (t & 63));
#pragma unroll
                        for (int e = 0; e < 4; ++e) { const float rev = pos * invr[e]; cs[e] = __builtin_amdgcn_cosf(rev); sn[e] = __builtin_amdgcn_sinf(rev); } }
#pragma unroll
                    for (int bj = 0; bj < 2; ++bj) { const f32x4 p = *(const PG8_LAS f32x4*)(part + (rl * 2 + bj) * 4);
                        const float rstd = 1.0f / sqrtf(((p[0] + p[1]) + (p[2] + p[3])) * (1.0f / 128.0f) + 1e-6f);
                        const f32x4 v1 = acc[ai][bj][m][0] * rstd * g1, v2 = acc[ai][bj][m][1] * rstd * g2;
                        if (isK && ctx) { const unsigned oo = (pn == 2 ? OFF_AK : OFF_BK) + (unsigned)(((((R >> 8) * 4 + l) * 256 + (R & 255)) * 2 + bj) * 128 + 16 * wc + 4 * fq); float* op = out + oo; *(f32x4*)op = v1; *(f32x4*)(op + 64) = v2; }
                        float o1[4], o2[4];
#pragma unroll
                        for (int e = 0; e < 4; ++e) { o1[e] = v1[e] * cs[e] - v2[e] * sn[e]; o2[e] = v2[e] * cs[e] + v1[e] * sn[e]; }
                        bf16_t* zp = Z + (size_t)R * 3584 + pn * BM + bj * HALF + 16 * wc + 4 * fq;
                        typedef unsigned u32x2 __attribute__((ext_vector_type(2)));
                        u32x2 q1, q2; q1.x = cvt_pk_bf16(o1[0], o1[1]); q1.y = cvt_pk_bf16(o1[2], o1[3]); q2.x = cvt_pk_bf16(o2[0], o2[1]); q2.y = cvt_pk_bf16(o2[2], o2[3]);
                        *(u32x2*)zp = q1; *(u32x2*)(zp + 64) = q2; }
                    __builtin_amdgcn_sched_barrier(0); }
        }
    }
};

template <class Epi, class Sched, bool ALIGN_EPI = false, bool SP2 = false, bool HALFN = false  >
__device__ __forceinline__ void gemm_phase(PG8_LAS unsigned char* lds, const Gemm g, const Sched& S, const Epi& E, const int wave_u  ) {
    unsigned lz_ = 0u; asm volatile("" : "+v"(lz_)); int lane_l = (int)__builtin_amdgcn_mbcnt_hi(~0u, __builtin_amdgcn_mbcnt_lo(~0u, lz_));
    const int tid = wave_u * 64 + lane_l, wid = __builtin_amdgcn_readfirstlane(tid >> 6), lane = tid & 63, wr = wid >> 2, wc = wid & 3, fr = lane & 15, fq = lane >> 4;
    static_assert(!HALFN || SP2, "HALFN is written for the SP2 loop only");
    const int K = g.K, nt = K / BK;
    unsigned voffA[2], voffB[2];
#pragma unroll
    for (int i = 0; i < 2; ++i) { int R, C; stage_rc(tid * 16 + i * 8192, R, C); const int Rb = Epi::PERM ? ((R & ~31) + perm32(R & 31)) : R;
        voffA[i] = (unsigned)(R * K + C) * 2u; voffB[i] = (unsigned)(Rb * K + C) * 2u; }
    const size_t kstep = (size_t)(BK * 2);
    const size_t hstep = (size_t)HALF * K * 2;
    const size_t tstep = 2 * hstep;
    const unsigned ldsw = (unsigned)wid * 1024u;
    const int aoff = lds_byte(wr * 64 + fr, fq * 8), boff = lds_byte(wc * 32 + fr, fq * 8);
#define PG8_SA(b, h) (((b) * 2 + (h)) * HTB)
#define PG8_SB(b, h) ((4 + (b) * 2 + (h)) * HTB)
#define PG8_STAGE(bufoff, gbase, voff) do { _Pragma("unroll") for (int _i = 0; _i < 2; ++_i) \
        __builtin_amdgcn_global_load_lds((const unsigned*)((const char*)(gbase) + (voff)[_i]), (PG8_LAS unsigned*)(lds + (bufoff) + ldsw + _i * 8192), 16, 0, 0); } while (0)
#define PG8_LDA(dst, b, h) do { _Pragma("unroll") for (int m = 0; m < 4; ++m) _Pragma("unroll") for (int k = 0; k < 2; ++k) dst[m][k] = *(const PG8_LAS bf16x8*)(lds + PG8_SA(b, h) + aoff + m * 2048 + k * 1024); } while (0)
#define PG8_LDB(dst, b, h) do { _Pragma("unroll") for (int n = 0; n < 2; ++n) _Pragma("unroll") for (int k = 0; k < 2; ++k) dst[n][k] = *(const PG8_LAS bf16x8*)(lds + PG8_SB(b, h) + boff + n * 2048 + k * 1024); } while (0)
#define PG8_MMA(ai, bj, At, Bt) do { __builtin_amdgcn_s_setprio(1); _Pragma("unroll") for (int m = 0; m < 4; ++m) _Pragma("unroll") for (int n = 0; n < 2; ++n) _Pragma("unroll") for (int k = 0; k < 2; ++k) \
        acc[ai][bj][m][n] = __builtin_amdgcn_mfma_f32_16x16x32_bf16(Bt[n][k], At[m][k], acc[ai][bj][m][n], 0, 0, 0); __builtin_amdgcn_s_setprio(0); } while (0)
#define PG8_WAIT_V(n) asm volatile("s_waitcnt vmcnt(" #n ")" ::: "memory")
#define PG8_WAIT_L(n) asm volatile("s_waitcnt lgkmcnt(" #n ")" ::: "memory")
#define PG8_BAR __builtin_amdgcn_s_barrier()
#define PG8_SCHED __builtin_amdgcn_sched_barrier(0)
    Unit cur, nxt; int ui = 0;
    if (!S.next(0, cur)) return;
    f32x4 acc[2][2][4][2];
#pragma unroll
    for (int a = 0; a < 2; ++a)
#pragma unroll
        for (int b = 0; b < 2; ++b)
#pragma unroll
            for (int m = 0; m < 4; ++m)
#pragma unroll
                for (int n = 0; n < 2; ++n) acc[a][b][m][n] = (f32x4){0.f, 0.f, 0.f, 0.f};
    bf16x8 At[4][2], B0[2][2], B1[2][2];
    const char* cA = (const char*)g.A + (size_t)cur.pm * tstep; const char* cB = (const char*)g.Bt + (size_t)cur.pn * (HALFN ? hstep : tstep);
    S.a_ready(cur);
    if constexpr (SP2) {
        PG8_STAGE(PG8_SB(0, 0), cB, voffB); PG8_STAGE(PG8_SB(0, 1), cB + hstep, voffB); PG8_STAGE(PG8_SA(0, 0), cA, voffA); PG8_STAGE(PG8_SA(0, 1), cA + hstep, voffA);
        if (wr == 1) PG8_BAR;
        PG8_WAIT_V(2); PG8_BAR;
        PG8_STAGE(PG8_SB(1, 0), cB + kstep, voffB); PG8_STAGE(PG8_SA(1, 0), cA + kstep, voffA); PG8_STAGE(PG8_SB(1, 1), cB + hstep + kstep, voffB);
        PG8_WAIT_V(6); PG8_BAR;
    } else {
        PG8_STAGE(PG8_SB(0, 0), cB, voffB); PG8_STAGE(PG8_SA(0, 0), cA, voffA); PG8_STAGE(PG8_SB(0, 1), cB + hstep, voffB); PG8_STAGE(PG8_SA(0, 1), cA + hstep, voffA);
        if (wr == 1) PG8_BAR;
        PG8_WAIT_V(4); PG8_BAR;
        PG8_STAGE(PG8_SB(1, 0), cB + kstep, voffB); PG8_STAGE(PG8_SA(1, 0), cA + kstep, voffA); PG8_STAGE(PG8_SB(1, 1), cB + hstep + kstep, voffB);
        PG8_WAIT_V(6); PG8_BAR;
    }
    for (;;) {
        const bool has_next = S.next(ui + 1, nxt);
        const char* nA = has_next ? (const char*)g.A + (size_t)nxt.pm * tstep : cA; const char* nB = has_next ? (const char*)g.Bt + (size_t)nxt.pn * (HALFN ? hstep : tstep) : cB;
        for (int t = 0; t < nt; t += 2) {
            const bool last = (t == nt - 2);
            const char* a1 = cA + (size_t)(t + 1) * kstep;
            const char* a2 = last ? nA : cA + (size_t)(t + 2) * kstep; const char* b2 = last ? nB : cB + (size_t)(t + 2) * kstep;
            const char* a3 = a2 + kstep; const char* b3 = b2 + kstep;
            if (last && has_next) S.a_ready(nxt);
            if constexpr (SP2) {
            PG8_LDB(B0, 0, 0); if constexpr (!HALFN) PG8_LDB(B1, 0, 1); PG8_SCHED; PG8_LDA(At, 0, 0); PG8_STAGE(PG8_SA(1, 1), a1 + hstep, voffA);
            PG8_WAIT_V(8); PG8_WAIT_L(0); PG8_BAR; PG8_MMA(0, 0, At, B0); if constexpr (!HALFN) PG8_MMA(0, 1, At, B1); PG8_BAR; PG8_SCHED;
            PG8_LDA(At, 0, 1); PG8_STAGE(PG8_SB(0, 0), b2, voffB); PG8_STAGE(PG8_SB(0, 1), b2 + hstep, voffB); PG8_STAGE(PG8_SA(0, 0), a2, voffA);
            PG8_WAIT_V(8); PG8_WAIT_L(0); PG8_BAR; PG8_MMA(1, 0, At, B0); if constexpr (!HALFN) PG8_MMA(1, 1, At, B1); PG8_BAR; PG8_SCHED;
            PG8_LDB(B0, 1, 0); if constexpr (!HALFN) PG8_LDB(B1, 1, 1); PG8_SCHED; PG8_LDA(At, 1, 0); PG8_STAGE(PG8_SA(0, 1), a2 + hstep, voffA);
            PG8_WAIT_V(8); PG8_WAIT_L(0); PG8_BAR; PG8_MMA(0, 0, At, B0); if constexpr (!HALFN) PG8_MMA(0, 1, At, B1); PG8_BAR; PG8_SCHED;
            PG8_LDA(At, 1, 1); PG8_STAGE(PG8_SB(1, 0), b3, voffB); PG8_STAGE(PG8_SB(1, 1), b3 + hstep, voffB); PG8_STAGE(PG8_SA(1, 0), a3, voffA);
            PG8_WAIT_V(8); PG8_WAIT_L(0); PG8_BAR; PG8_MMA(1, 0, At, B0); if constexpr (!HALFN) PG8_MMA(1, 1, At, B1); PG8_BAR; PG8_SCHED;
            } else {
            PG8_LDB(B0, 0, 0); PG8_SCHED; PG8_LDA(At, 0, 0); PG8_STAGE(PG8_SA(1, 1), a1 + hstep, voffA);
            PG8_WAIT_L(8); PG8_BAR; PG8_WAIT_L(0); PG8_MMA(0, 0, At, B0); PG8_BAR; PG8_SCHED;
            PG8_LDB(B1, 0, 1); PG8_STAGE(PG8_SB(0, 0), b2, voffB);
            PG8_BAR; PG8_WAIT_L(0); PG8_MMA(0, 1, At, B1); PG8_BAR;
            PG8_LDA(At, 0, 1); PG8_STAGE(PG8_SA(0, 0), a2, voffA);
            PG8_BAR; PG8_WAIT_L(0); PG8_MMA(1, 0, At, B0); PG8_BAR; PG8_SCHED;
            PG8_STAGE(PG8_SB(0, 1), b2 + hstep, voffB);
            PG8_WAIT_V(6); PG8_BAR; PG8_MMA(1, 1, At, B1); PG8_BAR;
            PG8_LDB(B0, 1, 0); PG8_SCHED; PG8_LDA(At, 1, 0); PG8_STAGE(PG8_SA(0, 1), a2 + hstep, voffA);
            PG8_WAIT_L(8); PG8_BAR; PG8_WAIT_L(0); PG8_MMA(0, 0, At, B0); PG8_BAR; PG8_SCHED;
            PG8_LDB(B1, 1, 1); PG8_STAGE(PG8_SB(1, 0), b3, voffB);
            PG8_BAR; PG8_WAIT_L(0); PG8_MMA(0, 1, At, B1); PG8_BAR;
            PG8_LDA(At, 1, 1); PG8_STAGE(PG8_SA(1, 0), a3, voffA);
            PG8_BAR; PG8_WAIT_L(0); PG8_MMA(1, 0, At, B0); PG8_BAR; PG8_SCHED;
            PG8_STAGE(PG8_SB(1, 1), b3 + hstep, voffB);
            PG8_WAIT_V(6); PG8_BAR; PG8_MMA(1, 1, At, B1); PG8_BAR;
            }
        }
        if constexpr (ALIGN_EPI) { if (wr == 0) PG8_BAR; }
        if constexpr (!Epi::AFTER_DRAIN) { E(acc, cur, wr, wc, fr, fq); S.done(cur); }
        if (!has_next) break;
#pragma unroll
        for (int a = 0; a < 2; ++a)
#pragma unroll
            for (int b = 0; b < 2; ++b)
#pragma unroll
                for (int m = 0; m < 4; ++m)
#pragma unroll
                    for (int n = 0; n < 2; ++n) acc[a][b][m][n] = (f32x4){0.f, 0.f, 0.f, 0.f};
        cur = nxt; cA = nA; cB = nB; ++ui;
        if constexpr (ALIGN_EPI) { if (wr == 1) PG8_BAR; }
    }
    PG8_WAIT_V(0);
    if constexpr (!ALIGN_EPI) { if (wr == 0) PG8_BAR; }
    PG8_BAR;
    if constexpr (Epi::AFTER_DRAIN) { E.fused(acc, cur, wr, wc, fr, fq, lds, wid, lane); S.done(cur); }
#undef PG8_SA
#undef PG8_SB
#undef PG8_STAGE
#undef PG8_LDA
#undef PG8_LDB
#undef PG8_MMA
#undef PG8_WAIT_V
#undef PG8_WAIT_L
#undef PG8_BAR
#undef PG8_SCHED
}
}
#define LAS __attribute__((address_space(3)))
#define XB_TMO      128
#define XB_XCNT(j)  (256  + 64 * (j))
#define XB_XSUB(j)  (1280 + 64 * (j))
#define XB_XGEN(j)  (2304 + 64 * (j))
#define XB_TOP      3328
#define XB_TOPGEN   3392
#define XCD_BAR_WORDS 3456
#define XB_SPIN_CAP (1u << 18)

__device__ __forceinline__ unsigned xb_ld(unsigned* p)              { return __hip_atomic_load(p, __ATOMIC_RELAXED, __HIP_MEMORY_SCOPE_AGENT); }
__device__ __forceinline__ unsigned xb_add(unsigned* p, unsigned v) { return __hip_atomic_fetch_add(p, v, __ATOMIC_RELAXED, __HIP_MEMORY_SCOPE_AGENT); }
__device__ __forceinline__ unsigned xb_xcc_id() { return (unsigned)__builtin_amdgcn_s_getreg((3 << 11) | 20) & 0xFu; }
#define XB_SPIN(cond, bar) do { unsigned _sp = 0; while (cond) { __builtin_amdgcn_s_sleep(1); \
    if ((++_sp & 255u) == 0u) { if (xb_ld(&(bar)[XB_TMO])) break; if (_sp > XB_SPIN_CAP) { atomicAdd(&(bar)[XB_TMO], 1u); break; } } } } while (0)

struct XcdBarrier {
    unsigned* bar; unsigned x;
    volatile LAS unsigned* st;
};

__device__ __forceinline__ XcdBarrier xcd_barrier_post(unsigned* bar, volatile LAS unsigned* st) {
    XcdBarrier b; b.bar = bar; b.x = xb_xcc_id(); b.st = st;
    if (threadIdx.x == 0) (void)xb_add(&bar[XB_XCNT(b.x)], 1u);
    return b;
}
__device__ __forceinline__ void xcd_barrier_complete(unsigned* bar, unsigned x, unsigned& nloc, unsigned& nx) {
    const unsigned G = gridDim.x * gridDim.y * gridDim.z;
    unsigned sum, cnt, mine, sp = 0u;
    for (;;) {
        sum = 0u; cnt = 0u; mine = 0u;
#pragma unroll
        for (unsigned j = 0; j < 16; ++j) { const unsigned c = xb_ld(&bar[XB_XCNT(j)]); sum += c; cnt += (c > 0u) ? 1u : 0u; mine = (j == x) ? c : mine; }
        if (sum == G) break;
        __builtin_amdgcn_s_sleep(1);
        if ((++sp & 255u) == 0u) { if (xb_ld(&bar[XB_TMO])) break; if (sp > XB_SPIN_CAP) { atomicAdd(&bar[XB_TMO], 1u); break; } }
    }
    nloc = mine > 0u ? mine : 1u; nx = cnt > 0u ? cnt : 1u;
}

__device__ __forceinline__ void xcd_barrier(const XcdBarrier& b) {
    unsigned* bar_u = b.bar; asm volatile("" : "+s"(bar_u));
    asm volatile("s_waitcnt vmcnt(0)" ::: "memory");
    __syncthreads();
    if (threadIdx.x == 0) {
        unsigned* bar = bar_u; const unsigned bx_ = xb_xcc_id();
        __builtin_amdgcn_s_waitcnt(0);
        unsigned nloc = b.st[0], nx = b.st[1];
        if (nloc == 0u) { xcd_barrier_complete(bar, bx_, nloc, nx); b.st[0] = nloc; b.st[1] = nx; }
        const unsigned old = xb_add(&bar[XB_XSUB(bx_)], 1u);
        const unsigned gen = old / nloc;
        if (old + 1u == (gen + 1u) * nloc) {
            __builtin_amdgcn_fence(__ATOMIC_RELEASE, "agent");
            asm volatile("s_waitcnt vmcnt(0)" ::: "memory");
            const unsigned og = xb_add(&bar[XB_TOP], 1u);
            const unsigned tg = og / nx;
            if (og + 1u == (tg + 1u) * nx) xb_add(&bar[XB_TOPGEN], 1u);
            else XB_SPIN(xb_ld(&bar[XB_TOPGEN]) == tg, bar);
            __builtin_amdgcn_fence(__ATOMIC_ACQUIRE, "agent");
            xb_add(&bar[XB_XGEN(bx_)], 1u);
            asm volatile("s_waitcnt vmcnt(0)" ::: "memory");
        } else {
            XB_SPIN(xb_ld(&bar[XB_XGEN(bx_)]) == gen, bar);
            __builtin_amdgcn_fence(__ATOMIC_ACQUIRE, "agent");
            asm volatile("s_waitcnt vmcnt(0)" ::: "memory");
        }
    }
    __syncthreads();
}
namespace att {
#define ATT_LAS __attribute__((address_space(3)))
#define ATT_GAS __attribute__((address_space(1)))
typedef unsigned short bf16_t;
typedef short bf16x8 __attribute__((ext_vector_type(8)));
typedef short s16x4 __attribute__((ext_vector_type(4)));
typedef float f32x16 __attribute__((ext_vector_type(16)));
typedef unsigned u32x4 __attribute__((ext_vector_type(4)));
constexpr int D = 128, NW = 8, QBLK = 32, KVBLK = 64;
constexpr float SCALE = 0.088388347648318440f, THR = 8.f, LOG2E = 1.4426950408889634f;
constexpr int SHM_V = KVBLK * D * 2, SHM_K = KVBLK * D * 2, SHM_ATTN = 2 * SHM_V + 2 * SHM_K + NW * 64 * 4;
#define KSWZ(row, colB) ((row) * 256 + ((colB) ^ (((row) & 7) << 4)))
#define SBAR() __builtin_amdgcn_sched_barrier(0)
__device__ __forceinline__ int crow(int r, int hi) { return (r & 3) + 8 * (r >> 2) + 4 * hi; }
__device__ __forceinline__ unsigned cvtpk(float lo, float hi) { unsigned r; asm volatile("v_cvt_pk_bf16_f32 %0, %1, %2" : "=v"(r) : "v"(lo), "v"(hi)); return r; }
__device__ __forceinline__ void partialSM(f32x16& p0, f32x16& p1, float& m_reg, float& mn, float& alpha) {
  constexpr float C = SCALE * LOG2E;
  float pmax = p0[0];
#pragma unroll
  for (int r = 1; r < 16; ++r) pmax = fmaxf(pmax, p0[r]);
#pragma unroll
  for (int r = 0; r < 16; ++r) pmax = fmaxf(pmax, p1[r]);
  { auto rr = __builtin_amdgcn_permlane32_swap(__float_as_uint(pmax), __float_as_uint(pmax), false, false);
    pmax = fmaxf(__uint_as_float(rr[0]), __uint_as_float(rr[1])); }
  if (__builtin_expect(__all(pmax - m_reg <= THR / SCALE), 1)) { mn = m_reg; alpha = 1.f; }
  else { mn = fmaxf(m_reg, pmax); alpha = __builtin_amdgcn_exp2f((m_reg - mn) * C); m_reg = mn; }
  const float mnC = -mn * C;
#pragma unroll
  for (int r = 0; r < 16; ++r) p0[r] = fmaf(p0[r], C, mnC);
#pragma unroll
  for (int r = 0; r < 16; ++r) p1[r] = fmaf(p1[r], C, mnC);
#pragma unroll
  for (int r = 0; r < 16; ++r) p0[r] = __builtin_amdgcn_exp2f(p0[r]);
}
__device__ __forceinline__ void finishSM(f32x16& p0, f32x16& p1, float alpha, float& l_reg, bf16x8& pa0, bf16x8& pa1, bf16x8& pa2, bf16x8& pa3) {
#pragma unroll
  for (int r = 0; r < 16; ++r) p1[r] = __builtin_amdgcn_exp2f(p1[r]);
  float ps = 0;
#pragma unroll
  for (int r = 0; r < 16; ++r) ps += p0[r];
#pragma unroll
  for (int r = 0; r < 16; ++r) ps += p1[r];
  { auto rr = __builtin_amdgcn_permlane32_swap(__float_as_uint(ps), __float_as_uint(ps), false, false);
    ps = __uint_as_float(rr[0]) + __uint_as_float(rr[1]); }
  l_reg = l_reg * alpha + ps;
#define PK4(P, BASE, OUT) do { unsigned a0 = cvtpk(P[BASE + 0], P[BASE + 1]), a1 = cvtpk(P[BASE + 2], P[BASE + 3]);   \
    unsigned b0 = cvtpk(P[BASE + 4], P[BASE + 5]), b1 = cvtpk(P[BASE + 6], P[BASE + 7]);                              \
    auto r0 = __builtin_amdgcn_permlane32_swap(a0, b0, false, false); auto r1 = __builtin_amdgcn_permlane32_swap(a1, b1, false, false); \
    u32x4 w = {r0[0], r1[0], r0[1], r1[1]}; OUT = *reinterpret_cast<bf16x8*>(&w); } while (0)
  PK4(p0, 0, pa0); PK4(p0, 8, pa1); PK4(p1, 0, pa2); PK4(p1, 8, pa3);
#undef PK4
}
__device__ __forceinline__ void mask_win(f32x16& p0, f32x16& p1, int dq) {
  const float NEG = -__builtin_inff();
#pragma unroll
  for (int r = 0; r < 16; ++r) { const int c = (r & 3) + 8 * (r >> 2);
    if ((unsigned)(dq - c) >= 257u) p0[r] = NEG;
    if ((unsigned)(dq - c - 32) >= 257u) p1[r] = NEG; }
}
__device__ __forceinline__ void qkt(f32x16& p0, f32x16& p1, const ATT_LAS char* Ks, const bf16x8* qr, int r32, int hi) {
  p0 = f32x16{}; p1 = f32x16{};
  const ATT_LAS char* kb[4];
#pragma unroll
  for (int dd = 0; dd < 4; ++dd) kb[dd] = Ks + KSWZ(r32, (dd * 16 + hi * 8) * 2);
#pragma unroll
  for (int d0 = 0; d0 < 8; ++d0) { const ATT_LAS char* a = kb[d0 & 3] + (d0 >> 2) * 128;
    const bf16x8 b0 = *reinterpret_cast<const ATT_LAS bf16x8*>(a);
    const bf16x8 b1 = *reinterpret_cast<const ATT_LAS bf16x8*>(a + 32 * 256);
    p0 = __builtin_amdgcn_mfma_f32_32x32x16_bf16(b0, qr[d0], p0, 0, 0, 0);
    p1 = __builtin_amdgcn_mfma_f32_32x32x16_bf16(b1, qr[d0], p1, 0, 0, 0); }
}
__device__ __forceinline__ int v_st(int k, int c) { const int kk = (k & ~0xC) | ((k & 4) << 1) | ((k & 8) >> 1); return ((kk >> 3) * 4 + (c >> 5)) * 512 + ((kk & 7) * 32 + (c & 31)) * 2; }
__device__ __forceinline__ int v_rd_base(int lane) { return ((lane & 3) << 3) | (((lane >> 2) & 3) << 6) | (((lane >> 4) & 1) << 5) | (((lane >> 5) & 1) << 8); }
constexpr int v_rd_off(int d0, int ks, int half) { return d0 * 512 + ks * 4096 + half * 2048; }
template <int OFF> __device__ __forceinline__ s16x4 tr_read(int vb) {
  s16x4 r; asm volatile("ds_read_b64_tr_b16 %0, %1 offset:%2" : "=&v"(r) : "v"(vb), "i"(OFF) : "memory"); return r;
}
template <int D0> __device__ __forceinline__ void pv_one(f32x16& od, int vb, bf16x8 pa0, bf16x8 pa1, bf16x8 pa2, bf16x8 pa3) {
  const s16x4 l0 = tr_read<v_rd_off(D0, 0, 0)>(vb), h0 = tr_read<v_rd_off(D0, 0, 1)>(vb), l1 = tr_read<v_rd_off(D0, 1, 0)>(vb), h1 = tr_read<v_rd_off(D0, 1, 1)>(vb);
  const s16x4 l2 = tr_read<v_rd_off(D0, 2, 0)>(vb), h2 = tr_read<v_rd_off(D0, 2, 1)>(vb), l3 = tr_read<v_rd_off(D0, 3, 0)>(vb), h3 = tr_read<v_rd_off(D0, 3, 1)>(vb);
  asm volatile("s_waitcnt lgkmcnt(0)" ::: "memory"); SBAR();
#define PK(L, H) (bf16x8){L[0], L[1], L[2], L[3], H[0], H[1], H[2], H[3]}
  od = __builtin_amdgcn_mfma_f32_32x32x16_bf16(pa0, PK(l0, h0), od, 0, 0, 0);
  od = __builtin_amdgcn_mfma_f32_32x32x16_bf16(pa1, PK(l1, h1), od, 0, 0, 0);
  od = __builtin_amdgcn_mfma_f32_32x32x16_bf16(pa2, PK(l2, h2), od, 0, 0, 0);
  od = __builtin_amdgcn_mfma_f32_32x32x16_bf16(pa3, PK(l3, h3), od, 0, 0, 0);
#undef PK
}
__device__ __forceinline__ void pv_d0(f32x16* o, int vb, bf16x8 pa0, bf16x8 pa1, bf16x8 pa2, bf16x8 pa3) {
  pv_one<0>(o[0], vb, pa0, pa1, pa2, pa3); pv_one<1>(o[1], vb, pa0, pa1, pa2, pa3); pv_one<2>(o[2], vb, pa0, pa1, pa2, pa3); pv_one<3>(o[3], vb, pa0, pa1, pa2, pa3);
}

struct AUnit {
  const bf16_t* Q; const bf16_t* K0; const bf16_t* K1; bf16_t* O;
  int nt0, nt1;
  float sink_l2;
  int mask;
  int qk0;
};
constexpr int LDQ = 3584, LD0 = 256, LD1 = 3584, LDO = 2048, VOFF0 = 2097152, VOFF1 = 256;
__device__ __forceinline__ void attn_unit(const AUnit& u, ATT_LAS char* lds, const int wave_u) {
  unsigned lz_ = 0u; asm volatile("" : "+v"(lz_)); int lane_l = (int)__builtin_amdgcn_mbcnt_hi(~0u, __builtin_amdgcn_mbcnt_lo(~0u, lz_));
  const int tid = wave_u * 64 + lane_l, wid = __builtin_amdgcn_readfirstlane(tid >> 6), lane = tid & 63, r32 = lane & 31, hi = lane >> 5;
  ATT_LAS char* V_lds = lds; ATT_LAS char* K_lds = lds + 2 * SHM_V;
  ATT_LAS float* ws = (ATT_LAS float*)(lds + 2 * SHM_V + 2 * SHM_K) + wid * 64; ATT_LAS float* li_l = ws; ATT_LAS float* al_l = ws + 32;
  float m_reg = -1e30f, l_reg = 0; f32x16 o[4] = {}; bf16x8 qr[8];
  const ATT_GAS bf16_t* Qw = (const ATT_GAS bf16_t*)u.Q + (size_t)(wid * QBLK + r32) * LDQ + hi * 8;
#pragma unroll
  for (int d0 = 0; d0 < 8; ++d0) qr[d0] = *reinterpret_cast<const ATT_GAS bf16x8*>(Qw + d0 * 16);
  const int sr = tid >> 4, sc = (tid & 15) * 8, vst0 = v_st(sr, sc), vst1 = v_st(32 + sr, sc), kws = KSWZ(sr, sc * 2);
  const int vb0 = (int)(unsigned)(__UINTPTR_TYPE__)V_lds + v_rd_base(lane);
  const int nt0 = u.nt0, NT = u.nt0 + u.nt1;
  const int dqb = u.qk0 + wid * QBLK + r32 - 4 * hi + 128;
  struct { bf16x8 vs0, vs1, ks0, ks1; } sr_[2];
  const unsigned offa0 = (unsigned)(sr * LD0 + sc), offb0 = offa0 + 32u * LD0, offa1 = (unsigned)(sr * LD1 + sc), offb1 = offa1 + 32u * LD1;
#define SLOAD(i, t) do { const int t_ = (t); const bool s0_ = t_ < nt0;                                                                          \
    const ATT_GAS bf16_t* kp_ = s0_ ? (const ATT_GAS bf16_t*)u.K0 + (size_t)t_ * (KVBLK * LD0) : (const ATT_GAS bf16_t*)u.K1 + (size_t)(t_ - nt0) * (KVBLK * LD1); \
    const ATT_GAS bf16_t* vp_ = kp_ + (s0_ ? VOFF0 : VOFF1); const unsigned oa_ = s0_ ? offa0 : offa1, ob_ = s0_ ? offb0 : offb1;                \
    sr_[i].vs0 = *reinterpret_cast<const ATT_GAS bf16x8*>(vp_ + oa_); sr_[i].vs1 = *reinterpret_cast<const ATT_GAS bf16x8*>(vp_ + ob_);           \
    sr_[i].ks0 = *reinterpret_cast<const ATT_GAS bf16x8*>(kp_ + oa_); sr_[i].ks1 = *reinterpret_cast<const ATT_GAS bf16x8*>(kp_ + ob_); } while (0)
#define SWRITE(b, i) do { *(ATT_LAS bf16x8*)(V_lds + (b) * SHM_V + vst0) = sr_[i].vs0; *(ATT_LAS bf16x8*)(V_lds + (b) * SHM_V + vst1) = sr_[i].vs1; \
    *(ATT_LAS bf16x8*)(K_lds + (b) * SHM_K + kws) = sr_[i].ks0; *(ATT_LAS bf16x8*)(K_lds + (b) * SHM_K + kws + 32 * 256) = sr_[i].ks1; } while (0)
#define SWAIT() asm volatile("s_waitcnt vmcnt(4)" ::: "memory")
#define RESC(a) do { if (__any((a) < 1.f)) { if (hi == 0) al_l[r32] = (a); asm volatile("s_waitcnt lgkmcnt(0)" ::: "memory"); \
    _Pragma("unroll") for (int d = 0; d < 4; ++d) _Pragma("unroll") for (int r = 0; r < 16; ++r) o[d][r] *= al_l[crow(r, hi)]; } } while (0)
#ifdef NOMASK
#define MASKT(P0_, P1_, t) do { } while (0)
#else
#define MASKT(P0_, P1_, t) do { if (u.mask && (t) >= nt0) mask_win(P0_, P1_, dqb - ((t) - nt0) * KVBLK); } while (0)
#endif
  f32x16 pA0, pA1, pB0, pB1; float mnA, mnB, alA, alB; bf16x8 pa0, pa1, pa2, pa3;
  constexpr int SE = 0, SO = 1;
  SLOAD(SE, 0); asm volatile("s_waitcnt vmcnt(0)" ::: "memory"); SWRITE(0, SE); __syncthreads();
  qkt(pA0, pA1, K_lds, qr, r32, hi); MASKT(pA0, pA1, 0); partialSM(pA0, pA1, m_reg, mnA, alA);
  SLOAD(SO, 1); if (2 < NT) SLOAD(SE, 2);
  SWAIT(); SWRITE(1, SO); __syncthreads();
  for (int j = 1; j + 1 < NT; j += 2) {
    SBAR(); qkt(pB0, pB1, K_lds + SHM_K, qr, r32, hi);
    finishSM(pA0, pA1, alA, l_reg, pa0, pa1, pa2, pa3); SBAR();
    SLOAD(SO, j + 2); SBAR();
    pv_d0(o, vb0, pa0, pa1, pa2, pa3); MASKT(pB0, pB1, j); partialSM(pB0, pB1, m_reg, mnB, alB);
    __syncthreads(); SWAIT(); SWRITE(0, SE);
    RESC(alB); __syncthreads();
    SBAR(); qkt(pA0, pA1, K_lds, qr, r32, hi);
    finishSM(pB0, pB1, alB, l_reg, pa0, pa1, pa2, pa3); SBAR();
    if (j + 3 < NT) SLOAD(SE, j + 3); SBAR();
    pv_d0(o, vb0 + (int)SHM_V, pa0, pa1, pa2, pa3); MASKT(pA0, pA1, j + 1); partialSM(pA0, pA1, m_reg, mnA, alA);
    __syncthreads(); SWAIT(); SWRITE(1, SO);
    RESC(alA); __syncthreads();
  }
  SBAR(); qkt(pB0, pB1, K_lds + SHM_K, qr, r32, hi);
  finishSM(pA0, pA1, alA, l_reg, pa0, pa1, pa2, pa3); SBAR();
  pv_d0(o, vb0, pa0, pa1, pa2, pa3); MASKT(pB0, pB1, NT - 1); partialSM(pB0, pB1, m_reg, mnB, alB);
  __syncthreads(); RESC(alB);
  finishSM(pB0, pB1, alB, l_reg, pa0, pa1, pa2, pa3); SBAR();
  pv_d0(o, vb0 + (int)SHM_V, pa0, pa1, pa2, pa3);
  l_reg += __builtin_amdgcn_exp2f(u.sink_l2 - m_reg * (SCALE * LOG2E));
  if (hi == 0) li_l[r32] = l_reg; asm volatile("s_waitcnt lgkmcnt(0)" ::: "memory");
  float rli[16];
#pragma unroll
  for (int r = 0; r < 16; ++r) rli[r] = __builtin_amdgcn_rcpf(li_l[crow(r, hi)]);
  ATT_GAS bf16_t* Ow = (ATT_GAS bf16_t*)u.O + (size_t)(wid * QBLK) * LDO;
#pragma unroll
  for (int r = 0; r < 16; ++r) { const int orow = crow(r, hi);
#pragma unroll
    for (int d0 = 0; d0 < 4; ++d0) { const float v = o[d0][r] * rli[r]; const float vn = __shfl_xor(v, 1);
      if ((r32 & 1) == 0) *(ATT_GAS unsigned*)(Ow + (size_t)orow * LDO + d0 * 32 + r32) = cvtpk(v, vn); } }
#undef SLOAD
#undef SWRITE
#undef SWAIT
#undef RESC
#undef MASKT
}
}
constexpr int NWAVES = 8;
constexpr int DM = 2048, DEPTH = 4, M_CTX = 4096, M_LAT = 32768, M_ALL = 36864, IN_W = 3584, FF = 5632, NGU = 11264, NMODROW = 9, MODW = 12288;
constexpr int COL_QA = 0, COL_KA = 512, COL_VA = 768, COL_QB = 1024, COL_KB = 2048, COL_VB = 2304, COL_CV = 2560, COL_CG = 3072;
constexpr int MIX_OA = 0, MIX_OB = 512, MIX_OC = 1536;
constexpr int CONV_W = 31, C_CH = 512;
constexpr float EPS = 1e-6f;
constexpr size_t MiB = 1u << 20;
constexpr size_t WS_CTL = 0, CTL_ZERO_BYTES = 1 * MiB;
constexpr size_t WS_MOD = 1 * MiB;
constexpr size_t WS_GAINS = 3 * MiB - 65536;
constexpr size_t WS_ROPE = 3 * MiB;
constexpr size_t WS_WIN = 6 * MiB;
constexpr size_t WS_WOUT = 62 * MiB;
constexpr size_t WS_WGU = 94 * MiB;
constexpr size_t WS_WDN = 270 * MiB;
constexpr size_t WS_CACHE = 358 * MiB;
constexpr size_t WS_H = 374 * MiB;
constexpr size_t WS_Z = 518 * MiB;
constexpr size_t WS_MIX = 770 * MiB;
constexpr size_t WS_ACT = WS_Z;
constexpr size_t WS_XB = 914 * MiB;
constexpr size_t WS_END = 1058 * MiB;
static_assert(WS_Z + (size_t)M_ALL * IN_W * 2 == WS_MIX && WS_MIX + (size_t)M_ALL * DM * 2 == WS_XB && WS_ACT + (size_t)M_ALL * FF * 2 == WS_XB && WS_XB + (size_t)M_ALL * DM * 2 == WS_END, "ws map");
static_assert(WS_WIN + (size_t)DEPTH * IN_W * DM * 2 == WS_WOUT && WS_WOUT + (size_t)DEPTH * DM * DM * 2 == WS_WGU && WS_WGU + (size_t)DEPTH * NGU * DM * 2 == WS_WDN && WS_WDN + (size_t)DEPTH * DM * FF * 2 == WS_CACHE, "ws map");
constexpr int CW_BAR = 4096;
constexpr size_t OUT_YP = 0, OUT_YS = 8388608, OUT_AK = 75497472, OUT_AV = 79691776, OUT_BK = 83886080, OUT_BV = 88080384, OUT_TOTAL = 92274688;
static_assert(pg8::EpiQKV::OFF_AK == OUT_AK && pg8::EpiQKV::OFF_AV == OUT_AV && pg8::EpiQKV::OFF_BK == OUT_BK && pg8::EpiQKV::OFF_BV == OUT_BV, "output map");
constexpr int RING_BYTES = 131072, LDSCTL_OFF = RING_BYTES, MISC_OFF = LDSCTL_OFF + 320, XCH_OFF = RING_BYTES + 2048  , LDS_BYTES = 147456;
static_assert(MISC_OFF + 128 <= XCH_OFF && XCH_OFF + 8192 <= LDS_BYTES, "LDS map");

typedef unsigned short bf16;
typedef unsigned v4u __attribute__((ext_vector_type(4)));
typedef unsigned v2u __attribute__((ext_vector_type(2)));
typedef float f32x4 __attribute__((ext_vector_type(4)));
typedef float f32x2 __attribute__((ext_vector_type(2)));
#define LDS_WAIT() asm volatile("s_waitcnt lgkmcnt(0)" ::: "memory")
__device__ __forceinline__ unsigned pk2(float lo, float hi) { unsigned r; asm volatile("v_cvt_pk_bf16_f32 %0, %1, %2" : "=v"(r) : "v"(lo), "v"(hi)); return r; }
__device__ __forceinline__ float bflo(unsigned w) { return __uint_as_float(w << 16); }
__device__ __forceinline__ float bfhi(unsigned w) { return __uint_as_float(w & 0xffff0000u); }
__device__ __forceinline__ float wave_sum(float v) {
#pragma unroll
    for (int o = 1; o < 64; o <<= 1) v += __shfl_xor(v, o);
    return v;
}

struct Args { const float* in[26]; float* out; unsigned char* ws; };
enum { I_XP = 0, I_XS, I_CAK, I_CAV, I_CBK, I_CBV, I_C, I_CCTX, I_WADA, I_BADA, I_WIN, I_WOUT, I_WGATE, I_WUP, I_WDOWN, I_N1G, I_N2G, I_QGA, I_KGA, I_QGB, I_KGB, I_SINK, I_CONVW, I_CONVB, I_CLNG, I_CLNB };

__device__ __forceinline__ int win_row(int c) {
    if (c >= 2560) { const int gate = c >= 3072, f = c - (gate ? 3072 : 2560); return 2560 + 256 * (f >> 7) + 128 * gate + (f & 127); }
    if ((c >= 768 && c < 1024) || c >= 2304) return c;
    const int f = c & 127, n = f >> 6, r = f & 63;
    return (c & ~127) + 32 * (r >> 4) + 8 * ((r >> 2) & 3) + 4 * n + (r & 3);
}
__device__ __forceinline__ void p0_transpose_item(const float* W, int K, int N, bf16* WT, int mode, LAS float* scr, int item, int lane) {
    const int nblk = N / 32, kb = item / nblk, nb = item % nblk, k0 = 64 * kb, n0 = 32 * nb;
    const int drow0 = mode == 0 ? n0 : 256 * (n0 >> 7) + (n0 & 127) + (mode == 2 ? 128 : 0);
    float wv[32];
#pragma unroll
    for (int i = 0; i < 32; ++i) { const int kk = 2 * i + (lane >> 5); wv[i] = W[(size_t)(k0 + kk) * N + n0 + (lane & 31)]; }
#pragma unroll
    for (int i = 0; i < 32; ++i) { const int kk = 2 * i + (lane >> 5); scr[kk * 33 + (lane & 31)] = wv[i]; }
    LDS_WAIT(); asm volatile("" ::: "memory");
    const int c = lane & 7;
#pragma unroll
    for (int j = 0; j < 4; ++j) { const int n = (lane >> 3) + 8 * j; const LAS float* s = scr + (8 * c) * 33 + n;
        v4u o; o.x = pk2(s[0 * 33], s[1 * 33]); o.y = pk2(s[2 * 33], s[3 * 33]); o.z = pk2(s[4 * 33], s[5 * 33]); o.w = pk2(s[6 * 33], s[7 * 33]);
        *(v4u*)(WT + (size_t)(mode == 3 ? win_row(n0 + n) : drow0 + n) * K + k0 + 8 * c) = o; }
    LDS_WAIT(); asm volatile("" ::: "memory");
}
constexpr int CV_A = 32 * 112, CV_B = 32 * 64, CV_C = 32 * 176, CV_D = 88 * 64, CV_PER_L = CV_A + CV_B + 2 * CV_C + CV_D;
__device__ __forceinline__ void convert_layer_items(const Args& a, int l, int lo, int hi, int gwl, int NGWL, LAS float* scr, int lane) {
    unsigned char* ws = a.ws;
    for (int it = lo + gwl; it < hi; it += NGWL) {
        int r = it;
        if (r < CV_A) { p0_transpose_item(a.in[I_WIN] + (size_t)l * DM * IN_W, DM, IN_W, (bf16*)(ws + WS_WIN) + (size_t)l * IN_W * DM, 3, scr, r, lane); continue; } r -= CV_A;
        if (r < CV_B) { p0_transpose_item(a.in[I_WOUT] + (size_t)l * DM * DM, DM, DM, (bf16*)(ws + WS_WOUT) + (size_t)l * DM * DM, 0, scr, r, lane); continue; } r -= CV_B;
        if (r < CV_C) { p0_transpose_item(a.in[I_WGATE] + (size_t)l * DM * FF, DM, FF, (bf16*)(ws + WS_WGU) + (size_t)l * NGU * DM, 1, scr, r, lane); continue; } r -= CV_C;
        if (r < CV_C) { p0_transpose_item(a.in[I_WUP] + (size_t)l * DM * FF, DM, FF, (bf16*)(ws + WS_WGU) + (size_t)l * NGU * DM, 2, scr, r, lane); continue; } r -= CV_C;
        p0_transpose_item(a.in[I_WDOWN] + (size_t)l * FF * DM, FF, DM, (bf16*)(ws + WS_WDN) + (size_t)l * DM * FF, 0, scr, r, lane);
    }
}
__device__ __forceinline__ void convert_in_tail(const Args& a, int l_next, int lo, int hi, int nunits, LAS unsigned char* lds, int G, const int wave_u) {
    unsigned lz_ = 0u; asm volatile("" : "+v"(lz_)); int lane_l = (int)__builtin_amdgcn_mbcnt_hi(~0u, __builtin_amdgcn_mbcnt_lo(~0u, lz_));
    const int rem = nunits % G, first = rem, nconv = G - rem;
    if ((int)blockIdx.x >= first) convert_layer_items(a, l_next, lo, hi, ((int)blockIdx.x - first) * NWAVES + wave_u, nconv * NWAVES, (LAS float*)(lds + wave_u * 8448), lane_l);
}
__device__ __forceinline__ void p0_prologue(const Args& a, LAS unsigned char* lds, int G, const int wave_u) {
    unsigned lz_ = 0u; asm volatile("" : "+v"(lz_)); int lane_l = (int)__builtin_amdgcn_mbcnt_hi(~0u, __builtin_amdgcn_mbcnt_lo(~0u, lz_)); const int lane = lane_l, wave = wave_u, tid = wave_u * 64 + lane_l; (void)tid; (void)lane; (void)wave;
    unsigned char* ws = a.ws;
    if ((int)blockIdx.x < DEPTH * 48) {
        LAS float* sl = (LAS float*)lds;
        LAS float* red = (LAS float*)(lds + 73728);
        for (int i = tid; i < NMODROW * DM; i += NWAVES * 64) { const int mb = i >> 11, k = i & 2047; const float x = mb == 0 ? a.in[I_CCTX][k] : a.in[I_C][(mb - 1) * DM + k]; sl[i] = x / (1.0f + expf(-x)); }
        __syncthreads();
        float* mod = (float*)(ws + WS_MOD);
        for (int item = blockIdx.x; item < DEPTH * 48; item += G) {
            const int l = item / 48, cb = item % 48;
            const float* W = a.in[I_WADA] + (size_t)l * DM * MODW + cb * 256 + 4 * lane;
            f32x4 acc[NMODROW];
#pragma unroll
            for (int mb = 0; mb < NMODROW; ++mb) acc[mb] = (f32x4){0.f, 0.f, 0.f, 0.f};
            const int k0 = wave * 256;
            for (int kb = 0; kb < 256; kb += 16) { f32x4 w[16];
#pragma unroll
                for (int q = 0; q < 16; ++q) w[q] = *(const f32x4*)(W + (size_t)(k0 + kb + q) * MODW);
#pragma unroll
                for (int q = 0; q < 16; ++q)
#pragma unroll
                    for (int mb = 0; mb < NMODROW; ++mb) { const float s = sl[mb * DM + k0 + kb + q]; acc[mb] += w[q] * s; } }
#pragma unroll
            for (int pass = 0; pass < 2; ++pass) { const int m0 = pass * 5, nm = pass ? 4 : 5;
#pragma unroll
                for (int mm = 0; mm < 5; ++mm) if (mm < nm) *(LAS f32x4*)(red + ((wave * 5 + mm) * 256 + 4 * lane)) = acc[m0 + mm];
                __syncthreads();
                for (int t = tid; t < nm * 256; t += NWAVES * 64) { const int mm = t >> 8, cc = t & 255; float s = a.in[I_BADA][l * MODW + cb * 256 + cc];
#pragma unroll
                    for (int w8 = 0; w8 < NWAVES; ++w8) s += red[(w8 * 5 + mm) * 256 + cc];
                    mod[(size_t)(l * NMODROW + m0 + mm) * MODW + cb * 256 + cc] = s; }
                __syncthreads(); }
        }
    }
    __syncthreads();
    convert_layer_items(a, 0, 0, CV_PER_L, blockIdx.x * NWAVES + wave, G * NWAVES, (LAS float*)(lds + wave * 8448), lane);
    {
        const size_t gt = (size_t)blockIdx.x * (NWAVES * 64) + tid, NT = (size_t)G * (NWAVES * 64);
        constexpr size_t PER = 2097152 / 8;
        for (size_t i = gt; i < 4 * PER; i += NT) { const int which = (int)(i / PER); const size_t j = i % PER;
            const float* src = a.in[I_CAK + which] + j * 8; const f32x4 x0 = *(const f32x4*)src, x1 = *(const f32x4*)(src + 4);
            v4u o; o.x = pk2(x0[0], x0[1]); o.y = pk2(x0[2], x0[3]); o.z = pk2(x1[0], x1[1]); o.w = pk2(x1[2], x1[3]);
            *(v4u*)((bf16*)(ws + WS_CACHE) + (size_t)which * 2097152 + j * 8) = o; }
        for (size_t i = gt; i < DEPTH * 512; i += NT) { const int l = (int)(i >> 9), ty = (int)(i >> 7) & 3, d = (int)(i & 127); ((float*)(ws + WS_GAINS))[i] = a.in[I_QGA + ty][l * 128 + d]; }
        float* rc = (float*)(ws + WS_ROPE); float* rs = rc + 4096 * 64;
        for (size_t i = gt; i < 4096 * 64; i += NT) { const int t = (int)(i >> 6), j = (int)(i & 63), jj = j & 31; const float pos = (float)(j < 32 ? (t >> 6) : (t & 63));
            const float inv = exp2f(-(float)jj * (13.287712379549449f / 32.0f)); const float ang = pos * inv;
            rc[i] = cosf(ang); rs[i] = sinf(ang); }
    }
}

template <bool BF>
__device__ __forceinline__ void norm_mod_rows(const float* xc, const float* xl, const bf16* xb, const float* g, const float* modl, int sh_idx, int sc_idx, bf16* H, int G, int lane, int wave) {
    const int gw = blockIdx.x * NWAVES + wave, NGW = G * NWAVES;
    constexpr int NV = BF ? 4 : 8;
    float A[32], S[32];
    for (int base = gw * 18; base < M_ALL; base += NGW * 18) {
        int cur = -1;
        v4u raw[4][NV];
#define NM_LOAD(slot_, r_) do { const int rr_ = (r_); \
            if constexpr (BF) { const bf16* xr = xb + (size_t)rr_ * DM + 8 * lane; _Pragma("unroll") for (int j = 0; j < 4; ++j) raw[slot_][j] = *(const v4u*)(xr + 512 * j); } \
            else { const float* xr = (rr_ < M_CTX ? xc : xl) + (size_t)rr_ * DM + 8 * lane; _Pragma("unroll") for (int j = 0; j < 4; ++j) { raw[slot_][2 * j] = *(const v4u*)(xr + 512 * j); raw[slot_][2 * j + 1] = *(const v4u*)(xr + 512 * j + 4); } } } while (0)
        NM_LOAD(0, base); NM_LOAD(1, base + 1); NM_LOAD(2, base + 2);
#pragma unroll
        for (int i = 0; i < 18; ++i) {
            const int r = base + i;
            if (i + 3 < 18) NM_LOAD((i + 3) & 3, r + 3);
            const int mb = r < M_CTX ? 0 : 1 + ((r - M_CTX) >> 12);
            if (mb != cur) { cur = mb;
                const float* scp = modl + (size_t)mb * MODW + sc_idx * DM; const float* shp = modl + (size_t)mb * MODW + sh_idx * DM;
#pragma unroll
                for (int j = 0; j < 4; ++j)
#pragma unroll
                    for (int h = 0; h < 2; ++h) { const int c = 512 * j + 8 * lane + 4 * h; const f32x4 gv = *(const f32x4*)(g + c), sv = *(const f32x4*)(scp + c), hv = *(const f32x4*)(shp + c);
#pragma unroll
                        for (int e = 0; e < 4; ++e) { A[j * 8 + h * 4 + e] = gv[e] * (1.0f + sv[e]); S[j * 8 + h * 4 + e] = hv[e]; } } }
            f32x4 v[8]; float ss = 0.f;
#pragma unroll
            for (int j = 0; j < 4; ++j) {
                if constexpr (BF) { const v4u w = raw[i & 3][j]; v[2 * j] = (f32x4){bflo(w.x), bfhi(w.x), bflo(w.y), bfhi(w.y)}; v[2 * j + 1] = (f32x4){bflo(w.z), bfhi(w.z), bflo(w.w), bfhi(w.w)}; }
                else { v[2 * j] = __builtin_bit_cast(f32x4, raw[i & 3][2 * j]); v[2 * j + 1] = __builtin_bit_cast(f32x4, raw[i & 3][2 * j + 1]); } }
#pragma unroll
            for (int q = 0; q < 8; ++q) ss += (v[q][0] * v[q][0] + v[q][1] * v[q][1]) + (v[q][2] * v[q][2] + v[q][3] * v[q][3]);
            const float rstd = 1.0f / sqrtf(wave_sum(ss) * (1.0f / DM) + EPS);
            bf16* hr = H + (size_t)r * DM + 8 * lane;
#pragma unroll
            for (int j = 0; j < 4; ++j) { float y[8];
#pragma unroll
                for (int e = 0; e < 8; ++e) y[e] = v[2 * j + (e >> 2)][e & 3] * rstd * A[j * 8 + e] + S[j * 8 + e];
                v4u o; o.x = pk2(y[0], y[1]); o.y = pk2(y[2], y[3]); o.z = pk2(y[4], y[5]); o.w = pk2(y[6], y[7]);
                *(v4u*)(hr + 512 * j) = o; }
        }
#undef NM_LOAD
    }
}
__device__ __forceinline__ void norm_mod_phase(const float* xc, const float* xl, const bf16* xb  , const float* g, const float* modl, int sh_idx, int sc_idx, bf16* H, int G, const int wave_u) {
    unsigned lz_ = 0u; asm volatile("" : "+v"(lz_)); const int lane = (int)__builtin_amdgcn_mbcnt_hi(~0u, __builtin_amdgcn_mbcnt_lo(~0u, lz_));
    if (xb) norm_mod_rows<true>(xc, xl, xb, g, modl, sh_idx, sc_idx, H, G, lane, wave_u); else norm_mod_rows<false>(xc, xl, xb, g, modl, sh_idx, sc_idx, H, G, lane, wave_u);
}

struct QkvRaw { v4u w1[3], w2[3], wv, wg; f32x4 ca, cb, sa, sb; };
template <bool CTX>
__device__ __forceinline__ void qkv_load(const Args& a, const bf16* Z, int r, int lane, QkvRaw& q) {
    const int hs = lane >> 3, i8 = lane & 7;
    const bf16* zr = Z + (size_t)r * IN_W;
#pragma unroll
    for (int it = 0; it < 3; ++it) { const int seg = it * 8 + hs; const bf16* p1 = zr + (seg < 20 ? seg : 0) * 128 + 8 * i8; q.w1[it] = *(const v4u*)p1; q.w2[it] = *(const v4u*)(p1 + 64); }
    q.wv = *(const v4u*)(zr + COL_CV + 8 * lane); q.wg = *(const v4u*)(zr + COL_CG + 8 * lane);
    if constexpr (!CTX) { const float* rc = (const float*)(a.ws + WS_ROPE); const float* rs = rc + 4096 * 64; const int t = (r - M_CTX) & 4095;
        q.ca = *(const f32x4*)(rc + t * 64 + 8 * i8); q.cb = *(const f32x4*)(rc + t * 64 + 8 * i8 + 4); q.sa = *(const f32x4*)(rs + t * 64 + 8 * i8); q.sb = *(const f32x4*)(rs + t * 64 + 8 * i8 + 4); }
}
template <bool CTX>
__device__ __forceinline__ void qkv_row(const Args& a, int l, const QkvRaw& q, bf16* Zo, int r, int lane, const float* qga, const float* kga, const float* qgb, const float* kgb) {
    const int hs = lane >> 3, i8 = lane & 7;
    bf16* zo = Zo + (size_t)r * IN_W;
    const v4u* w1 = q.w1; const v4u* w2 = q.w2; const v4u wv = q.wv, wg = q.wg;
    float cs[8], sn[8];
#pragma unroll
    for (int e = 0; e < 8; ++e) { cs[e] = 1.f; sn[e] = 0.f; }
    if constexpr (!CTX) {
#pragma unroll
        for (int e = 0; e < 4; ++e) { cs[e] = q.ca[e]; cs[4 + e] = q.cb[e]; sn[e] = q.sa[e]; sn[4 + e] = q.sb[e]; } }
#pragma unroll
    for (int it = 0; it < 3; ++it) {
        const int seg = it * 8 + hs;
        const bool active = (it < 2) || hs < 4;
        const bool isK = (it == 0) ? (hs == 4 || hs == 5) : (it == 2 ? hs < 2 : false);
        const bool isV = (it == 0) ? (hs >= 6) : (it == 2 ? (hs == 2 || hs == 3) : false);
        const float* gp = (it == 0) ? (hs < 4 ? qga : kga) : (it == 1 ? qgb : kgb);
        const unsigned u1[4] = {w1[it].x, w1[it].y, w1[it].z, w1[it].w}, u2[4] = {w2[it].x, w2[it].y, w2[it].z, w2[it].w};
        float x1[8], x2[8];
#pragma unroll
        for (int e = 0; e < 4; ++e) { x1[2 * e] = bflo(u1[e]); x1[2 * e + 1] = bfhi(u1[e]); x2[2 * e] = bflo(u2[e]); x2[2 * e + 1] = bfhi(u2[e]); }
        float ss = 0.f;
#pragma unroll
        for (int e = 0; e < 8; ++e) ss += x1[e] * x1[e] + x2[e] * x2[e];
        ss += __shfl_xor(ss, 1); ss += __shfl_xor(ss, 2); ss += __shfl_xor(ss, 4);
        const float rstd = 1.0f / sqrtf(ss * (1.0f / 128.0f) + EPS);
        const f32x4 g1a = *(const f32x4*)(gp + 8 * i8), g1b = *(const f32x4*)(gp + 8 * i8 + 4), g2a = *(const f32x4*)(gp + 64 + 8 * i8), g2b = *(const f32x4*)(gp + 64 + 8 * i8 + 4);
        float y1[8], y2[8];
#pragma unroll
        for (int e = 0; e < 8; ++e) { const float ga = e < 4 ? g1a[e & 3] : g1b[e & 3], gb = e < 4 ? g2a[e & 3] : g2b[e & 3]; y1[e] = isV ? x1[e] : x1[e] * rstd * ga; y2[e] = isV ? x2[e] : x2[e] * rstd * gb; }
        if constexpr (CTX) {
            if (it != 1 && (isK || isV)) {
                const int b = r >> 8, s = r & 255, kv = hs & 1;
                float* op = a.out + (it == 0 ? (isV ? OUT_AV : OUT_AK) : (isV ? OUT_BV : OUT_BK)) + ((((size_t)b * DEPTH + l) * 256 + s) * 2 + kv) * 128 + 8 * i8;
                *(f32x4*)op = (f32x4){y1[0], y1[1], y1[2], y1[3]}; *(f32x4*)(op + 4) = (f32x4){y1[4], y1[5], y1[6], y1[7]};
                *(f32x4*)(op + 64) = (f32x4){y2[0], y2[1], y2[2], y2[3]}; *(f32x4*)(op + 68) = (f32x4){y2[4], y2[5], y2[6], y2[7]};
            }
        }
        if (active && !isV) {
            float o1[8], o2[8];
#pragma unroll
            for (int e = 0; e < 8; ++e) { o1[e] = y1[e] * cs[e] - y2[e] * sn[e]; o2[e] = y2[e] * cs[e] + y1[e] * sn[e]; }
            bf16* p1 = zo + seg * 128 + 8 * i8;
            *(v4u*)p1 = (v4u){pk2(o1[0], o1[1]), pk2(o1[2], o1[3]), pk2(o1[4], o1[5]), pk2(o1[6], o1[7])};
            *(v4u*)(p1 + 64) = (v4u){pk2(o2[0], o2[1]), pk2(o2[2], o2[3]), pk2(o2[4], o2[5]), pk2(o2[6], o2[7])};
        }
    }
    { const unsigned vv[4] = {wv.x, wv.y, wv.z, wv.w}, gg[4] = {wg.x, wg.y, wg.z, wg.w}; unsigned oo[4];
#pragma unroll
      for (int e = 0; e < 4; ++e) { const float g0 = bflo(gg[e]), g1 = bfhi(gg[e]);
          oo[e] = pk2(bflo(vv[e]) * __builtin_amdgcn_rcpf(1.0f + __expf(-g0)), bfhi(vv[e]) * __builtin_amdgcn_rcpf(1.0f + __expf(-g1))); }
      *(v4u*)(zo + COL_CV + 8 * lane) = (v4u){oo[0], oo[1], oo[2], oo[3]}; }
}
__device__ __forceinline__ void qkv_post_phase(const Args& a, int l, bf16* Z, bf16* Zo, int G, const int wave_u) {
    unsigned lz_ = 0u; asm volatile("" : "+v"(lz_)); int lane_l = (int)__builtin_amdgcn_mbcnt_hi(~0u, __builtin_amdgcn_mbcnt_lo(~0u, lz_)); const int lane = lane_l, wave = wave_u;
    const int gw = blockIdx.x * NWAVES + wave, NGW = G * NWAVES;
    const float* qga = a.in[I_QGA] + l * 128; const float* kga = a.in[I_KGA] + l * 128; const float* qgb = a.in[I_QGB] + l * 128; const float* kgb = a.in[I_KGB] + l * 128;
    { QkvRaw cur, nxt; int r = gw; if (r < M_CTX) qkv_load<true>(a, Z, r, lane, cur);
      for (; r < M_CTX; r += NGW) { const int rn = r + NGW; if (rn < M_CTX) qkv_load<true>(a, Z, rn, lane, nxt); qkv_row<true>(a, l, cur, Zo, r, lane, qga, kga, qgb, kgb); cur = nxt; } }
    { QkvRaw cur, nxt; int r = M_CTX + gw; if (r < M_ALL) qkv_load<false>(a, Z, r, lane, cur);
      for (; r < M_ALL; r += NGW) { const int rn = r + NGW; if (rn < M_ALL) qkv_load<false>(a, Z, rn, lane, nxt); qkv_row<false>(a, l, cur, Zo, r, lane, qga, kga, qgb, kgb); cur = nxt; } }
}

__device__ __forceinline__ void conv_phase(const Args& a, int l, const bf16* Z, bf16* MIX, LAS unsigned char* lds, int G, const int wave_u) {
    unsigned lz_ = 0u; asm volatile("" : "+v"(lz_)); int lane_l = (int)__builtin_amdgcn_mbcnt_hi(~0u, __builtin_amdgcn_mbcnt_lo(~0u, lz_)); const int lane = lane_l, wave = wave_u, tid = wave_u * 64 + lane_l; (void)tid; (void)lane; (void)wave;
    LAS float* cw = (LAS float*)lds;
    for (int i = tid; i < CONV_W * C_CH; i += NWAVES * 64) cw[i] = a.in[I_CONVW][(size_t)l * CONV_W * C_CH + i];
    __syncthreads();
    const int gw = blockIdx.x * NWAVES + wave, NGW = G * NWAVES;
    float cb[8], lg[8], lb[8];
    { const float* p = a.in[I_CONVB] + l * C_CH + 8 * lane; const float* q = a.in[I_CLNG] + l * C_CH + 8 * lane; const float* s = a.in[I_CLNB] + l * C_CH + 8 * lane;
#pragma unroll
      for (int e = 0; e < 8; ++e) { cb[e] = p[e]; lg[e] = q[e]; lb[e] = s[e]; } }
    for (int item = gw; item < M_ALL / 8; item += NGW) {
        const int R0 = item * 8;
        const int s0 = R0 < M_CTX ? (R0 & ~255) : M_CTX + ((R0 - M_CTX) & ~4095), s1 = s0 + (R0 < M_CTX ? 256 : 4096);
        float acc[8][8];
#pragma unroll
        for (int i = 0; i < 8; ++i)
#pragma unroll
            for (int e = 0; e < 8; ++e) acc[i][e] = cb[e];
        v4u raw[2][8];
#define CV_LOADB(b_, buf_) do { _Pragma("unroll") for (int q = 0; q < 8; ++q) { const int p = 8 * (b_) + q; if (p > 37) continue; const int row = R0 - 15 + p; const bool ok = row >= s0 && row < s1; const int rowc = ok ? row : R0; \
            raw[buf_][q] = *(const v4u*)(Z + (size_t)rowc * IN_W + COL_CV + 8 * lane); if (!ok) raw[buf_][q] = (v4u){0u, 0u, 0u, 0u}; } } while (0)
#define CV_COMP(b_, buf_) do { float U[8][8]; \
            _Pragma("unroll") for (int q = 0; q < 8; ++q) { if (8 * (b_) + q > 37) continue; const v4u w = raw[buf_][q]; \
                U[q][0] = bflo(w.x); U[q][1] = bfhi(w.x); U[q][2] = bflo(w.y); U[q][3] = bfhi(w.y); U[q][4] = bflo(w.z); U[q][5] = bfhi(w.z); U[q][6] = bflo(w.w); U[q][7] = bfhi(w.w); } \
            _Pragma("unroll") for (int jj = 0; jj < 15; ++jj) { const int j = 8 * (b_) - 7 + jj; if (j < 0 || j >= CONV_W) continue; \
                const f32x4 wa = *(const LAS f32x4*)(cw + j * C_CH + 8 * lane), wb = *(const LAS f32x4*)(cw + j * C_CH + 8 * lane + 4); \
                _Pragma("unroll") for (int i = 0; i < 8; ++i) { const int p = j + i, q = p - 8 * (b_); if (q < 0 || q >= 8 || p > 37) continue; \
                    _Pragma("unroll") for (int e = 0; e < 4; ++e) { acc[i][e] = fmaf(U[q][e], wa[e], acc[i][e]); acc[i][4 + e] = fmaf(U[q][4 + e], wb[e], acc[i][4 + e]); } } } } while (0)
#define CV_SB() __builtin_amdgcn_sched_barrier(0)
        CV_LOADB(0, 0); CV_SB();
        CV_LOADB(1, 1); CV_SB(); CV_COMP(0, 0); CV_SB();
        CV_LOADB(2, 0); CV_SB(); CV_COMP(1, 1); CV_SB();
        CV_LOADB(3, 1); CV_SB(); CV_COMP(2, 0); CV_SB();
        CV_LOADB(4, 0); CV_SB(); CV_COMP(3, 1); CV_SB();
        CV_COMP(4, 0); CV_SB();
#undef CV_SB
#undef CV_LOADB
#undef CV_COMP
#pragma unroll
        for (int i = 0; i < 8; ++i) {
            float s = 0.f;
#pragma unroll
            for (int e = 0; e < 8; ++e) s += acc[i][e];
            const float mean = wave_sum(s) * (1.0f / C_CH); float q = 0.f;
#pragma unroll
            for (int e = 0; e < 8; ++e) { const float d = acc[i][e] - mean; q += d * d; }
            const float rstd = 1.0f / sqrtf(wave_sum(q) * (1.0f / C_CH) + EPS);
            float y[8];
#pragma unroll
            for (int e = 0; e < 8; ++e) { const float t = (acc[i][e] - mean) * rstd * lg[e] + lb[e]; y[e] = t / (1.0f + __expf(-t)); }
            v4u o; o.x = pk2(y[0], y[1]); o.y = pk2(y[2], y[3]); o.z = pk2(y[4], y[5]); o.w = pk2(y[6], y[7]);
            *(v4u*)(MIX + (size_t)(R0 + i) * DM + MIX_OC + 8 * lane) = o;
        }
    }
    __syncthreads();
}

__device__ __forceinline__ void attn_phase(const Args& a, int l, const bf16* Z, bf16* MIX, LAS unsigned char* lds, int G, const int wave_u) {
    const bf16* cache = (const bf16*)(a.ws + WS_CACHE);
    const float* sink = a.in[I_SINK] + l * 4;
    for (int L = blockIdx.x; L < 1728; L += G) {
        att::AUnit u;
        if (L < 1024) {
            const int x = L & 7, j = (L >> 3) & 31, i = L >> 8, pair = 2 * x + (i >> 1), uu = (i & 1) * 32 + j, b = pair >> 1, kvh = pair & 1, h = kvh * 4 + (uu >> 4), qb = uu & 15;
            const size_t row0 = (size_t)M_CTX + (size_t)b * 4096;
            u.Q = Z + (row0 + qb * 256) * IN_W + COL_QB + h * 128;
            u.K0 = cache + (size_t)2 * 2097152 + ((size_t)(b * DEPTH + l) * 256 * 2 + kvh) * 128; u.nt0 = 4;
            u.K1 = Z + row0 * IN_W + COL_KB + kvh * 128; u.nt1 = 64;
            u.O = MIX + (row0 + qb * 256) * DM + MIX_OB + h * 128;
            u.sink_l2 = -__builtin_inff(); u.mask = 0; u.qk0 = 0;
        } else if (L < 1536) {
            const int Lp = L - 1024, x = Lp & 7, j = (Lp >> 3) & 31, i = Lp >> 8, pair = 2 * x + i, b = pair >> 1, kvh = pair & 1, h = kvh * 2 + (j >> 4), qb = j & 15;
            const size_t row0 = (size_t)M_CTX + (size_t)b * 4096;
            const int q0 = qb * 256, ks = q0 - 128 < 0 ? 0 : q0 - 128, ke = q0 + 384 > 4096 ? 4096 : q0 + 384;
            u.Q = Z + (row0 + q0) * IN_W + COL_QA + h * 128;
            u.K0 = cache + ((size_t)(b * DEPTH + l) * 256 * 2 + kvh) * 128; u.nt0 = 4;
            u.K1 = Z + (row0 + ks) * IN_W + COL_KA + kvh * 128; u.nt1 = (ke - ks) / 64;
            u.O = MIX + (row0 + q0) * DM + MIX_OA + h * 128;
            u.sink_l2 = sink[h] * att::LOG2E; u.mask = 1; u.qk0 = q0 - ks;
        } else if (L < 1664) {
            const int Lp = L - 1536, b = Lp >> 3, h = Lp & 7, kvh = h >> 2; const size_t row0 = (size_t)b * 256;
            u.Q = Z + row0 * IN_W + COL_QB + h * 128;
            u.K1 = Z + row0 * IN_W + COL_KB + kvh * 128; u.nt1 = 4; u.K0 = u.K1; u.nt0 = 0;
            u.O = MIX + row0 * DM + MIX_OB + h * 128;
            u.sink_l2 = -__builtin_inff(); u.mask = 0; u.qk0 = 0;
        } else {
            const int Lp = L - 1664, b = Lp >> 2, h = Lp & 3, kvh = h >> 1; const size_t row0 = (size_t)b * 256;
            u.Q = Z + row0 * IN_W + COL_QA + h * 128;
            u.K1 = Z + row0 * IN_W + COL_KA + kvh * 128; u.nt1 = 4; u.K0 = u.K1; u.nt0 = 0;
            u.O = MIX + row0 * DM + MIX_OA + h * 128;
            u.sink_l2 = sink[h] * att::LOG2E; u.mask = 0; u.qk0 = 0;
        }
        att::attn_unit(u, (ATT_LAS char*)lds, wave_u);
        __syncthreads();
    }
}

#ifndef ALIGN_RESID
#define ALIGN_RESID true
#endif
#ifndef P7_WGM
#define P7_WGM 8
#endif
#ifndef P7_ALIGN
#define P7_ALIGN true
#endif
#ifndef P7_SP2
#define P7_SP2 true
#endif
#define NREP2 2
#ifdef PROBE_P7X2
#define NREP_P7 NREP2
#else
#define NREP_P7 1
#endif
#ifdef PROBE_P4X2
#define NREP_P4 NREP2
#else
#define NREP_P4 1
#endif
#ifdef PROBE_P2X2
#define NREP_P2 NREP2
#else
#define NREP_P2 1
#endif
#ifdef PROBE_P5X2
#define NREP_P5 NREP2
#else
#define NREP_P5 1
#endif
#ifdef PROBE_P8X2
#define NREP_P8 NREP2
#else
#define NREP_P8 1
#endif
#ifdef PROBE_P3X2
#define NREP_P3 NREP2
#else
#define NREP_P3 1
#endif
#ifdef PROBE_CONVX2
#define NREP_CONV NREP2
#else
#define NREP_CONV 1
#endif
#ifdef PROBE_THINX2
#define NREP_TH NREP2
#else
#define NREP_TH 1
#endif
#ifndef PH_MASK
#define PH_MASK 0x3ff
#endif
#define PH(n) ((PH_MASK >> (n)) & 1)
__global__ void __launch_bounds__(NWAVES * 64, 2) fwd_kernel(Args args) {
    extern __shared__ __attribute__((aligned(16))) unsigned char lds_raw[];
    LAS unsigned char* lds = (LAS unsigned char*)lds_raw;
    const int tid = threadIdx.x, G = gridDim.x, wave_u = __builtin_amdgcn_readfirstlane(tid >> 6);
    unsigned char* ws = args.ws;
    for (int u = tid; u < (LDS_BYTES - LDSCTL_OFF) / 4; u += NWAVES * 64) ((LAS unsigned*)(lds + LDSCTL_OFF))[u] = 0u;
    __syncthreads();
    XcdBarrier bar = xcd_barrier_post((unsigned*)(ws + WS_CTL) + CW_BAR, (volatile LAS unsigned*)(lds + MISC_OFF) + 8);

    bf16* H = (bf16*)(ws + WS_H); bf16* Z = (bf16*)(ws + WS_Z); bf16* MIX = (bf16*)(ws + WS_MIX); bf16* ACT = (bf16*)(ws + WS_ACT); bf16* XB = (bf16*)(ws + WS_XB);
    float* out = args.out;

    for (int rep = 0; rep < NREP_TH; ++rep) { if (rep) xcd_barrier(bar);
    if (PH(0)) p0_prologue(args, lds, G, wave_u); }
    xcd_barrier(bar);

    for (int l = 0; l < DEPTH; ++l) {
        const float* modl = (const float*)(ws + WS_MOD) + (size_t)l * NMODROW * MODW;
        const float* xc = args.in[I_XP];
        const float* xl = args.in[I_XS] - (size_t)M_CTX * DM;
        for (int rep = 0; rep < NREP_TH; ++rep) { if (rep) xcd_barrier(bar);
        if (PH(1)) norm_mod_phase(xc, xl, l == 0 ? (const bf16*)nullptr : XB, args.in[I_N1G] + l * DM, modl, 0, 1, H, G, wave_u); }
        xcd_barrier(bar);
        if (PH(2)) { pg8::Gemm g{H, (const bf16*)(ws + WS_WIN) + (size_t)l * IN_W * DM, M_ALL, IN_W, DM}; pg8::StaticOrderC<M_ALL / 256, IN_W / 256> S; S.init(G, (int)blockIdx.x);
          pg8::EpiQKV E{Z, out, (const float*)(ws + WS_GAINS) + l * 512, l, (LAS float*)(lds + XCH_OFF)};
          for (int rep = 0; rep < NREP_P2; ++rep) { if (rep) xcd_barrier(bar); pg8::gemm_phase<pg8::EpiQKV, pg8::StaticOrderC<M_ALL / 256, IN_W / 256>, true, true>(lds, g, S, E, wave_u); } }
        xcd_barrier(bar);
        for (int rep = 0; rep < NREP_P4; ++rep) { if (rep) xcd_barrier(bar);
#pragma nounroll
        for (int crep = 0; crep < NREP_CONV; ++crep)
        if (PH(4)) conv_phase(args, l, Z, MIX, lds, G, wave_u);
        if (PH(5)) attn_phase(args, l, Z, MIX, lds, G, wave_u); }
        xcd_barrier(bar);
        if (PH(6)) { pg8::Gemm g{MIX, (const bf16*)(ws + WS_WOUT) + (size_t)l * DM * DM, M_ALL, DM, DM}; pg8::StaticOrderC<M_ALL / 256, DM / 256> S; S.init(G, (int)blockIdx.x);
#pragma nounroll
          for (int rep = NREP_P5 - 1; rep >= 0; --rep) { pg8::EpiResidB E{xc, xl, XB, rep ? (bf16*)(ws + WS_END) : XB, out, modl + 2 * DM, l == 0 ? 0 : 1};
            pg8::gemm_phase<pg8::EpiResidB, pg8::StaticOrderC<M_ALL / 256, DM / 256>, ALIGN_RESID, true>(lds, g, S, E, wave_u); if (rep) xcd_barrier(bar); }
          if (l + 1 < DEPTH) convert_in_tail(args, l + 1, 0, CV_A + CV_B, (M_ALL / 256) * (DM / 256), lds, G, wave_u); }
        xcd_barrier(bar);
        for (int rep = 0; rep < NREP_TH; ++rep) { if (rep) xcd_barrier(bar);
        if (PH(7)) norm_mod_phase(xc, xl, XB, args.in[I_N2G] + l * DM, modl, 3, 4, H, G, wave_u); }
        xcd_barrier(bar);
        if (PH(8)) { pg8::Gemm g{H, (const bf16*)(ws + WS_WGU) + (size_t)l * NGU * DM, M_ALL, NGU, DM}; pg8::StaticOrderC<M_ALL / 256, NGU / 256, P7_WGM> S; S.init(G, (int)blockIdx.x);
          pg8::EpiSwiGLU E{ACT, FF};
          for (int rep = 0; rep < NREP_P7; ++rep) { if (rep) xcd_barrier(bar); pg8::gemm_phase<pg8::EpiSwiGLU, pg8::StaticOrderC<M_ALL / 256, NGU / 256, P7_WGM>, P7_ALIGN, P7_SP2>(lds, g, S, E, wave_u); }

        }
        xcd_barrier(bar);
        if (PH(9)) { pg8::Gemm g{ACT, (const bf16*)(ws + WS_WDN) + (size_t)l * DM * FF, M_ALL, DM, FF}; pg8::StaticOrderC<M_ALL / 256, DM / 256> S; S.init(G, (int)blockIdx.x);
#pragma nounroll
          for (int rep = NREP_P8 - 1; rep >= 0; --rep) { pg8::EpiResidB E{xc, xl, XB, rep ? (bf16*)(ws + WS_END) : XB, rep ? (float*)(ws + WS_END) : out, modl + 5 * DM, l + 1 < DEPTH ? 1 : 2};
            pg8::gemm_phase<pg8::EpiResidB, pg8::StaticOrderC<M_ALL / 256, DM / 256>, ALIGN_RESID, true>(lds, g, S, E, wave_u); if (rep) xcd_barrier(bar); }
          if (l + 1 < DEPTH) convert_in_tail(args, l + 1, CV_A + CV_B, CV_PER_L, (M_ALL / 256) * (DM / 256), lds, G, wave_u); }
        if (l + 1 < DEPTH) xcd_barrier(bar);
    }
}

extern "C" void kernel_launch(void* const* d_in, const int* in_sizes, int n_in, void* d_out, int out_size, void* d_ws, size_t ws_size, hipStream_t stream) {
    static int grid = 0;
    if (grid == 0) {
        if (n_in != 26 || in_sizes[0] != M_CTX * DM || in_sizes[1] != M_LAT * DM || (size_t)out_size != OUT_TOTAL || ws_size < WS_END) {
            fprintf(stderr, "kernel_launch: shape mismatch: n_in %d in0 %d in1 %d out %d ws %zu (need >= %zu); nothing launched\n", n_in, n_in > 0 ? in_sizes[0] : -1, n_in > 1 ? in_sizes[1] : -1, out_size, ws_size, (size_t)WS_END); grid = -1; return; }
        int dev = 0, cus = 0, per_cu = 0;
        if (hipGetDevice(&dev) != hipSuccess || hipDeviceGetAttribute(&cus, hipDeviceAttributeMultiprocessorCount, dev) != hipSuccess) { fprintf(stderr, "kernel_launch: device query failed\n"); grid = -1; return; }
        if (hipFuncSetAttribute((const void*)fwd_kernel, hipFuncAttributeMaxDynamicSharedMemorySize, LDS_BYTES) != hipSuccess) { fprintf(stderr, "kernel_launch: hipFuncSetAttribute failed\n"); grid = -1; return; }
        if (hipOccupancyMaxActiveBlocksPerMultiprocessor(&per_cu, (const void*)fwd_kernel, NWAVES * 64, LDS_BYTES) != hipSuccess || per_cu < 1)
            fprintf(stderr, "kernel_launch: note: occupancy query reports %d workgroups per CU\n", per_cu);
        (void)hipGetLastError();
        grid = cus;
    }
    if (grid < 0) return;
    if (hipMemsetAsync((char*)d_ws + WS_CTL, 0, CTL_ZERO_BYTES, stream) != hipSuccess) { fprintf(stderr, "kernel_launch: memset failed\n"); return; }
    Args a{};
    for (int i = 0; i < 26; ++i) a.in[i] = (const float*)d_in[i];
    a.out = (float*)d_out; a.ws = (unsigned char*)d_ws;
    hipLaunchKernelGGL(fwd_kernel, dim3(grid), dim3(NWAVES * 64), LDS_BYTES, stream, a);
    const hipError_t le = hipPeekAtLastError();
    if (le != hipSuccess) fprintf(stderr, "kernel_launch: launch failed: %s\n", hipGetErrorName(le));
}
```

```cpp
#include <hip/hip_runtime.h>
#include <cstdio>
#include <cstdint>
namespace pg8 {
#define PG8_LAS __attribute__((address_space(3)))
typedef unsigned short bf16_t;
typedef short bf16x8 __attribute__((ext_vector_type(8)));
typedef float f32x4 __attribute__((ext_vector_type(4)));
typedef unsigned u32x4 __attribute__((ext_vector_type(4)));
constexpr int BM = 256, BK = 64, HALF = 128, HTB = HALF * BK * 2  , STAGE_BYTES = 8 * HTB, NXCD = 8, WGM = 8;

__host__ __device__ __forceinline__ int lds_byte(int r, int c) { const int st = (r >> 4) * 2 + (c >> 5), rr = r & 15, cc = c & 31, ob = rr * 64 + cc * 2; return st * 1024 + (ob ^ (((ob >> 9) & 1) << 5)); }
__host__ __device__ __forceinline__ void stage_rc(int b, int& R, int& C) { const int st = b / 1024, sb = b % 1024, swz = sb ^ (((sb >> 9) & 1) << 5); R = (st >> 1) * 16 + swz / 64; C = (st & 1) * 32 + (swz % 64) / 2; }
__host__ __device__ __forceinline__ int perm32(int rho) { const int n = rho >> 4, i = rho & 15; return 8 * (i >> 2) + 4 * n + (i & 3); }

struct Unit { int pm, pn; };
struct Gemm { const bf16_t* A; const bf16_t* Bt; int M, N, K; };

struct StaticOrder {
    int nM, nN, nwg, G, c;
    __host__ __device__ void init(int M, int N, int G_, int c_) { nM = M / BM; nN = N / BM; nwg = nM * nN; G = G_; c = c_; }
    __host__ __device__ bool next(int i, Unit& u) const {
        const long L = (long)i * G + c; if (L >= nwg) return false;
        int wgid = (int)L; { const int q = nwg / NXCD, r = nwg % NXCD, xcd = wgid % NXCD, off = wgid / NXCD; wgid = (xcd < r ? xcd * (q + 1) : r * (q + 1) + (xcd - r) * q) + off; }
        const int nig = WGM * nN, gid = wgid / nig, fm = gid * WGM, gsz = (nM - fm) < WGM ? (nM - fm) : WGM;
        u.pm = fm + ((wgid % nig) % gsz); u.pn = (wgid % nig) / gsz; return true;
    }
    __device__ __forceinline__ void a_ready(const Unit&) const {}
    __device__ __forceinline__ void done(const Unit&) const {}
};

__device__ __forceinline__ unsigned cvt_pk_bf16(float lo, float hi) { unsigned r; asm volatile("v_cvt_pk_bf16_f32 %0, %1, %2" : "=v"(r) : "v"(lo), "v"(hi)); return r; }
typedef float f32x2 __attribute__((ext_vector_type(2)));
#ifdef EPI_NT
#define EPI_ST16(p, v) __builtin_nontemporal_store((v), (p))
#else
#define EPI_ST16(p, v) (*(p) = (v))
#endif
struct EpiZ {
    static constexpr bool PERM = true, AFTER_DRAIN = false;
    bf16_t* O; int ldc;
    __device__ __forceinline__ void operator()(const f32x4 (&acc)[2][2][4][2], const Unit& u, int wr, int wc, int fr, int fq) const {
        const int row0 = u.pm * BM + wr * 64 + fr, col0 = u.pn * BM + wc * 32 + 8 * fq;
#pragma unroll
        for (int ai = 0; ai < 2; ++ai)
#pragma unroll
            for (int m = 0; m < 4; ++m) { bf16_t* rowp = O + (size_t)(row0 + ai * HALF + m * 16) * ldc + col0;
#pragma unroll
                for (int bj = 0; bj < 2; ++bj) { const f32x4 v0 = acc[ai][bj][m][0], v1 = acc[ai][bj][m][1];
                    u32x4 w; w.x = cvt_pk_bf16(v0[0], v0[1]); w.y = cvt_pk_bf16(v0[2], v0[3]); w.z = cvt_pk_bf16(v1[0], v1[1]); w.w = cvt_pk_bf16(v1[2], v1[3]);
                    EPI_ST16((u32x4*)(rowp + bj * HALF), w); } }
    }
};
__device__ __forceinline__ float silu_mul(float g, float u) { return g * __builtin_amdgcn_rcpf(1.0f + __builtin_amdgcn_exp2f(g * -1.4426950408889634f)) * u; }
struct EpiSwiGLU {
    static constexpr bool PERM = true, AFTER_DRAIN = false;
    bf16_t* O; int ldc;
    __device__ __forceinline__ void operator()(const f32x4 (&acc)[2][2][4][2], const Unit& u, int wr, int wc, int fr, int fq) const {
        const int row0 = u.pm * BM + wr * 64 + fr, col0 = u.pn * HALF + wc * 32 + 8 * fq;
#pragma unroll
        for (int ai = 0; ai < 2; ++ai)
#pragma unroll
            for (int m = 0; m < 4; ++m) { bf16_t* rowp = O + (size_t)(row0 + ai * HALF + m * 16) * ldc + col0;
                const f32x4 g0 = acc[ai][0][m][0], g1 = acc[ai][0][m][1], u0 = acc[ai][1][m][0], u1 = acc[ai][1][m][1];
                u32x4 w; w.x = cvt_pk_bf16(silu_mul(g0[0], u0[0]), silu_mul(g0[1], u0[1])); w.y = cvt_pk_bf16(silu_mul(g0[2], u0[2]), silu_mul(g0[3], u0[3]));
                w.z = cvt_pk_bf16(silu_mul(g1[0], u1[0]), silu_mul(g1[1], u1[1])); w.w = cvt_pk_bf16(silu_mul(g1[2], u1[2]), silu_mul(g1[3], u1[3]));
                EPI_ST16((u32x4*)rowp, w); }
    }
};
template <bool HALFN> struct EpiResid {
    static constexpr bool PERM = false, AFTER_DRAIN = false;
    const float* base_c; const float* base_l; float* out; const float* gate;
    __device__ __forceinline__ void operator()(const f32x4 (&acc)[2][2][4][2], const Unit& u, int wr, int wc, int fr, int fq) const {
        constexpr int NBJ = HALFN ? 1 : 2;
        const int row0 = u.pm * BM + wr * 64 + fr, col0 = u.pn * (HALFN ? HALF : BM) + wc * 32 + 4 * fq;
        const int mb = u.pm < 16 ? 0 : 1 + ((u.pm - 16) >> 4);
        const float* gp = gate + (size_t)mb * 12288 + col0; const float* bp = u.pm < 16 ? base_c : base_l;
        f32x4 gv[NBJ][2];
#pragma unroll
        for (int bj = 0; bj < NBJ; ++bj)
#pragma unroll
            for (int n = 0; n < 2; ++n) gv[bj][n] = *(const f32x4*)(gp + bj * HALF + n * 16);
        constexpr int NB = 4, PER = 2 * NBJ * 2;
        f32x4 bs[2][PER];
#define EPR_LOAD(b_, buf_) do { _Pragma("unroll") for (int g2 = 0; g2 < 2; ++g2) { const int grp = (b_) * 2 + g2, ai = grp >> 2, m = grp & 3; const size_t off = (size_t)(row0 + ai * HALF + m * 16) * 2048 + col0; \
        _Pragma("unroll") for (int bj = 0; bj < NBJ; ++bj) _Pragma("unroll") for (int n = 0; n < 2; ++n) bs[buf_][(g2 * NBJ + bj) * 2 + n] = *(const f32x4*)(bp + off + bj * HALF + n * 16); } } while (0)
#define EPR_STORE(b_, buf_) do { _Pragma("unroll") for (int g2 = 0; g2 < 2; ++g2) { const int grp = (b_) * 2 + g2, ai = grp >> 2, m = grp & 3; const size_t off = (size_t)(row0 + ai * HALF + m * 16) * 2048 + col0; \
        _Pragma("unroll") for (int bj = 0; bj < NBJ; ++bj) _Pragma("unroll") for (int n = 0; n < 2; ++n) *(f32x4*)(out + off + bj * HALF + n * 16) = bs[buf_][(g2 * NBJ + bj) * 2 + n] + gv[bj][n] * acc[ai][bj][m][n]; } } while (0)
        EPR_LOAD(0, 0);
        EPR_LOAD(1, 1); EPR_STORE(0, 0);
        EPR_LOAD(2, 0); EPR_STORE(1, 1);
        EPR_LOAD(3, 1); EPR_STORE(2, 0);
        EPR_STORE(3, 1);
        static_assert(NB == 4, "pipeline written out for 4 batches");
#undef EPR_LOAD
#undef EPR_STORE
    }
};
struct HeadOrder : StaticOrder {
    int Lmax;
    __host__ __device__ bool next(int i, Unit& u) const { const long L = (long)i * G + c; if (L >= Lmax) return false; return StaticOrder::next(i, u); }
};
struct TailHalfOrder : StaticOrder {
    int Lmin;
    __host__ __device__ bool next(int i, Unit& u) const {
        const int nrem = nwg - Lmin; const long idx = (long)i * G + c; if (idx >= 2L * nrem) return false;
        const int L = Lmin + (int)(idx % nrem), half = (int)(idx / nrem);
        StaticOrder t = *this; t.G = 1; t.c = 0; Unit f; t.StaticOrder::next(L, f);
        u.pm = f.pm; u.pn = 2 * f.pn + half; return true;
    }
};

struct EpiResidB {
    static constexpr bool PERM = true, AFTER_DRAIN = false;
    const float* basef_c; const float* basef_l; const bf16_t* baseb; bf16_t* outb; float* outf; const float* gate; int mode;
    template <bool BF32, bool OF32> __device__ __forceinline__ void run(const f32x4 (&acc)[2][2][4][2], const Unit& u, int wr, int wc, int fr, int fq) const {
        const int row0 = u.pm * BM + wr * 64 + fr, col0 = u.pn * BM + wc * 32 + 8 * fq;
        const int mb = u.pm < 16 ? 0 : 1 + ((u.pm - 16) >> 4);
        const float* gp = gate + (size_t)mb * 12288 + col0; const float* bp = u.pm < 16 ? basef_c : basef_l;
        f32x4 gv[2][2];
#pragma unroll
        for (int bj = 0; bj < 2; ++bj)
#pragma unroll
            for (int n = 0; n < 2; ++n) gv[bj][n] = *(const f32x4*)(gp + bj * HALF + 4 * n);
        constexpr int NV = BF32 ? 8 : 4;
        u32x4 raw[2][NV];
#define EPB_LOAD(b_, buf_) do { _Pragma("unroll") for (int g2 = 0; g2 < 2; ++g2) { const int grp = (b_) * 2 + g2, ai = grp >> 2, m = grp & 3; const size_t off = (size_t)(row0 + ai * HALF + m * 16) * 2048 + col0; \
        _Pragma("unroll") for (int bj = 0; bj < 2; ++bj) { if constexpr (BF32) { raw[buf_][(g2 * 2 + bj) * 2] = *(const u32x4*)(bp + off + bj * HALF); raw[buf_][(g2 * 2 + bj) * 2 + 1] = *(const u32x4*)(bp + off + bj * HALF + 4); } \
                                                         else raw[buf_][g2 * 2 + bj] = *(const u32x4*)(baseb + off + bj * HALF); } } } while (0)
#define EPB_STORE(b_, buf_) do { _Pragma("unroll") for (int g2 = 0; g2 < 2; ++g2) { const int grp = (b_) * 2 + g2, ai = grp >> 2, m = grp & 3; const size_t off = (size_t)(row0 + ai * HALF + m * 16) * 2048 + col0; \
        _Pragma("unroll") for (int bj = 0; bj < 2; ++bj) { f32x4 b0, b1; \
            if constexpr (BF32) { b0 = __builtin_bit_cast(f32x4, raw[buf_][(g2 * 2 + bj) * 2]); b1 = __builtin_bit_cast(f32x4, raw[buf_][(g2 * 2 + bj) * 2 + 1]); } \
            else { const u32x4 w_ = raw[buf_][g2 * 2 + bj]; b0 = (f32x4){__uint_as_float(w_.x << 16), __uint_as_float(w_.x & 0xffff0000u), __uint_as_float(w_.y << 16), __uint_as_float(w_.y & 0xffff0000u)}; \
                   b1 = (f32x4){__uint_as_float(w_.z << 16), __uint_as_float(w_.z & 0xffff0000u), __uint_as_float(w_.w << 16), __uint_as_float(w_.w & 0xffff0000u)}; } \
            const f32x4 r0 = b0 + gv[bj][0] * acc[ai][bj][m][0], r1 = b1 + gv[bj][1] * acc[ai][bj][m][1]; \
            if constexpr (OF32) { *(f32x4*)(outf + off + bj * HALF) = r0; *(f32x4*)(outf + off + bj * HALF + 4) = r1; } \
            else { u32x4 o_; o_.x = cvt_pk_bf16(r0[0], r0[1]); o_.y = cvt_pk_bf16(r0[2], r0[3]); o_.z = cvt_pk_bf16(r1[0], r1[1]); o_.w = cvt_pk_bf16(r1[2], r1[3]); EPI_ST16((u32x4*)(outb + off + bj * HALF), o_); } } } } while (0)
        EPB_LOAD(0, 0);
        EPB_LOAD(1, 1); EPB_STORE(0, 0);
        EPB_LOAD(2, 0); EPB_STORE(1, 1);
        EPB_LOAD(3, 1); EPB_STORE(2, 0);
        EPB_STORE(3, 1);
#undef EPB_LOAD
#undef EPB_STORE
    }
    __device__ __forceinline__ void operator()(const f32x4 (&acc)[2][2][4][2], const Unit& u, int wr, int wc, int fr, int fq) const {
        if (mode == 0) run<true, false>(acc, u, wr, wc, fr, fq); else if (mode == 1) run<false, false>(acc, u, wr, wc, fr, fq); else run<false, true>(acc, u, wr, wc, fr, fq);
    }
};

template <int NM, int NN, int GM = WGM> struct StaticOrderC {
    static_assert(NM % GM == 0, "row tiles in whole groups");
    int G, c;
    __host__ __device__ void init(int G_, int c_) { G = G_; c = c_; }
    __host__ __device__ bool next(int i, Unit& u) const {
        constexpr int nwg = NM * NN, q = nwg / NXCD, r = nwg % NXCD, nig = GM * NN;
        const long L = (long)i * G + c; if (L >= nwg) return false;
        int wgid = (int)L; { const int xcd = wgid % NXCD, off = wgid / NXCD; wgid = (xcd < r ? xcd * (q + 1) : r * (q + 1) + (xcd - r) * q) + off; }
        const int gid = wgid / nig, fm = gid * GM, rem = wgid % nig;
        u.pm = fm + (rem % GM); u.pn = rem / GM; return true;
    }
    __device__ __forceinline__ void a_ready(const Unit&) const {}
    __device__ __forceinline__ void done(const Unit&) const {}
};

struct EpiQKV {
    static constexpr bool PERM = true, AFTER_DRAIN = false;
    bf16_t* Z; float* out; const float* gains; int l; PG8_LAS float* part;
    static constexpr unsigned OFF_AK = 75497472u, OFF_AV = 79691776u, OFF_BK = 83886080u, OFF_BV = 88080384u;
    __device__ __forceinline__ void operator()(const f32x4 (&acc)[2][2][4][2], const Unit& u, int wr, int wc, int fr_in, int fq_in) const {
        int fr = fr_in, fq = fq_in; asm volatile("" : "+v"(fr), "+v"(fq));
        const int pn = u.pn, row0 = u.pm * BM + wr * 64 + fr;
        const bool ctx = u.pm < 16;
        if (pn >= 10) {
#pragma unroll
            for (int ai = 0; ai < 2; ++ai)
#pragma unroll
                for (int m = 0; m < 4; ++m) { bf16_t* rowp = Z + (size_t)(row0 + ai * HALF + m * 16) * 3584 + 2560 + (pn - 10) * HALF + wc * 32 + 8 * fq;
                    const f32x4 a0 = acc[ai][0][m][0], a1 = acc[ai][0][m][1], g0 = acc[ai][1][m][0], g1 = acc[ai][1][m][1];
                    float r[8];
#pragma unroll
                    for (int e = 0; e < 4; ++e) { r[e] = a0[e] * __builtin_amdgcn_rcpf(1.0f + __builtin_amdgcn_exp2f(g0[e] * -1.4426950408889634f)); r[4 + e] = a1[e] * __builtin_amdgcn_rcpf(1.0f + __builtin_amdgcn_exp2f(g1[e] * -1.4426950408889634f)); }
                    u32x4 w; w.x = cvt_pk_bf16(r[0], r[1]); w.y = cvt_pk_bf16(r[2], r[3]); w.z = cvt_pk_bf16(r[4], r[5]); w.w = cvt_pk_bf16(r[6], r[7]);
                    *(u32x4*)rowp = w; }
        } else if (pn == 3 || pn == 9) {
#pragma unroll
            for (int ai = 0; ai < 2; ++ai)
#pragma unroll
                for (int m = 0; m < 4; ++m) { const int R = row0 + ai * HALF + m * 16; bf16_t* rowp = Z + (size_t)R * 3584 + pn * BM + wc * 32 + 8 * fq;
#pragma unroll
                    for (int bj = 0; bj < 2; ++bj) { const f32x4 v0 = acc[ai][bj][m][0], v1 = acc[ai][bj][m][1];
                        u32x4 w; w.x = cvt_pk_bf16(v0[0], v0[1]); w.y = cvt_pk_bf16(v0[2], v0[3]); w.z = cvt_pk_bf16(v1[0], v1[1]); w.w = cvt_pk_bf16(v1[2], v1[3]);
                        *(u32x4*)(rowp + bj * HALF) = w;
                        if (ctx) { const unsigned oo = (pn == 3 ? OFF_AV : OFF_BV) + (unsigned)(((((R >> 8) * 4 + l) * 256 + (R & 255)) * 2 + bj) * 128 + wc * 32 + 8 * fq); float* op = out + oo; *(f32x4*)op = v0; *(f32x4*)(op + 4) = v1; } } }
        } else {
            const bool isK = (pn == 2 || pn == 8);
            const float* g = gains + (pn < 2 ? 0 : pn == 2 ? 128 : pn < 8 ? 256 : 384);
#pragma unroll
            for (int ai = 0; ai < 2; ++ai)
#pragma unroll
                for (int m = 0; m < 4; ++m)
#pragma unroll
                    for (int bj = 0; bj < 2; ++bj) { const f32x4 a = acc[ai][bj][m][0], b = acc[ai][bj][m][1];
                        float s = (a[0] * a[0] + a[1] * a[1]) + (a[2] * a[2] + a[3] * a[3]) + (b[0] * b[0] + b[1] * b[1]) + (b[2] * b[2] + b[3] * b[3]);
                        s += __shfl_xor(s, 16); s += __shfl_xor(s, 32);
                        if (fq == 0) part[((ai * HALF + wr * 64 + m * 16 + fr) * 2 + bj) * 4 + wc] = s; }
            __builtin_amdgcn_sched_barrier(0);
            asm volatile("s_waitcnt lgkmcnt(0)" ::: "memory"); __builtin_amdgcn_s_barrier(); asm volatile("" ::: "memory");
            const f32x4 g1 = *(const f32x4*)(g + 16 * wc + 4 * fq), g2 = *(const f32x4*)(g + 64 + 16 * wc + 4 * fq);
            float invr[4];
#pragma unroll
            for (int e = 0; e < 4; ++e) { const int jj = (16 * wc + 4 * fq + e) & 31; invr[e] = __builtin_amdgcn_exp2f(-(float)jj * (13.287712379549449f / 32.0f)) * 0.15915494309189535f; }
#pragma unroll
            for (int ai = 0; ai < 2; ++ai)
#pragma unroll
                for (int m = 0; m < 4; ++m) { const int rl = ai * HALF + wr * 64 + m * 16 + fr, R = u.pm * BM + rl;
                    float cs[4] = {1.f, 1.f, 1.f, 1.f}, sn[4] = {0.f, 0.f, 0.f, 0.f};
                    if (!ctx) { const int t = (R - 4096) & 4095; const float pos = (float)(wc < 2 ? (t >> 6) : (t & 63));
#pragma unroll
                        for (int e = 0; e < 4; ++e) { const float rev = pos * invr[e]; cs[e] = __builtin_amdgcn_cosf(rev); sn[e] = __builtin_amdgcn_sinf(rev); } }
#pragma unroll
                    for (int bj = 0; bj < 2; ++bj) { const f32x4 p = *(const PG8_LAS f32x4*)(part + (rl * 2 + bj) * 4);
                        const float rstd = 1.0f / sqrtf(((p[0] + p[1]) + (p[2] + p[3])) * (1.0f / 128.0f) + 1e-6f);
                        const f32x4 v1 = acc[ai][bj][m][0] * rstd * g1, v2 = acc[ai][bj][m][1] * rstd * g2;
                        if (isK && ctx) { const unsigned oo = (pn == 2 ? OFF_AK : OFF_BK) + (unsigned)(((((R >> 8) * 4 + l) * 256 + (R & 255)) * 2 + bj) * 128 + 16 * wc + 4 * fq); float* op = out + oo; *(f32x4*)op = v1; *(f32x4*)(op + 64) = v2; }
                        float o1[4], o2[4];
#pragma unroll
                        for (int e = 0; e < 4; ++e) { o1[e] = v1[e] * cs[e] - v2[e] * sn[e]; o2[e] = v2[e] * cs[e] + v1[e] * sn[e]; }
                        bf16_t* zp = Z + (size_t)R * 3584 + pn * BM + bj * HALF + 16 * wc + 4 * fq;
                        typedef unsigned u32x2 __attribute__((ext_vector_type(2)));
                        u32x2 q1, q2; q1.x = cvt_pk_bf16(o1[0], o1[1]); q1.y = cvt_pk_bf16(o1[2], o1[3]); q2.x = cvt_pk_bf16(o2[0], o2[1]); q2.y = cvt_pk_bf16(o2[2], o2[3]);
                        *(u32x2*)zp = q1; *(u32x2*)(zp + 64) = q2; }
                    __builtin_amdgcn_sched_barrier(0); }
        }
    }
};

template <class Epi, class Sched, bool ALIGN_EPI = false, bool SP2 = false, bool HALFN = false  >
__device__ __forceinline__ void gemm_phase(PG8_LAS unsigned char* lds, const Gemm g, const Sched& S, const Epi& E, const int wave_u  ) {
    unsigned lz_ = 0u; asm volatile("" : "+v"(lz_)); int lane_l = (int)__builtin_amdgcn_mbcnt_hi(~0u, __builtin_amdgcn_mbcnt_lo(~0u, lz_));
    const int tid = wave_u * 64 + lane_l, wid = __builtin_amdgcn_readfirstlane(tid >> 6), lane = tid & 63, wr = wid >> 2, wc = wid & 3, fr = lane & 15, fq = lane >> 4;
    static_assert(!HALFN || SP2, "HALFN is written for the SP2 loop only");
    const int K = g.K, nt = K / BK;
    unsigned voffA[2], voffB[2];
#pragma unroll
    for (int i = 0; i < 2; ++i) { int R, C; stage_rc(tid * 16 + i * 8192, R, C); const int Rb = Epi::PERM ? ((R & ~31) + perm32(R & 31)) : R;
        voffA[i] = (unsigned)(R * K + C) * 2u; voffB[i] = (unsigned)(Rb * K + C) * 2u; }
    const size_t kstep = (size_t)(BK * 2);
    const size_t hstep = (size_t)HALF * K * 2;
    const size_t tstep = 2 * hstep;
    const unsigned ldsw = (unsigned)wid * 1024u;
    const int aoff = lds_byte(wr * 64 + fr, fq * 8), boff = lds_byte(wc * 32 + fr, fq * 8);
#define PG8_SA(b, h) (((b) * 2 + (h)) * HTB)
#define PG8_SB(b, h) ((4 + (b) * 2 + (h)) * HTB)
#define PG8_STAGE(bufoff, gbase, voff) do { _Pragma("unroll") for (int _i = 0; _i < 2; ++_i) \
        __builtin_amdgcn_global_load_lds((const unsigned*)((const char*)(gbase) + (voff)[_i]), (PG8_LAS unsigned*)(lds + (bufoff) + ldsw + _i * 8192), 16, 0, 0); } while (0)
#define PG8_LDA(dst, b, h) do { _Pragma("unroll") for (int m = 0; m < 4; ++m) _Pragma("unroll") for (int k = 0; k < 2; ++k) dst[m][k] = *(const PG8_LAS bf16x8*)(lds + PG8_SA(b, h) + aoff + m * 2048 + k * 1024); } while (0)
#define PG8_LDB(dst, b, h) do { _Pragma("unroll") for (int n = 0; n < 2; ++n) _Pragma("unroll") for (int k = 0; k < 2; ++k) dst[n][k] = *(const PG8_LAS bf16x8*)(lds + PG8_SB(b, h) + boff + n * 2048 + k * 1024); } while (0)
#define PG8_MMA(ai, bj, At, Bt) do { __builtin_amdgcn_s_setprio(1); _Pragma("unroll") for (int m = 0; m < 4; ++m) _Pragma("unroll") for (int n = 0; n < 2; ++n) _Pragma("unroll") for (int k = 0; k < 2; ++k) \
        acc[ai][bj][m][n] = __builtin_amdgcn_mfma_f32_16x16x32_bf16(Bt[n][k], At[m][k], acc[ai][bj][m][n], 0, 0, 0); __builtin_amdgcn_s_setprio(0); } while (0)
#define PG8_WAIT_V(n) asm volatile("s_waitcnt vmcnt(" #n ")" ::: "memory")
#define PG8_WAIT_L(n) asm volatile("s_waitcnt lgkmcnt(" #n ")" ::: "memory")
#define PG8_BAR __builtin_amdgcn_s_barrier()
#define PG8_SCHED __builtin_amdgcn_sched_barrier(0)
    Unit cur, nxt; int ui = 0;
    if (!S.next(0, cur)) return;
    f32x4 acc[2][2][4][2];
#pragma unroll
    for (int a = 0; a < 2; ++a)
#pragma unroll
        for (int b = 0; b < 2; ++b)
#pragma unroll
            for (int m = 0; m < 4; ++m)
#pragma unroll
                for (int n = 0; n < 2; ++n) acc[a][b][m][n] = (f32x4){0.f, 0.f, 0.f, 0.f};
    bf16x8 At[4][2], B0[2][2], B1[2][2];
    const char* cA = (const char*)g.A + (size_t)cur.pm * tstep; const char* cB = (const char*)g.Bt + (size_t)cur.pn * (HALFN ? hstep : tstep);
    S.a_ready(cur);
    if constexpr (SP2) {
        PG8_STAGE(PG8_SB(0, 0), cB, voffB); PG8_STAGE(PG8_SB(0, 1), cB + hstep, voffB); PG8_STAGE(PG8_SA(0, 0), cA, voffA); PG8_STAGE(PG8_SA(0, 1), cA + hstep, voffA);
        if (wr == 1) PG8_BAR;
        PG8_WAIT_V(2); PG8_BAR;
        PG8_STAGE(PG8_SB(1, 0), cB + kstep, voffB); PG8_STAGE(PG8_SA(1, 0), cA + kstep, voffA); PG8_STAGE(PG8_SB(1, 1), cB + hstep + kstep, voffB);
        PG8_WAIT_V(6); PG8_BAR;
    } else {
        PG8_STAGE(PG8_SB(0, 0), cB, voffB); PG8_STAGE(PG8_SA(0, 0), cA, voffA); PG8_STAGE(PG8_SB(0, 1), cB + hstep, voffB); PG8_STAGE(PG8_SA(0, 1), cA + hstep, voffA);
        if (wr == 1) PG8_BAR;
        PG8_WAIT_V(4); PG8_BAR;
        PG8_STAGE(PG8_SB(1, 0), cB + kstep, voffB); PG8_STAGE(PG8_SA(1, 0), cA + kstep, voffA); PG8_STAGE(PG8_SB(1, 1), cB + hstep + kstep, voffB);
        PG8_WAIT_V(6); PG8_BAR;
    }
    for (;;) {
        const bool has_next = S.next(ui + 1, nxt);
        const char* nA = has_next ? (const char*)g.A + (size_t)nxt.pm * tstep : cA; const char* nB = has_next ? (const char*)g.Bt + (size_t)nxt.pn * (HALFN ? hstep : tstep) : cB;
        for (int t = 0; t < nt; t += 2) {
            const bool last = (t == nt - 2);
            const char* a1 = cA + (size_t)(t + 1) * kstep;
            const char* a2 = last ? nA : cA + (size_t)(t + 2) * kstep; const char* b2 = last ? nB : cB + (size_t)(t + 2) * kstep;
            const char* a3 = a2 + kstep; const char* b3 = b2 + kstep;
            if (last && has_next) S.a_ready(nxt);
            if constexpr (SP2) {
            PG8_LDB(B0, 0, 0); if constexpr (!HALFN) PG8_LDB(B1, 0, 1); PG8_SCHED; PG8_LDA(At, 0, 0); PG8_STAGE(PG8_SA(1, 1), a1 + hstep, voffA);
            PG8_WAIT_V(8); PG8_WAIT_L(0); PG8_BAR; PG8_MMA(0, 0, At, B0); if constexpr (!HALFN) PG8_MMA(0, 1, At, B1); PG8_BAR; PG8_SCHED;
            PG8_LDA(At, 0, 1); PG8_STAGE(PG8_SB(0, 0), b2, voffB); PG8_STAGE(PG8_SB(0, 1), b2 + hstep, voffB); PG8_STAGE(PG8_SA(0, 0), a2, voffA);
            PG8_WAIT_V(8); PG8_WAIT_L(0); PG8_BAR; PG8_MMA(1, 0, At, B0); if constexpr (!HALFN) PG8_MMA(1, 1, At, B1); PG8_BAR; PG8_SCHED;
            PG8_LDB(B0, 1, 0); if constexpr (!HALFN) PG8_LDB(B1, 1, 1); PG8_SCHED; PG8_LDA(At, 1, 0); PG8_STAGE(PG8_SA(0, 1), a2 + hstep, voffA);
            PG8_WAIT_V(8); PG8_WAIT_L(0); PG8_BAR; PG8_MMA(0, 0, At, B0); if constexpr (!HALFN) PG8_MMA(0, 1, At, B1); PG8_BAR; PG8_SCHED;
            PG8_LDA(At, 1, 1); PG8_STAGE(PG8_SB(1, 0), b3, voffB); PG8_STAGE(PG8_SB(1, 1), b3 + hstep, voffB); PG8_STAGE(PG8_SA(1, 0), a3, voffA);
            PG8_WAIT_V(8); PG8_WAIT_L(0); PG8_BAR; PG8_MMA(1, 0, At, B0); if constexpr (!HALFN) PG8_MMA(1, 1, At, B1); PG8_BAR; PG8_SCHED;
            } else {
            PG8_LDB(B0, 0, 0); PG8_SCHED; PG8_LDA(At, 0, 0); PG8_STAGE(PG8_SA(1, 1), a1 + hstep, voffA);
            PG8_WAIT_L(8); PG8_BAR; PG8_WAIT_L(0); PG8_MMA(0, 0, At, B0); PG8_BAR; PG8_SCHED;
            PG8_LDB(B1, 0, 1); PG8_STAGE(PG8_SB(0, 0), b2, voffB);
            PG8_BAR; PG8_WAIT_L(0); PG8_MMA(0, 1, At, B1); PG8_BAR;
            PG8_LDA(At, 0, 1); PG8_STAGE(PG8_SA(0, 0), a2, voffA);
            PG8_BAR; PG8_WAIT_L(0); PG8_MMA(1, 0, At, B0); PG8_BAR; PG8_SCHED;
            PG8_STAGE(PG8_SB(0, 1), b2 + hstep, voffB);
            PG8_WAIT_V(6); PG8_BAR; PG8_MMA(1, 1, At, B1); PG8_BAR;
            PG8_LDB(B0, 1, 0); PG8_SCHED; PG8_LDA(At, 1, 0); PG8_STAGE(PG8_SA(0, 1), a2 + hstep, voffA);
            PG8_WAIT_L(8); PG8_BAR; PG8_WAIT_L(0); PG8_MMA(0, 0, At, B0); PG8_BAR; PG8_SCHED;
            PG8_LDB(B1, 1, 1); PG8_STAGE(PG8_SB(1, 0), b3, voffB);
            PG8_BAR; PG8_WAIT_L(0); PG8_MMA(0, 1, At, B1); PG8_BAR;
            PG8_LDA(At, 1, 1); PG8_STAGE(PG8_SA(1, 0), a3, voffA);
            PG8_BAR; PG8_WAIT_L(0); PG8_MMA(1, 0, At, B0); PG8_BAR; PG8_SCHED;
            PG8_STAGE(PG8_SB(1, 1), b3 + hstep, voffB);
            PG8_WAIT_V(6); PG8_BAR; PG8_MMA(1, 1, At, B1); PG8_BAR;
            }
        }
        if constexpr (ALIGN_EPI) { if (wr == 0) PG8_BAR; }
        if constexpr (!Epi::AFTER_DRAIN) { E(acc, cur, wr, wc, fr, fq); S.done(cur); }
        if (!has_next) break;
#pragma unroll
        for (int a = 0; a < 2; ++a)
#pragma unroll
            for (int b = 0; b < 2; ++b)
#pragma unroll
                for (int m = 0; m < 4; ++m)
#pragma unroll
                    for (int n = 0; n < 2; ++n) acc[a][b][m][n] = (f32x4){0.f, 0.f, 0.f, 0.f};
        cur = nxt; cA = nA; cB = nB; ++ui;
        if constexpr (ALIGN_EPI) { if (wr == 1) PG8_BAR; }
    }
    PG8_WAIT_V(0);
    if constexpr (!ALIGN_EPI) { if (wr == 0) PG8_BAR; }
    PG8_BAR;
    if constexpr (Epi::AFTER_DRAIN) { E.fused(acc, cur, wr, wc, fr, fq, lds, wid, lane); S.done(cur); }
#undef PG8_SA
#undef PG8_SB
#undef PG8_STAGE
#undef PG8_LDA
#undef PG8_LDB
#undef PG8_MMA
#undef PG8_WAIT_V
#undef PG8_WAIT_L
#undef PG8_BAR
#undef PG8_SCHED
}
}
#define LAS __attribute__((address_space(3)))
#define XB_TMO      128
#define XB_XCNT(j)  (256  + 64 * (j))
#define XB_XSUB(j)  (1280 + 64 * (j))
#define XB_XGEN(j)  (2304 + 64 * (j))
#define XB_TOP      3328
#define XB_TOPGEN   3392
#define XCD_BAR_WORDS 3456
#define XB_SPIN_CAP (1u << 18)

__device__ __forceinline__ unsigned xb_ld(unsigned* p)              { return __hip_atomic_load(p, __ATOMIC_RELAXED, __HIP_MEMORY_SCOPE_AGENT); }
__device__ __forceinline__ unsigned xb_add(unsigned* p, unsigned v) { return __hip_atomic_fetch_add(p, v, __ATOMIC_RELAXED, __HIP_MEMORY_SCOPE_AGENT); }
__device__ __forceinline__ unsigned xb_xcc_id() { return (unsigned)__builtin_amdgcn_s_getreg((3 << 11) | 20) & 0xFu; }
#define XB_SPIN(cond, bar) do { unsigned _sp = 0; while (cond) { __builtin_amdgcn_s_sleep(1); \
    if ((++_sp & 255u) == 0u) { if (xb_ld(&(bar)[XB_TMO])) break; if (_sp > XB_SPIN_CAP) { atomicAdd(&(bar)[XB_TMO], 1u); break; } } } } while (0)

struct XcdBarrier {
    unsigned* bar; unsigned x;
    volatile LAS unsigned* st;
};

__device__ __forceinline__ XcdBarrier xcd_barrier_post(unsigned* bar, volatile LAS unsigned* st) {
    XcdBarrier b; b.bar = bar; b.x = xb_xcc_id(); b.st = st;
    if (threadIdx.x == 0) (void)xb_add(&bar[XB_XCNT(b.x)], 1u);
    return b;
}
__device__ __forceinline__ void xcd_barrier_complete(unsigned* bar, unsigned x, unsigned& nloc, unsigned& nx) {
    const unsigned G = gridDim.x * gridDim.y * gridDim.z;
    unsigned sum, cnt, mine, sp = 0u;
    for (;;) {
        sum = 0u; cnt = 0u; mine = 0u;
#pragma unroll
        for (unsigned j = 0; j < 16; ++j) { const unsigned c = xb_ld(&bar[XB_XCNT(j)]); sum += c; cnt += (c > 0u) ? 1u : 0u; mine = (j == x) ? c : mine; }
        if (sum == G) break;
        __builtin_amdgcn_s_sleep(1);
        if ((++sp & 255u) == 0u) { if (xb_ld(&bar[XB_TMO])) break; if (sp > XB_SPIN_CAP) { atomicAdd(&bar[XB_TMO], 1u); break; } }
    }
    nloc = mine > 0u ? mine : 1u; nx = cnt > 0u ? cnt : 1u;
}

__device__ __forceinline__ void xcd_barrier(const XcdBarrier& b) {
    unsigned* bar_u = b.bar; asm volatile("" : "+s"(bar_u));
    asm volatile("s_waitcnt vmcnt(0)" ::: "memory");
    __syncthreads();
    if (threadIdx.x == 0) {
        unsigned* bar = bar_u; const unsigned bx_ = xb_xcc_id();
        __builtin_amdgcn_s_waitcnt(0);
        unsigned nloc = b.st[0], nx = b.st[1];
        if (nloc == 0u) { xcd_barrier_complete(bar, bx_, nloc, nx); b.st[0] = nloc; b.st[1] = nx; }
        const unsigned old = xb_add(&bar[XB_XSUB(bx_)], 1u);
        const unsigned gen = old / nloc;
        if (old + 1u == (gen + 1u) * nloc) {
            __builtin_amdgcn_fence(__ATOMIC_RELEASE, "agent");
            asm volatile("s_waitcnt vmcnt(0)" ::: "memory");
            const unsigned og = xb_add(&bar[XB_TOP], 1u);
            const unsigned tg = og / nx;
            if (og + 1u == (tg + 1u) * nx) xb_add(&bar[XB_TOPGEN], 1u);
            else XB_SPIN(xb_ld(&bar[XB_TOPGEN]) == tg, bar);
            __builtin_amdgcn_fence(__ATOMIC_ACQUIRE, "agent");
            xb_add(&bar[XB_XGEN(bx_)], 1u);
            asm volatile("s_waitcnt vmcnt(0)" ::: "memory");
        } else {
            XB_SPIN(xb_ld(&bar[XB_XGEN(bx_)]) == gen, bar);
            __builtin_amdgcn_fence(__ATOMIC_ACQUIRE, "agent");
            asm volatile("s_waitcnt vmcnt(0)" ::: "memory");
        }
    }
    __syncthreads();
}
namespace att {
#define ATT_LAS __attribute__((address_space(3)))
#define ATT_GAS __attribute__((address_space(1)))
typedef unsigned short bf16_t;
typedef short bf16x8 __attribute__((ext_vector_type(8)));
typedef short s16x4 __attribute__((ext_vector_type(4)));
typedef float f32x16 __attribute__((ext_vector_type(16)));
typedef unsigned u32x4 __attribute__((ext_vector_type(4)));
constexpr int D = 128, NW = 8, QBLK = 32, KVBLK = 64;
constexpr float SCALE = 0.088388347648318440f, THR = 8.f, LOG2E = 1.4426950408889634f;
constexpr int SHM_V = KVBLK * D * 2, SHM_K = KVBLK * D * 2, SHM_ATTN = 2 * SHM_V + 2 * SHM_K + NW * 64 * 4;
#define KSWZ(row, colB) ((row) * 256 + ((colB) ^ (((row) & 7) << 4)))
#define SBAR() __builtin_amdgcn_sched_barrier(0)
__device__ __forceinline__ int crow(int r, int hi) { return (r & 3) + 8 * (r >> 2) + 4 * hi; }
__device__ __forceinline__ unsigned cvtpk(float lo, float hi) { unsigned r; asm volatile("v_cvt_pk_bf16_f32 %0, %1, %2" : "=v"(r) : "v"(lo), "v"(hi)); return r; }
__device__ __forceinline__ void partialSM(f32x16& p0, f32x16& p1, float& m_reg, float& mn, float& alpha) {
  constexpr float C = SCALE * LOG2E;
  float pmax = p0[0];
#pragma unroll
  for (int r = 1; r < 16; ++r) pmax = fmaxf(pmax, p0[r]);
#pragma unroll
  for (int r = 0; r < 16; ++r) pmax = fmaxf(pmax, p1[r]);
  { auto rr = __builtin_amdgcn_permlane32_swap(__float_as_uint(pmax), __float_as_uint(pmax), false, false);
    pmax = fmaxf(__uint_as_float(rr[0]), __uint_as_float(rr[1])); }
  if (__builtin_expect(__all(pmax - m_reg <= THR / SCALE), 1)) { mn = m_reg; alpha = 1.f; }
  else { mn = fmaxf(m_reg, pmax); alpha = __builtin_amdgcn_exp2f((m_reg - mn) * C); m_reg = mn; }
  const float mnC = -mn * C;
#pragma unroll
  for (int r = 0; r < 16; ++r) p0[r] = fmaf(p0[r], C, mnC);
#pragma unroll
  for (int r = 0; r < 16; ++r) p1[r] = fmaf(p1[r], C, mnC);
#pragma unroll
  for (int r = 0; r < 16; ++r) p0[r] = __builtin_amdgcn_exp2f(p0[r]);
}
__device__ __forceinline__ void finishSM(f32x16& p0, f32x16& p1, float alpha, float& l_reg, bf16x8& pa0, bf16x8& pa1, bf16x8& pa2, bf16x8& pa3) {
#pragma unroll
  for (int r = 0; r < 16; ++r) p1[r] = __builtin_amdgcn_exp2f(p1[r]);
  float ps = 0;
#pragma unroll
  for (int r = 0; r < 16; ++r) ps += p0[r];
#pragma unroll
  for (int r = 0; r < 16; ++r) ps += p1[r];
  { auto rr = __builtin_amdgcn_permlane32_swap(__float_as_uint(ps), __float_as_uint(ps), false, false);
    ps = __uint_as_float(rr[0]) + __uint_as_float(rr[1]); }
  l_reg = l_reg * alpha + ps;
#define PK4(P, BASE, OUT) do { unsigned a0 = cvtpk(P[BASE + 0], P[BASE + 1]), a1 = cvtpk(P[BASE + 2], P[BASE + 3]);   \
    unsigned b0 = cvtpk(P[BASE + 4], P[BASE + 5]), b1 = cvtpk(P[BASE + 6], P[BASE + 7]);                              \
    auto r0 = __builtin_amdgcn_permlane32_swap(a0, b0, false, false); auto r1 = __builtin_amdgcn_permlane32_swap(a1, b1, false, false); \
    u32x4 w = {r0[0], r1[0], r0[1], r1[1]}; OUT = *reinterpret_cast<bf16x8*>(&w); } while (0)
  PK4(p0, 0, pa0); PK4(p0, 8, pa1); PK4(p1, 0, pa2); PK4(p1, 8, pa3);
#undef PK4
}
__device__ __forceinline__ void mask_win(f32x16& p0, f32x16& p1, int dq) {
  const float NEG = -__builtin_inff();
#pragma unroll
  for (int r = 0; r < 16; ++r) { const int c = (r & 3) + 8 * (r >> 2);
    if ((unsigned)(dq - c) >= 257u) p0[r] = NEG;
    if ((unsigned)(dq - c - 32) >= 257u) p1[r] = NEG; }
}
__device__ __forceinline__ void qkt(f32x16& p0, f32x16& p1, const ATT_LAS char* Ks, const bf16x8* qr, int r32, int hi) {
  p0 = f32x16{}; p1 = f32x16{};
  const ATT_LAS char* kb[4];
#pragma unroll
  for (int dd = 0; dd < 4; ++dd) kb[dd] = Ks + KSWZ(r32, (dd * 16 + hi * 8) * 2);
#pragma unroll
  for (int d0 = 0; d0 < 8; ++d0) { const ATT_LAS char* a = kb[d0 & 3] + (d0 >> 2) * 128;
    const bf16x8 b0 = *reinterpret_cast<const ATT_LAS bf16x8*>(a);
    const bf16x8 b1 = *reinterpret_cast<const ATT_LAS bf16x8*>(a + 32 * 256);
    p0 = __builtin_amdgcn_mfma_f32_32x32x16_bf16(b0, qr[d0], p0, 0, 0, 0);
    p1 = __builtin_amdgcn_mfma_f32_32x32x16_bf16(b1, qr[d0], p1, 0, 0, 0); }
}
__device__ __forceinline__ int v_st(int k, int c) { const int kk = (k & ~0xC) | ((k & 4) << 1) | ((k & 8) >> 1); return ((kk >> 3) * 4 + (c >> 5)) * 512 + ((kk & 7) * 32 + (c & 31)) * 2; }
__device__ __forceinline__ int v_rd_base(int lane) { return ((lane & 3) << 3) | (((lane >> 2) & 3) << 6) | (((lane >> 4) & 1) << 5) | (((lane >> 5) & 1) << 8); }
constexpr int v_rd_off(int d0, int ks, int half) { return d0 * 512 + ks * 4096 + half * 2048; }
template <int OFF> __device__ __forceinline__ s16x4 tr_read(int vb) {
  s16x4 r; asm volatile("ds_read_b64_tr_b16 %0, %1 offset:%2" : "=&v"(r) : "v"(vb), "i"(OFF) : "memory"); return r;
}
template <int D0> __device__ __forceinline__ void pv_one(f32x16& od, int vb, bf16x8 pa0, bf16x8 pa1, bf16x8 pa2, bf16x8 pa3) {
  const s16x4 l0 = tr_read<v_rd_off(D0, 0, 0)>(vb), h0 = tr_read<v_rd_off(D0, 0, 1)>(vb), l1 = tr_read<v_rd_off(D0, 1, 0)>(vb), h1 = tr_read<v_rd_off(D0, 1, 1)>(vb);
  const s16x4 l2 = tr_read<v_rd_off(D0, 2, 0)>(vb), h2 = tr_read<v_rd_off(D0, 2, 1)>(vb), l3 = tr_read<v_rd_off(D0, 3, 0)>(vb), h3 = tr_read<v_rd_off(D0, 3, 1)>(vb);
  asm volatile("s_waitcnt lgkmcnt(0)" ::: "memory"); SBAR();
#define PK(L, H) (bf16x8){L[0], L[1], L[2], L[3], H[0], H[1], H[2], H[3]}
  od = __builtin_amdgcn_mfma_f32_32x32x16_bf16(pa0, PK(l0, h0), od, 0, 0, 0);
  od = __builtin_amdgcn_mfma_f32_32x32x16_bf16(pa1, PK(l1, h1), od, 0, 0, 0);
  od = __builtin_amdgcn_mfma_f32_32x32x16_bf16(pa2, PK(l2, h2), od, 0, 0, 0);
  od = __builtin_amdgcn_mfma_f32_32x32x16_bf16(pa3, PK(l3, h3), od, 0, 0, 0);
#undef PK
}
__device__ __forceinline__ void pv_d0(f32x16* o, int vb, bf16x8 pa0, bf16x8 pa1, bf16x8 pa2, bf16x8 pa3) {
  pv_one<0>(o[0], vb, pa0, pa1, pa2, pa3); pv_one<1>(o[1], vb, pa0, pa1, pa2, pa3); pv_one<2>(o[2], vb, pa0, pa1, pa2, pa3); pv_one<3>(o[3], vb, pa0, pa1, pa2, pa3);
}

struct AUnit {
  const bf16_t* Q; const bf16_t* K0; const bf16_t* K1; bf16_t* O;
  int nt0, nt1;
  float sink_l2;
  int mask;
  int qk0;
};
constexpr int LDQ = 3584, LD0 = 256, LD1 = 3584, LDO = 2048, VOFF0 = 2097152, VOFF1 = 256;
__device__ __forceinline__ void attn_unit(const AUnit& u, ATT_LAS char* lds, const int wave_u) {
  unsigned lz_ = 0u; asm volatile("" : "+v"(lz_)); int lane_l = (int)__builtin_amdgcn_mbcnt_hi(~0u, __builtin_amdgcn_mbcnt_lo(~0u, lz_));
  const int tid = wave_u * 64 + lane_l, wid = __builtin_amdgcn_readfirstlane(tid >> 6), lane = tid & 63, r32 = lane & 31, hi = lane >> 5;
  ATT_LAS char* V_lds = lds; ATT_LAS char* K_lds = lds + 2 * SHM_V;
  ATT_LAS float* ws = (ATT_LAS float*)(lds + 2 * SHM_V + 2 * SHM_K) + wid * 64; ATT_LAS float* li_l = ws; ATT_LAS float* al_l = ws + 32;
  float m_reg = -1e30f, l_reg = 0; f32x16 o[4] = {}; bf16x8 qr[8];
  const ATT_GAS bf16_t* Qw = (const ATT_GAS bf16_t*)u.Q + (size_t)(wid * QBLK + r32) * LDQ + hi * 8;
#pragma unroll
  for (int d0 = 0; d0 < 8; ++d0) qr[d0] = *reinterpret_cast<const ATT_GAS bf16x8*>(Qw + d0 * 16);
  const int sr = tid >> 4, sc = (tid & 15) * 8, vst0 = v_st(sr, sc), vst1 = v_st(32 + sr, sc), kws = KSWZ(sr, sc * 2);
  const int vb0 = (int)(unsigned)(__UINTPTR_TYPE__)V_lds + v_rd_base(lane);
  const int nt0 = u.nt0, NT = u.nt0 + u.nt1;
  const int dqb = u.qk0 + wid * QBLK + r32 - 4 * hi + 128;
  struct { bf16x8 vs0, vs1, ks0, ks1; } sr_[2];
  const unsigned offa0 = (unsigned)(sr * LD0 + sc), offb0 = offa0 + 32u * LD0, offa1 = (unsigned)(sr * LD1 + sc), offb1 = offa1 + 32u * LD1;
#define SLOAD(i, t) do { const int t_ = (t); const bool s0_ = t_ < nt0;                                                                          \
    const ATT_GAS bf16_t* kp_ = s0_ ? (const ATT_GAS bf16_t*)u.K0 + (size_t)t_ * (KVBLK * LD0) : (const ATT_GAS bf16_t*)u.K1 + (size_t)(t_ - nt0) * (KVBLK * LD1); \
    const ATT_GAS bf16_t* vp_ = kp_ + (s0_ ? VOFF0 : VOFF1); const unsigned oa_ = s0_ ? offa0 : offa1, ob_ = s0_ ? offb0 : offb1;                \
    sr_[i].vs0 = *reinterpret_cast<const ATT_GAS bf16x8*>(vp_ + oa_); sr_[i].vs1 = *reinterpret_cast<const ATT_GAS bf16x8*>(vp_ + ob_);           \
    sr_[i].ks0 = *reinterpret_cast<const ATT_GAS bf16x8*>(kp_ + oa_); sr_[i].ks1 = *reinterpret_cast<const ATT_GAS bf16x8*>(kp_ + ob_); } while (0)
#define SWRITE(b, i) do { *(ATT_LAS bf16x8*)(V_lds + (b) * SHM_V + vst0) = sr_[i].vs0; *(ATT_LAS bf16x8*)(V_lds + (b) * SHM_V + vst1) = sr_[i].vs1; \
    *(ATT_LAS bf16x8*)(K_lds + (b) * SHM_K + kws) = sr_[i].ks0; *(ATT_LAS bf16x8*)(K_lds + (b) * SHM_K + kws + 32 * 256) = sr_[i].ks1; } while (0)
#define SWAIT() asm volatile("s_waitcnt vmcnt(4)" ::: "memory")
#define RESC(a) do { if (__any((a) < 1.f)) { if (hi == 0) al_l[r32] = (a); asm volatile("s_waitcnt lgkmcnt(0)" ::: "memory"); \
    _Pragma("unroll") for (int d = 0; d < 4; ++d) _Pragma("unroll") for (int r = 0; r < 16; ++r) o[d][r] *= al_l[crow(r, hi)]; } } while (0)
#ifdef NOMASK
#define MASKT(P0_, P1_, t) do { } while (0)
#else
#define MASKT(P0_, P1_, t) do { if (u.mask && (t) >= nt0) mask_win(P0_, P1_, dqb - ((t) - nt0) * KVBLK); } while (0)
#endif
  f32x16 pA0, pA1, pB0, pB1; float mnA, mnB, alA, alB; bf16x8 pa0, pa1, pa2, pa3;
  constexpr int SE = 0, SO = 1;
  SLOAD(SE, 0); asm volatile("s_waitcnt vmcnt(0)" ::: "memory"); SWRITE(0, SE); __syncthreads();
  qkt(pA0, pA1, K_lds, qr, r32, hi); MASKT(pA0, pA1, 0); partialSM(pA0, pA1, m_reg, mnA, alA);
  SLOAD(SO, 1); if (2 < NT) SLOAD(SE, 2);
  SWAIT(); SWRITE(1, SO); __syncthreads();
  for (int j = 1; j + 1 < NT; j += 2) {
    SBAR(); qkt(pB0, pB1, K_lds + SHM_K, qr, r32, hi);
    finishSM(pA0, pA1, alA, l_reg, pa0, pa1, pa2, pa3); SBAR();
    SLOAD(SO, j + 2); SBAR();
    pv_d0(o, vb0, pa0, pa1, pa2, pa3); MASKT(pB0, pB1, j); partialSM(pB0, pB1, m_reg, mnB, alB);
    __syncthreads(); SWAIT(); SWRITE(0, SE);
    RESC(alB); __syncthreads();
    SBAR(); qkt(pA0, pA1, K_lds, qr, r32, hi);
    finishSM(pB0, pB1, alB, l_reg, pa0, pa1, pa2, pa3); SBAR();
    if (j + 3 < NT) SLOAD(SE, j + 3); SBAR();
    pv_d0(o, vb0 + (int)SHM_V, pa0, pa1, pa2, pa3); MASKT(pA0, pA1, j + 1); partialSM(pA0, pA1, m_reg, mnA, alA);
    __syncthreads(); SWAIT(); SWRITE(1, SO);
    RESC(alA); __syncthreads();
  }
  SBAR(); qkt(pB0, pB1, K_lds + SHM_K, qr, r32, hi);
  finishSM(pA0, pA1, alA, l_reg, pa0, pa1, pa2, pa3); SBAR();
  pv_d0(o, vb0, pa0, pa1, pa2, pa3); MASKT(pB0, pB1, NT - 1); partialSM(pB0, pB1, m_reg, mnB, alB);
  __syncthreads(); RESC(alB);
  finishSM(pB0, pB1, alB, l_reg, pa0, pa1, pa2, pa3); SBAR();
  pv_d0(o, vb0 + (int)SHM_V, pa0, pa1, pa2, pa3);
  l_reg += __builtin_amdgcn_exp2f(u.sink_l2 - m_reg * (SCALE * LOG2E));
  if (hi == 0) li_l[r32] = l_reg; asm volatile("s_waitcnt lgkmcnt(0)" ::: "memory");
  float rli[16];
#pragma unroll
  for (int r = 0; r < 16; ++r) rli[r] = __builtin_amdgcn_rcpf(li_l[crow(r, hi)]);
  ATT_GAS bf16_t* Ow = (ATT_GAS bf16_t*)u.O + (size_t)(wid * QBLK) * LDO;
#pragma unroll
  for (int r = 0; r < 16; ++r) { const int orow = crow(r, hi);
#pragma unroll
    for (int d0 = 0; d0 < 4; ++d0) { const float v = o[d0][r] * rli[r]; const float vn = __shfl_xor(v, 1);
      if ((r32 & 1) == 0) *(ATT_GAS unsigned*)(Ow + (size_t)orow * LDO + d0 * 32 + r32) = cvtpk(v, vn); } }
#undef SLOAD
#undef SWRITE
#undef SWAIT
#undef RESC
#undef MASKT
}
}
constexpr int NWAVES = 8;
constexpr int DM = 2048, DEPTH = 4, M_CTX = 4096, M_LAT = 32768, M_ALL = 36864, IN_W = 3584, FF = 5632, NGU = 11264, NMODROW = 9, MODW = 12288;
constexpr int COL_QA = 0, COL_KA = 512, COL_VA = 768, COL_QB = 1024, COL_KB = 2048, COL_VB = 2304, COL_CV = 2560, COL_CG = 3072;
constexpr int MIX_OA = 0, MIX_OB = 512, MIX_OC = 1536;
constexpr int CONV_W = 31, C_CH = 512;
constexpr float EPS = 1e-6f;
constexpr size_t MiB = 1u << 20;
constexpr size_t WS_CTL = 0, CTL_ZERO_BYTES = 1 * MiB;
constexpr size_t WS_MOD = 1 * MiB;
constexpr size_t WS_GAINS = 3 * MiB - 65536;
constexpr size_t WS_ROPE = 3 * MiB;
constexpr size_t WS_WIN = 6 * MiB;
constexpr size_t WS_WOUT = 62 * MiB;
constexpr size_t WS_WGU = 94 * MiB;
constexpr size_t WS_WDN = 270 * MiB;
constexpr size_t WS_CACHE = 358 * MiB;
constexpr size_t WS_H = 374 * MiB;
constexpr size_t WS_Z = 518 * MiB;
constexpr size_t WS_MIX = 770 * MiB;
constexpr size_t WS_ACT = WS_Z;
constexpr size_t WS_XB = 914 * MiB;
constexpr size_t WS_END = 1058 * MiB;
static_assert(WS_Z + (size_t)M_ALL * IN_W * 2 == WS_MIX && WS_MIX + (size_t)M_ALL * DM * 2 == WS_XB && WS_ACT + (size_t)M_ALL * FF * 2 == WS_XB && WS_XB + (size_t)M_ALL * DM * 2 == WS_END, "ws map");
static_assert(WS_WIN + (size_t)DEPTH * IN_W * DM * 2 == WS_WOUT && WS_WOUT + (size_t)DEPTH * DM * DM * 2 == WS_WGU && WS_WGU + (size_t)DEPTH * NGU * DM * 2 == WS_WDN && WS_WDN + (size_t)DEPTH * DM * FF * 2 == WS_CACHE, "ws map");
constexpr int CW_BAR = 4096;
constexpr size_t OUT_YP = 0, OUT_YS = 8388608, OUT_AK = 75497472, OUT_AV = 79691776, OUT_BK = 83886080, OUT_BV = 88080384, OUT_TOTAL = 92274688;
static_assert(pg8::EpiQKV::OFF_AK == OUT_AK && pg8::EpiQKV::OFF_AV == OUT_AV && pg8::EpiQKV::OFF_BK == OUT_BK && pg8::EpiQKV::OFF_BV == OUT_BV, "output map");
constexpr int RING_BYTES = 131072, LDSCTL_OFF = RING_BYTES, MISC_OFF = LDSCTL_OFF + 320, XCH_OFF = RING_BYTES + 2048  , LDS_BYTES = 147456;
static_assert(MISC_OFF + 128 <= XCH_OFF && XCH_OFF + 8192 <= LDS_BYTES, "LDS map");

typedef unsigned short bf16;
typedef unsigned v4u __attribute__((ext_vector_type(4)));
typedef unsigned v2u __attribute__((ext_vector_type(2)));
typedef float f32x4 __attribute__((ext_vector_type(4)));
typedef float f32x2 __attribute__((ext_vector_type(2)));
#define LDS_WAIT() asm volatile("s_waitcnt lgkmcnt(0)" ::: "memory")
__device__ __forceinline__ unsigned pk2(float lo, float hi) { unsigned r; asm volatile("v_cvt_pk_bf16_f32 %0, %1, %2" : "=v"(r) : "v"(lo), "v"(hi)); return r; }
__device__ __forceinline__ float bflo(unsigned w) { return __uint_as_float(w << 16); }
__device__ __forceinline__ float bfhi(unsigned w) { return __uint_as_float(w & 0xffff0000u); }
__device__ __forceinline__ float wave_sum(float v) {
#pragma unroll
    for (int o = 1; o < 64; o <<= 1) v += __shfl_xor(v, o);
    return v;
}

struct Args { const float* in[26]; float* out; unsigned char* ws; };
enum { I_XP = 0, I_XS, I_CAK, I_CAV, I_CBK, I_CBV, I_C, I_CCTX, I_WADA, I_BADA, I_WIN, I_WOUT, I_WGATE, I_WUP, I_WDOWN, I_N1G, I_N2G, I_QGA, I_KGA, I_QGB, I_KGB, I_SINK, I_CONVW, I_CONVB, I_CLNG, I_CLNB };

__device__ __forceinline__ int win_row(int c) {
    if (c >= 2560) { const int gate = c >= 3072, f = c - (gate ? 3072 : 2560); return 2560 + 256 * (f >> 7) + 128 * gate + (f & 127); }
    if ((c >= 768 && c < 1024) || c >= 2304) return c;
    const int f = c & 127, n = f >> 6, r = f & 63;
    return (c & ~127) + 32 * (r >> 4) + 8 * ((r >> 2) & 3) + 4 * n + (r & 3);
}
__device__ __forceinline__ void p0_transpose_item(const float* W, int K, int N, bf16* WT, int mode, LAS float* scr, int item, int lane) {
    const int nblk = N / 32, kb = item / nblk, nb = item % nblk, k0 = 64 * kb, n0 = 32 * nb;
    const int drow0 = mode == 0 ? n0 : 256 * (n0 >> 7) + (n0 & 127) + (mode == 2 ? 128 : 0);
    float wv[32];
#pragma unroll
    for (int i = 0; i < 32; ++i) { const int kk = 2 * i + (lane >> 5); wv[i] = W[(size_t)(k0 + kk) * N + n0 + (lane & 31)]; }
#pragma unroll
    for (int i = 0; i < 32; ++i) { const int kk = 2 * i + (lane >> 5); scr[kk * 33 + (lane & 31)] = wv[i]; }
    LDS_WAIT(); asm volatile("" ::: "memory");
    const int c = lane & 7;
#pragma unroll
    for (int j = 0; j < 4; ++j) { const int n = (lane >> 3) + 8 * j; const LAS float* s = scr + (8 * c) * 33 + n;
        v4u o; o.x = pk2(s[0 * 33], s[1 * 33]); o.y = pk2(s[2 * 33], s[3 * 33]); o.z = pk2(s[4 * 33], s[5 * 33]); o.w = pk2(s[6 * 33], s[7 * 33]);
        *(v4u*)(WT + (size_t)(mode == 3 ? win_row(n0 + n) : drow0 + n) * K + k0 + 8 * c) = o; }
    LDS_WAIT(); asm volatile("" ::: "memory");
}
constexpr int CV_A = 32 * 112, CV_B = 32 * 64, CV_C = 32 * 176, CV_D = 88 * 64, CV_PER_L = CV_A + CV_B + 2 * CV_C + CV_D;
__device__ __forceinline__ void convert_layer_items(const Args& a, int l, int lo, int hi, int gwl, int NGWL, LAS float* scr, int lane) {
    unsigned char* ws = a.ws;
    for (int it = lo + gwl; it < hi; it += NGWL) {
        int r = it;
        if (r < CV_A) { p0_transpose_item(a.in[I_WIN] + (size_t)l * DM * IN_W, DM, IN_W, (bf16*)(ws + WS_WIN) + (size_t)l * IN_W * DM, 3, scr, r, lane); continue; } r -= CV_A;
        if (r < CV_B) { p0_transpose_item(a.in[I_WOUT] + (size_t)l * DM * DM, DM, DM, (bf16*)(ws + WS_WOUT) + (size_t)l * DM * DM, 0, scr, r, lane); continue; } r -= CV_B;
        if (r < CV_C) { p0_transpose_item(a.in[I_WGATE] + (size_t)l * DM * FF, DM, FF, (bf16*)(ws + WS_WGU) + (size_t)l * NGU * DM, 1, scr, r, lane); continue; } r -= CV_C;
        if (r < CV_C) { p0_transpose_item(a.in[I_WUP] + (size_t)l * DM * FF, DM, FF, (bf16*)(ws + WS_WGU) + (size_t)l * NGU * DM, 2, scr, r, lane); continue; } r -= CV_C;
        p0_transpose_item(a.in[I_WDOWN] + (size_t)l * FF * DM, FF, DM, (bf16*)(ws + WS_WDN) + (size_t)l * DM * FF, 0, scr, r, lane);
    }
}
__device__ __forceinline__ void convert_in_tail(const Args& a, int l_next, int lo, int hi, int nunits, LAS unsigned char* lds, int G, const int wave_u) {
    unsigned lz_ = 0u; asm volatile("" : "+v"(lz_)); int lane_l = (int)__builtin_amdgcn_mbcnt_hi(~0u, __builtin_amdgcn_mbcnt_lo(~0u, lz_));
    const int rem = nunits % G, first = rem, nconv = G - rem;
    if ((int)blockIdx.x >= first) convert_layer_items(a, l_next, lo, hi, ((int)blockIdx.x - first) * NWAVES + wave_u, nconv * NWAVES, (LAS float*)(lds + wave_u * 8448), lane_l);
}
__device__ __forceinline__ void p0_prologue(const Args& a, LAS unsigned char* lds, int G, const int wave_u) {
    unsigned lz_ = 0u; asm volatile("" : "+v"(lz_)); int lane_l = (int)__builtin_amdgcn_mbcnt_hi(~0u, __builtin_amdgcn_mbcnt_lo(~0u, lz_)); const int lane = lane_l, wave = wave_u, tid = wave_u * 64 + lane_l; (void)tid; (void)lane; (void)wave;
    unsigned char* ws = a.ws;
    if ((int)blockIdx.x < DEPTH * 48) {
        LAS float* sl = (LAS float*)lds;
        LAS float* red = (LAS float*)(lds + 73728);
        for (int i = tid; i < NMODROW * DM; i += NWAVES * 64) { const int mb = i >> 11, k = i & 2047; const float x = mb == 0 ? a.in[I_CCTX][k] : a.in[I_C][(mb - 1) * DM + k]; sl[i] = x / (1.0f + expf(-x)); }
        __syncthreads();
        float* mod = (float*)(ws + WS_MOD);
        for (int item = blockIdx.x; item < DEPTH * 48; item += G) {
            const int l = item / 48, cb = item % 48;
            const float* W = a.in[I_WADA] + (size_t)l * DM * MODW + cb * 256 + 4 * lane;
            f32x4 acc[NMODROW];
#pragma unroll
            for (int mb = 0; mb < NMODROW; ++mb) acc[mb] = (f32x4){0.f, 0.f, 0.f, 0.f};
            const int k0 = wave * 256;
            for (int kb = 0; kb < 256; kb += 16) { f32x4 w[16];
#pragma unroll
                for (int q = 0; q < 16; ++q) w[q] = *(const f32x4*)(W + (size_t)(k0 + kb + q) * MODW);
#pragma unroll
                for (int q = 0; q < 16; ++q)
#pragma unroll
                    for (int mb = 0; mb < NMODROW; ++mb) { const float s = sl[mb * DM + k0 + kb + q]; acc[mb] += w[q] * s; } }
#pragma unroll
            for (int pass = 0; pass < 2; ++pass) { const int m0 = pass * 5, nm = pass ? 4 : 5;
#pragma unroll
                for (int mm = 0; mm < 5; ++mm) if (mm < nm) *(LAS f32x4*)(red + ((wave * 5 + mm) * 256 + 4 * lane)) = acc[m0 + mm];
                __syncthreads();
                for (int t = tid; t < nm * 256; t += NWAVES * 64) { const int mm = t >> 8, cc = t & 255; float s = a.in[I_BADA][l * MODW + cb * 256 + cc];
#pragma unroll
                    for (int w8 = 0; w8 < NWAVES; ++w8) s += red[(w8 * 5 + mm) * 256 + cc];
                    mod[(size_t)(l * NMODROW + m0 + mm) * MODW + cb * 256 + cc] = s; }
                __syncthreads(); }
        }
    }
    __syncthreads();
    convert_layer_items(a, 0, 0, CV_PER_L, blockIdx.x * NWAVES + wave, G * NWAVES, (LAS float*)(lds + wave * 8448), lane);
    {
        const size_t gt = (size_t)blockIdx.x * (NWAVES * 64) + tid, NT = (size_t)G * (NWAVES * 64);
        constexpr size_t PER = 2097152 / 8;
        for (size_t i = gt; i < 4 * PER; i += NT) { const int which = (int)(i / PER); const size_t j = i % PER;
            const float* src = a.in[I_CAK + which] + j * 8; const f32x4 x0 = *(const f32x4*)src, x1 = *(const f32x4*)(src + 4);
            v4u o; o.x = pk2(x0[0], x0[1]); o.y = pk2(x0[2], x0[3]); o.z = pk2(x1[0], x1[1]); o.w = pk2(x1[2], x1[3]);
            *(v4u*)((bf16*)(ws + WS_CACHE) + (size_t)which * 2097152 + j * 8) = o; }
        for (size_t i = gt; i < DEPTH * 512; i += NT) { const int l = (int)(i >> 9), ty = (int)(i >> 7) & 3, d = (int)(i & 127); ((float*)(ws + WS_GAINS))[i] = a.in[I_QGA + ty][l * 128 + d]; }
        float* rc = (float*)(ws + WS_ROPE); float* rs = rc + 4096 * 64;
        for (size_t i = gt; i < 4096 * 64; i += NT) { const int t = (int)(i >> 6), j = (int)(i & 63), jj = j & 31; const float pos = (float)(j < 32 ? (t >> 6) : (t & 63));
            const float inv = exp2f(-(float)jj * (13.287712379549449f / 32.0f)); const float ang = pos * inv;
            rc[i] = cosf(ang); rs[i] = sinf(ang); }
    }
}

__device__ __forceinline__ void norm_mod_phase(const float* xc, const float* xl, const bf16* xb  , const float* g, const float* modl, int sh_idx, int sc_idx, bf16* H, int G, const int wave_u) {
    unsigned lz_ = 0u; asm volatile("" : "+v"(lz_)); int lane_l = (int)__builtin_amdgcn_mbcnt_hi(~0u, __builtin_amdgcn_mbcnt_lo(~0u, lz_)); const int lane = lane_l, wave = wave_u, tid = wave_u * 64 + lane_l; (void)tid; (void)lane; (void)wave;
    const int gw = blockIdx.x * NWAVES + wave, NGW = G * NWAVES;
    float A[32], S[32];
    for (int base = gw * 18; base < M_ALL; base += NGW * 18) {
        int cur = -1;
        for (int r = base; r < base + 18; ++r) {
            const int mb = r < M_CTX ? 0 : 1 + ((r - M_CTX) >> 12);
            if (mb != cur) { cur = mb;
                const float* scp = modl + (size_t)mb * MODW + sc_idx * DM; const float* shp = modl + (size_t)mb * MODW + sh_idx * DM;
#pragma unroll
                for (int j = 0; j < 4; ++j)
#pragma unroll
                    for (int h = 0; h < 2; ++h) { const int c = 512 * j + 8 * lane + 4 * h; const f32x4 gv = *(const f32x4*)(g + c), sv = *(const f32x4*)(scp + c), hv = *(const f32x4*)(shp + c);
#pragma unroll
                        for (int e = 0; e < 4; ++e) { A[j * 8 + h * 4 + e] = gv[e] * (1.0f + sv[e]); S[j * 8 + h * 4 + e] = hv[e]; } } }
            f32x4 v[8]; float ss = 0.f;
            if (xb) { const bf16* xr = xb + (size_t)r * DM + 8 * lane; v4u w[4];
#pragma unroll
                for (int j = 0; j < 4; ++j) w[j] = *(const v4u*)(xr + 512 * j);
#pragma unroll
                for (int j = 0; j < 4; ++j) { v[2 * j] = (f32x4){bflo(w[j].x), bfhi(w[j].x), bflo(w[j].y), bfhi(w[j].y)}; v[2 * j + 1] = (f32x4){bflo(w[j].z), bfhi(w[j].z), bflo(w[j].w), bfhi(w[j].w)}; } }
            else { const float* xr = (r < M_CTX ? xc : xl) + (size_t)r * DM + 8 * lane;
#pragma unroll
                for (int j = 0; j < 4; ++j) { v[2 * j] = *(const f32x4*)(xr + 512 * j); v[2 * j + 1] = *(const f32x4*)(xr + 512 * j + 4); } }
#pragma unroll
            for (int q = 0; q < 8; ++q) ss += (v[q][0] * v[q][0] + v[q][1] * v[q][1]) + (v[q][2] * v[q][2] + v[q][3] * v[q][3]);
            const float rstd = 1.0f / sqrtf(wave_sum(ss) * (1.0f / DM) + EPS);
            bf16* hr = H + (size_t)r * DM + 8 * lane;
#pragma unroll
            for (int j = 0; j < 4; ++j) { float y[8];
#pragma unroll
                for (int e = 0; e < 8; ++e) y[e] = v[2 * j + (e >> 2)][e & 3] * rstd * A[j * 8 + e] + S[j * 8 + e];
                v4u o; o.x = pk2(y[0], y[1]); o.y = pk2(y[2], y[3]); o.z = pk2(y[4], y[5]); o.w = pk2(y[6], y[7]);
                *(v4u*)(hr + 512 * j) = o; }
        }
    }
}

struct QkvRaw { v4u w1[3], w2[3], wv, wg; f32x4 ca, cb, sa, sb; };
template <bool CTX>
__device__ __forceinline__ void qkv_load(const Args& a, const bf16* Z, int r, int lane, QkvRaw& q) {
    const int hs = lane >> 3, i8 = lane & 7;
    const bf16* zr = Z + (size_t)r * IN_W;
#pragma unroll
    for (int it = 0; it < 3; ++it) { const int seg = it * 8 + hs; const bf16* p1 = zr + (seg < 20 ? seg : 0) * 128 + 8 * i8; q.w1[it] = *(const v4u*)p1; q.w2[it] = *(const v4u*)(p1 + 64); }
    q.wv = *(const v4u*)(zr + COL_CV + 8 * lane); q.wg = *(const v4u*)(zr + COL_CG + 8 * lane);
    if constexpr (!CTX) { const float* rc = (const float*)(a.ws + WS_ROPE); const float* rs = rc + 4096 * 64; const int t = (r - M_CTX) & 4095;
        q.ca = *(const f32x4*)(rc + t * 64 + 8 * i8); q.cb = *(const f32x4*)(rc + t * 64 + 8 * i8 + 4); q.sa = *(const f32x4*)(rs + t * 64 + 8 * i8); q.sb = *(const f32x4*)(rs + t * 64 + 8 * i8 + 4); }
}
template <bool CTX>
__device__ __forceinline__ void qkv_row(const Args& a, int l, const QkvRaw& q, bf16* Zo, int r, int lane, const float* qga, const float* kga, const float* qgb, const float* kgb) {
    const int hs = lane >> 3, i8 = lane & 7;
    bf16* zo = Zo + (size_t)r * IN_W;
    const v4u* w1 = q.w1; const v4u* w2 = q.w2; const v4u wv = q.wv, wg = q.wg;
    float cs[8], sn[8];
#pragma unroll
    for (int e = 0; e < 8; ++e) { cs[e] = 1.f; sn[e] = 0.f; }
    if constexpr (!CTX) {
#pragma unroll
        for (int e = 0; e < 4; ++e) { cs[e] = q.ca[e]; cs[4 + e] = q.cb[e]; sn[e] = q.sa[e]; sn[4 + e] = q.sb[e]; } }
#pragma unroll
    for (int it = 0; it < 3; ++it) {
        const int seg = it * 8 + hs;
        const bool active = (it < 2) || hs < 4;
        const bool isK = (it == 0) ? (hs == 4 || hs == 5) : (it == 2 ? hs < 2 : false);
        const bool isV = (it == 0) ? (hs >= 6) : (it == 2 ? (hs == 2 || hs == 3) : false);
        const float* gp = (it == 0) ? (hs < 4 ? qga : kga) : (it == 1 ? qgb : kgb);
        const unsigned u1[4] = {w1[it].x, w1[it].y, w1[it].z, w1[it].w}, u2[4] = {w2[it].x, w2[it].y, w2[it].z, w2[it].w};
        float x1[8], x2[8];
#pragma unroll
        for (int e = 0; e < 4; ++e) { x1[2 * e] = bflo(u1[e]); x1[2 * e + 1] = bfhi(u1[e]); x2[2 * e] = bflo(u2[e]); x2[2 * e + 1] = bfhi(u2[e]); }
        float ss = 0.f;
#pragma unroll
        for (int e = 0; e < 8; ++e) ss += x1[e] * x1[e] + x2[e] * x2[e];
        ss += __shfl_xor(ss, 1); ss += __shfl_xor(ss, 2); ss += __shfl_xor(ss, 4);
        const float rstd = 1.0f / sqrtf(ss * (1.0f / 128.0f) + EPS);
        const f32x4 g1a = *(const f32x4*)(gp + 8 * i8), g1b = *(const f32x4*)(gp + 8 * i8 + 4), g2a = *(const f32x4*)(gp + 64 + 8 * i8), g2b = *(const f32x4*)(gp + 64 + 8 * i8 + 4);
        float y1[8], y2[8];
#pragma unroll
        for (int e = 0; e < 8; ++e) { const float ga = e < 4 ? g1a[e & 3] : g1b[e & 3], gb = e < 4 ? g2a[e & 3] : g2b[e & 3]; y1[e] = isV ? x1[e] : x1[e] * rstd * ga; y2[e] = isV ? x2[e] : x2[e] * rstd * gb; }
        if constexpr (CTX) {
            if (it != 1 && (isK || isV)) {
                const int b = r >> 8, s = r & 255, kv = hs & 1;
                float* op = a.out + (it == 0 ? (isV ? OUT_AV : OUT_AK) : (isV ? OUT_BV : OUT_BK)) + ((((size_t)b * DEPTH + l) * 256 + s) * 2 + kv) * 128 + 8 * i8;
                *(f32x4*)op = (f32x4){y1[0], y1[1], y1[2], y1[3]}; *(f32x4*)(op + 4) = (f32x4){y1[4], y1[5], y1[6], y1[7]};
                *(f32x4*)(op + 64) = (f32x4){y2[0], y2[1], y2[2], y2[3]}; *(f32x4*)(op + 68) = (f32x4){y2[4], y2[5], y2[6], y2[7]};
            }
        }
        if (active && !isV) {
            float o1[8], o2[8];
#pragma unroll
            for (int e = 0; e < 8; ++e) { o1[e] = y1[e] * cs[e] - y2[e] * sn[e]; o2[e] = y2[e] * cs[e] + y1[e] * sn[e]; }
            bf16* p1 = zo + seg * 128 + 8 * i8;
            *(v4u*)p1 = (v4u){pk2(o1[0], o1[1]), pk2(o1[2], o1[3]), pk2(o1[4], o1[5]), pk2(o1[6], o1[7])};
            *(v4u*)(p1 + 64) = (v4u){pk2(o2[0], o2[1]), pk2(o2[2], o2[3]), pk2(o2[4], o2[5]), pk2(o2[6], o2[7])};
        }
    }
    { const unsigned vv[4] = {wv.x, wv.y, wv.z, wv.w}, gg[4] = {wg.x, wg.y, wg.z, wg.w}; unsigned oo[4];
#pragma unroll
      for (int e = 0; e < 4; ++e) { const float g0 = bflo(gg[e]), g1 = bfhi(gg[e]);
          oo[e] = pk2(bflo(vv[e]) * __builtin_amdgcn_rcpf(1.0f + __expf(-g0)), bfhi(vv[e]) * __builtin_amdgcn_rcpf(1.0f + __expf(-g1))); }
      *(v4u*)(zo + COL_CV + 8 * lane) = (v4u){oo[0], oo[1], oo[2], oo[3]}; }
}
__device__ __forceinline__ void qkv_post_phase(const Args& a, int l, bf16* Z, bf16* Zo, int G, const int wave_u) {
    unsigned lz_ = 0u; asm volatile("" : "+v"(lz_)); int lane_l = (int)__builtin_amdgcn_mbcnt_hi(~0u, __builtin_amdgcn_mbcnt_lo(~0u, lz_)); const int lane = lane_l, wave = wave_u;
    const int gw = blockIdx.x * NWAVES + wave, NGW = G * NWAVES;
    const float* qga = a.in[I_QGA] + l * 128; const float* kga = a.in[I_KGA] + l * 128; const float* qgb = a.in[I_QGB] + l * 128; const float* kgb = a.in[I_KGB] + l * 128;
    { QkvRaw cur, nxt; int r = gw; if (r < M_CTX) qkv_load<true>(a, Z, r, lane, cur);
      for (; r < M_CTX; r += NGW) { const int rn = r + NGW; if (rn < M_CTX) qkv_load<true>(a, Z, rn, lane, nxt); qkv_row<true>(a, l, cur, Zo, r, lane, qga, kga, qgb, kgb); cur = nxt; } }
    { QkvRaw cur, nxt; int r = M_CTX + gw; if (r < M_ALL) qkv_load<false>(a, Z, r, lane, cur);
      for (; r < M_ALL; r += NGW) { const int rn = r + NGW; if (rn < M_ALL) qkv_load<false>(a, Z, rn, lane, nxt); qkv_row<false>(a, l, cur, Zo, r, lane, qga, kga, qgb, kgb); cur = nxt; } }
}

__device__ __forceinline__ void conv_phase(const Args& a, int l, const bf16* Z, bf16* MIX, LAS unsigned char* lds, int G, const int wave_u) {
    unsigned lz_ = 0u; asm volatile("" : "+v"(lz_)); int lane_l = (int)__builtin_amdgcn_mbcnt_hi(~0u, __builtin_amdgcn_mbcnt_lo(~0u, lz_)); const int lane = lane_l, wave = wave_u, tid = wave_u * 64 + lane_l; (void)tid; (void)lane; (void)wave;
    LAS float* cw = (LAS float*)lds;
    for (int i = tid; i < CONV_W * C_CH; i += NWAVES * 64) cw[i] = a.in[I_CONVW][(size_t)l * CONV_W * C_CH + i];
    __syncthreads();
    const int gw = blockIdx.x * NWAVES + wave, NGW = G * NWAVES;
    float cb[8], lg[8], lb[8];
    { const float* p = a.in[I_CONVB] + l * C_CH + 8 * lane; const float* q = a.in[I_CLNG] + l * C_CH + 8 * lane; const float* s = a.in[I_CLNB] + l * C_CH + 8 * lane;
#pragma unroll
      for (int e = 0; e < 8; ++e) { cb[e] = p[e]; lg[e] = q[e]; lb[e] = s[e]; } }
    for (int item = gw; item < M_ALL / 8; item += NGW) {
        const int R0 = item * 8;
        const int s0 = R0 < M_CTX ? (R0 & ~255) : M_CTX + ((R0 - M_CTX) & ~4095), s1 = s0 + (R0 < M_CTX ? 256 : 4096);
        f32x2 acc[8][4];
#pragma unroll
        for (int i = 0; i < 8; ++i)
#pragma unroll
            for (int e = 0; e < 4; ++e) acc[i][e] = (f32x2){cb[2 * e], cb[2 * e + 1]};
        v4u raw[2][8];
#define CV_LOADB(b_, buf_) do { _Pragma("unroll") for (int q = 0; q < 8; ++q) { const int p = 8 * (b_) + q; if (p > 37) continue; const int row = R0 - 15 + p; const bool ok = row >= s0 && row < s1; const int rowc = ok ? row : R0; \
            raw[buf_][q] = *(const v4u*)(Z + (size_t)rowc * IN_W + COL_CV + 8 * lane); if (!ok) raw[buf_][q] = (v4u){0u, 0u, 0u, 0u}; } } while (0)
#define CV_COMP(b_, buf_) do { f32x2 U[8][4]; \
            _Pragma("unroll") for (int q = 0; q < 8; ++q) { if (8 * (b_) + q > 37) continue; const v4u w = raw[buf_][q]; \
                U[q][0] = (f32x2){bflo(w.x), bfhi(w.x)}; U[q][1] = (f32x2){bflo(w.y), bfhi(w.y)}; U[q][2] = (f32x2){bflo(w.z), bfhi(w.z)}; U[q][3] = (f32x2){bflo(w.w), bfhi(w.w)}; } \
            _Pragma("unroll") for (int jj = 0; jj < 15; ++jj) { const int j = 8 * (b_) - 7 + jj; if (j < 0 || j >= CONV_W) continue; \
                const f32x4 wa = *(const LAS f32x4*)(cw + j * C_CH + 8 * lane), wb = *(const LAS f32x4*)(cw + j * C_CH + 8 * lane + 4); \
                const f32x2 w2[4] = {(f32x2){wa[0], wa[1]}, (f32x2){wa[2], wa[3]}, (f32x2){wb[0], wb[1]}, (f32x2){wb[2], wb[3]}}; \
                _Pragma("unroll") for (int i = 0; i < 8; ++i) { const int p = j + i, q = p - 8 * (b_); if (q < 0 || q >= 8 || p > 37) continue; \
                    _Pragma("unroll") for (int e = 0; e < 4; ++e) acc[i][e] = __builtin_elementwise_fma(U[q][e], w2[e], acc[i][e]); } } } while (0)
#define CV_SB() __builtin_amdgcn_sched_barrier(0)
        CV_LOADB(0, 0); CV_SB();
        CV_LOADB(1, 1); CV_SB(); CV_COMP(0, 0); CV_SB();
        CV_LOADB(2, 0); CV_SB(); CV_COMP(1, 1); CV_SB();
        CV_LOADB(3, 1); CV_SB(); CV_COMP(2, 0); CV_SB();
        CV_LOADB(4, 0); CV_SB(); CV_COMP(3, 1); CV_SB();
        CV_COMP(4, 0); CV_SB();
#undef CV_SB
#undef CV_LOADB
#undef CV_COMP
#pragma unroll
        for (int i = 0; i < 8; ++i) {
            float av[8];
#pragma unroll
            for (int e = 0; e < 4; ++e) { av[2 * e] = acc[i][e].x; av[2 * e + 1] = acc[i][e].y; }
            float s = 0.f;
#pragma unroll
            for (int e = 0; e < 8; ++e) s += av[e];
            const float mean = wave_sum(s) * (1.0f / C_CH); float q = 0.f;
#pragma unroll
            for (int e = 0; e < 8; ++e) { const float d = av[e] - mean; q += d * d; }
            const float rstd = 1.0f / sqrtf(wave_sum(q) * (1.0f / C_CH) + EPS);
            float y[8];
#pragma unroll
            for (int e = 0; e < 8; ++e) { const float t = (av[e] - mean) * rstd * lg[e] + lb[e]; y[e] = t * __builtin_amdgcn_rcpf(1.0f + __builtin_amdgcn_exp2f(t * -1.4426950408889634f)); }
            v4u o; o.x = pk2(y[0], y[1]); o.y = pk2(y[2], y[3]); o.z = pk2(y[4], y[5]); o.w = pk2(y[6], y[7]);
            *(v4u*)(MIX + (size_t)(R0 + i) * DM + MIX_OC + 8 * lane) = o;
        }
    }
    __syncthreads();
}

__device__ __forceinline__ void attn_phase(const Args& a, int l, const bf16* Z, bf16* MIX, LAS unsigned char* lds, int G, const int wave_u) {
    const bf16* cache = (const bf16*)(a.ws + WS_CACHE);
    const float* sink = a.in[I_SINK] + l * 4;
    for (int L = blockIdx.x; L < 1728; L += G) {
        att::AUnit u;
        if (L < 1024) {
            const int x = L & 7, j = (L >> 3) & 31, i = L >> 8, pair = 2 * x + (i >> 1), uu = (i & 1) * 32 + j, b = pair >> 1, kvh = pair & 1, h = kvh * 4 + (uu >> 4), qb = uu & 15;
            const size_t row0 = (size_t)M_CTX + (size_t)b * 4096;
            u.Q = Z + (row0 + qb * 256) * IN_W + COL_QB + h * 128;
            u.K0 = cache + (size_t)2 * 2097152 + ((size_t)(b * DEPTH + l) * 256 * 2 + kvh) * 128; u.nt0 = 4;
            u.K1 = Z + row0 * IN_W + COL_KB + kvh * 128; u.nt1 = 64;
            u.O = MIX + (row0 + qb * 256) * DM + MIX_OB + h * 128;
            u.sink_l2 = -__builtin_inff(); u.mask = 0; u.qk0 = 0;
        } else if (L < 1536) {
            const int Lp = L - 1024, x = Lp & 7, j = (Lp >> 3) & 31, i = Lp >> 8, pair = 2 * x + i, b = pair >> 1, kvh = pair & 1, h = kvh * 2 + (j >> 4), qb = j & 15;
            const size_t row0 = (size_t)M_CTX + (size_t)b * 4096;
            const int q0 = qb * 256, ks = q0 - 128 < 0 ? 0 : q0 - 128, ke = q0 + 384 > 4096 ? 4096 : q0 + 384;
            u.Q = Z + (row0 + q0) * IN_W + COL_QA + h * 128;
            u.K0 = cache + ((size_t)(b * DEPTH + l) * 256 * 2 + kvh) * 128; u.nt0 = 4;
            u.K1 = Z + (row0 + ks) * IN_W + COL_KA + kvh * 128; u.nt1 = (ke - ks) / 64;
            u.O = MIX + (row0 + q0) * DM + MIX_OA + h * 128;
            u.sink_l2 = sink[h] * att::LOG2E; u.mask = 1; u.qk0 = q0 - ks;
        } else if (L < 1664) {
            const int Lp = L - 1536, b = Lp >> 3, h = Lp & 7, kvh = h >> 2; const size_t row0 = (size_t)b * 256;
            u.Q = Z + row0 * IN_W + COL_QB + h * 128;
            u.K1 = Z + row0 * IN_W + COL_KB + kvh * 128; u.nt1 = 4; u.K0 = u.K1; u.nt0 = 0;
            u.O = MIX + row0 * DM + MIX_OB + h * 128;
            u.sink_l2 = -__builtin_inff(); u.mask = 0; u.qk0 = 0;
        } else {
            const int Lp = L - 1664, b = Lp >> 2, h = Lp & 3, kvh = h >> 1; const size_t row0 = (size_t)b * 256;
            u.Q = Z + row0 * IN_W + COL_QA + h * 128;
            u.K1 = Z + row0 * IN_W + COL_KA + kvh * 128; u.nt1 = 4; u.K0 = u.K1; u.nt0 = 0;
            u.O = MIX + row0 * DM + MIX_OA + h * 128;
            u.sink_l2 = sink[h] * att::LOG2E; u.mask = 0; u.qk0 = 0;
        }
        att::attn_unit(u, (ATT_LAS char*)lds, wave_u);
        __syncthreads();
    }
}

#ifndef ALIGN_RESID
#define ALIGN_RESID true
#endif
#ifndef P7_WGM
#define P7_WGM 8
#endif
#ifndef P7_ALIGN
#define P7_ALIGN true
#endif
#ifndef P7_SP2
#define P7_SP2 true
#endif
#define NREP2 2
#ifdef PROBE_P7X2
#define NREP_P7 NREP2
#else
#define NREP_P7 1
#endif
#ifdef PROBE_P4X2
#define NREP_P4 NREP2
#else
#define NREP_P4 1
#endif
#ifdef PROBE_P2X2
#define NREP_P2 NREP2
#else
#define NREP_P2 1
#endif
#ifdef PROBE_P5X2
#define NREP_P5 NREP2
#else
#define NREP_P5 1
#endif
#ifdef PROBE_P8X2
#define NREP_P8 NREP2
#else
#define NREP_P8 1
#endif
#ifdef PROBE_P3X2
#define NREP_P3 NREP2
#else
#define NREP_P3 1
#endif
#ifdef PROBE_CONVX2
#define NREP_CONV NREP2
#else
#define NREP_CONV 1
#endif
#ifdef PROBE_P0X2
#define NREP_P0 NREP2
#else
#define NREP_P0 NREP_TH
#endif
#ifdef PROBE_THINX2
#define NREP_TH NREP2
#else
#define NREP_TH 1
#endif
#ifndef PH_MASK
#define PH_MASK 0x3ff
#endif
#define PH(n) ((PH_MASK >> (n)) & 1)
__global__ void __launch_bounds__(NWAVES * 64, 2) fwd_kernel(Args args) {
    extern __shared__ __attribute__((aligned(16))) unsigned char lds_raw[];
    LAS unsigned char* lds = (LAS unsigned char*)lds_raw;
    const int tid = threadIdx.x, G = gridDim.x, wave_u = __builtin_amdgcn_readfirstlane(tid >> 6);
    unsigned char* ws = args.ws;
    for (int u = tid; u < (LDS_BYTES - LDSCTL_OFF) / 4; u += NWAVES * 64) ((LAS unsigned*)(lds + LDSCTL_OFF))[u] = 0u;
    __syncthreads();
    XcdBarrier bar = xcd_barrier_post((unsigned*)(ws + WS_CTL) + CW_BAR, (volatile LAS unsigned*)(lds + MISC_OFF) + 8);

    bf16* H = (bf16*)(ws + WS_H); bf16* Z = (bf16*)(ws + WS_Z); bf16* MIX = (bf16*)(ws + WS_MIX); bf16* ACT = (bf16*)(ws + WS_ACT); bf16* XB = (bf16*)(ws + WS_XB);
    float* out = args.out;

    for (int rep = 0; rep < NREP_P0; ++rep) { if (rep) xcd_barrier(bar);
    if (PH(0)) p0_prologue(args, lds, G, wave_u); }
    xcd_barrier(bar);

    for (int l = 0; l < DEPTH; ++l) {
        const float* modl = (const float*)(ws + WS_MOD) + (size_t)l * NMODROW * MODW;
        const float* xc = args.in[I_XP];
        const float* xl = args.in[I_XS] - (size_t)M_CTX * DM;
        for (int rep = 0; rep < NREP_TH; ++rep) { if (rep) xcd_barrier(bar);
        if (PH(1)) norm_mod_phase(xc, xl, l == 0 ? (const bf16*)nullptr : XB, args.in[I_N1G] + l * DM, modl, 0, 1, H, G, wave_u); }
        xcd_barrier(bar);
        if (PH(2)) { pg8::Gemm g{H, (const bf16*)(ws + WS_WIN) + (size_t)l * IN_W * DM, M_ALL, IN_W, DM}; pg8::StaticOrderC<M_ALL / 256, IN_W / 256> S; S.init(G, (int)blockIdx.x);
          pg8::EpiQKV E{Z, out, (const float*)(ws + WS_GAINS) + l * 512, l, (LAS float*)(lds + XCH_OFF)};
          for (int rep = 0; rep < NREP_P2; ++rep) { if (rep) xcd_barrier(bar); pg8::gemm_phase<pg8::EpiQKV, pg8::StaticOrderC<M_ALL / 256, IN_W / 256>, true, true>(lds, g, S, E, wave_u); } }
        xcd_barrier(bar);
        for (int rep = 0; rep < NREP_P4; ++rep) { if (rep) xcd_barrier(bar);
#pragma nounroll
        for (int crep = 0; crep < NREP_CONV; ++crep)
        if (PH(4)) conv_phase(args, l, Z, MIX, lds, G, wave_u);
        if (PH(5)) attn_phase(args, l, Z, MIX, lds, G, wave_u); }
        xcd_barrier(bar);
        if (PH(6)) { pg8::Gemm g{MIX, (const bf16*)(ws + WS_WOUT) + (size_t)l * DM * DM, M_ALL, DM, DM}; pg8::StaticOrderC<M_ALL / 256, DM / 256> S; S.init(G, (int)blockIdx.x);
#pragma nounroll
          for (int rep = NREP_P5 - 1; rep >= 0; --rep) { pg8::EpiResidB E{xc, xl, XB, rep ? (bf16*)(ws + WS_END) : XB, out, modl + 2 * DM, l == 0 ? 0 : 1};
            pg8::gemm_phase<pg8::EpiResidB, pg8::StaticOrderC<M_ALL / 256, DM / 256>, ALIGN_RESID, true>(lds, g, S, E, wave_u); if (rep) xcd_barrier(bar); }
          if (l + 1 < DEPTH) convert_in_tail(args, l + 1, 0, CV_A + CV_B, (M_ALL / 256) * (DM / 256), lds, G, wave_u); }
        xcd_barrier(bar);
        for (int rep = 0; rep < NREP_TH; ++rep) { if (rep) xcd_barrier(bar);
        if (PH(7)) norm_mod_phase(xc, xl, XB, args.in[I_N2G] + l * DM, modl, 3, 4, H, G, wave_u); }
        xcd_barrier(bar);
        if (PH(8)) { pg8::Gemm g{H, (const bf16*)(ws + WS_WGU) + (size_t)l * NGU * DM, M_ALL, NGU, DM}; pg8::StaticOrderC<M_ALL / 256, NGU / 256, P7_WGM> S; S.init(G, (int)blockIdx.x);
          pg8::EpiSwiGLU E{ACT, FF};
          for (int rep = 0; rep < NREP_P7; ++rep) { if (rep) xcd_barrier(bar); pg8::gemm_phase<pg8::EpiSwiGLU, pg8::StaticOrderC<M_ALL / 256, NGU / 256, P7_WGM>, P7_ALIGN, P7_SP2>(lds, g, S, E, wave_u); }

        }
        xcd_barrier(bar);
        if (PH(9)) { pg8::Gemm g{ACT, (const bf16*)(ws + WS_WDN) + (size_t)l * DM * FF, M_ALL, DM, FF}; pg8::StaticOrderC<M_ALL / 256, DM / 256> S; S.init(G, (int)blockIdx.x);
#pragma nounroll
          for (int rep = NREP_P8 - 1; rep >= 0; --rep) { pg8::EpiResidB E{xc, xl, XB, rep ? (bf16*)(ws + WS_END) : XB, rep ? (float*)(ws + WS_END) : out, modl + 5 * DM, l + 1 < DEPTH ? 1 : 2};
            pg8::gemm_phase<pg8::EpiResidB, pg8::StaticOrderC<M_ALL / 256, DM / 256>, ALIGN_RESID, true>(lds, g, S, E, wave_u); if (rep) xcd_barrier(bar); }
          if (l + 1 < DEPTH) convert_in_tail(args, l + 1, CV_A + CV_B, CV_PER_L, (M_ALL / 256) * (DM / 256), lds, G, wave_u); }
        if (l + 1 < DEPTH) xcd_barrier(bar);
    }
}

extern "C" void kernel_launch(void* const* d_in, const int* in_sizes, int n_in, void* d_out, int out_size, void* d_ws, size_t ws_size, hipStream_t stream) {
    static int grid = 0;
    if (grid == 0) {
        if (n_in != 26 || in_sizes[0] != M_CTX * DM || in_sizes[1] != M_LAT * DM || (size_t)out_size != OUT_TOTAL || ws_size < WS_END) {
            fprintf(stderr, "kernel_launch: shape mismatch: n_in %d in0 %d in1 %d out %d ws %zu (need >= %zu); nothing launched\n", n_in, n_in > 0 ? in_sizes[0] : -1, n_in > 1 ? in_sizes[1] : -1, out_size, ws_size, (size_t)WS_END); grid = -1; return; }
        int dev = 0, cus = 0, per_cu = 0;
        if (hipGetDevice(&dev) != hipSuccess || hipDeviceGetAttribute(&cus, hipDeviceAttributeMultiprocessorCount, dev) != hipSuccess) { fprintf(stderr, "kernel_launch: device query failed\n"); grid = -1; return; }
        if (hipFuncSetAttribute((const void*)fwd_kernel, hipFuncAttributeMaxDynamicSharedMemorySize, LDS_BYTES) != hipSuccess) { fprintf(stderr, "kernel_launch: hipFuncSetAttribute failed\n"); grid = -1; return; }
        if (hipOccupancyMaxActiveBlocksPerMultiprocessor(&per_cu, (const void*)fwd_kernel, NWAVES * 64, LDS_BYTES) != hipSuccess || per_cu < 1)
            fprintf(stderr, "kernel_launch: note: occupancy query reports %d workgroups per CU\n", per_cu);
        (void)hipGetLastError();
        grid = cus;
    }
    if (grid < 0) return;
    if (hipMemsetAsync((char*)d_ws + WS_CTL, 0, CTL_ZERO_BYTES, stream) != hipSuccess) { fprintf(stderr, "kernel_launch: memset failed\n"); return; }
    Args a{};
    for (int i = 0; i < 26; ++i) a.in[i] = (const float*)d_in[i];
    a.out = (float*)d_out; a.ws = (unsigned char*)d_ws;
    hipLaunchKernelGGL(fwd_kernel, dim3(grid), dim3(NWAVES * 64), LDS_BYTES, stream, a);
    const hipError_t le = hipPeekAtLastError();
    if (le != hipSuccess) fprintf(stderr, "kernel_launch: launch failed: %s\n", hipGetErrorName(le));
}
```

```cpp
#include <hip/hip_runtime.h>
#include <cstdio>
#include <cstdint>

namespace pg8 {
#define PG8_LAS __attribute__((address_space(3)))
typedef unsigned short bf16_t;
typedef short bf16x8 __attribute__((ext_vector_type(8)));
typedef float f32x4 __attribute__((ext_vector_type(4)));
typedef unsigned u32x4 __attribute__((ext_vector_type(4)));
constexpr int BM = 256, BK = 64, HALF = 128, HTB = HALF * BK * 2  , STAGE_BYTES = 8 * HTB, NXCD = 8, WGM = 8;

__host__ __device__ __forceinline__ int lds_byte(int r, int c) { const int st = (r >> 4) * 2 + (c >> 5), rr = r & 15, cc = c & 31, ob = rr * 64 + cc * 2; return st * 1024 + (ob ^ (((ob >> 9) & 1) << 5)); }
__host__ __device__ __forceinline__ void stage_rc(int b, int& R, int& C) { const int st = b / 1024, sb = b % 1024, swz = sb ^ (((sb >> 9) & 1) << 5); R = (st >> 1) * 16 + swz / 64; C = (st & 1) * 32 + (swz % 64) / 2; }
__host__ __device__ __forceinline__ int perm32(int rho) { const int n = rho >> 4, i = rho & 15; return 8 * (i >> 2) + 4 * n + (i & 3); }

struct Unit { int pm, pn; };
struct Gemm { const bf16_t* A; const bf16_t* Bt; int M, N, K; };

struct StaticOrder {
    int nM, nN, nwg, G, c;
    __host__ __device__ void init(int M, int N, int G_, int c_) { nM = M / BM; nN = N / BM; nwg = nM * nN; G = G_; c = c_; }
    __host__ __device__ bool next(int i, Unit& u) const {
        const long L = (long)i * G + c; if (L >= nwg) return false;
        int wgid = (int)L; { const int q = nwg / NXCD, r = nwg % NXCD, xcd = wgid % NXCD, off = wgid / NXCD; wgid = (xcd < r ? xcd * (q + 1) : r * (q + 1) + (xcd - r) * q) + off; }
        const int nig = WGM * nN, gid = wgid / nig, fm = gid * WGM, gsz = (nM - fm) < WGM ? (nM - fm) : WGM;
        u.pm = fm + ((wgid % nig) % gsz); u.pn = (wgid % nig) / gsz; return true;
    }
    __device__ __forceinline__ void a_ready(const Unit&) const {}
    __device__ __forceinline__ void done(const Unit&) const {}
};

__device__ __forceinline__ unsigned cvt_pk_bf16(float lo, float hi) { unsigned r; asm volatile("v_cvt_pk_bf16_f32 %0, %1, %2" : "=v"(r) : "v"(lo), "v"(hi)); return r; }
typedef float f32x2 __attribute__((ext_vector_type(2)));
#ifdef EPI_NT
#define EPI_ST16(p, v) __builtin_nontemporal_store((v), (p))
#else
#define EPI_ST16(p, v) (*(p) = (v))
#endif
struct EpiZ {
    static constexpr bool PERM = true, AFTER_DRAIN = false;
    bf16_t* O; int ldc;
    __device__ __forceinline__ void operator()(const f32x4 (&acc)[2][2][4][2], const Unit& u, int wr, int wc, int fr, int fq) const {
        const int row0 = u.pm * BM + wr * 64 + fr, col0 = u.pn * BM + wc * 32 + 8 * fq;
#pragma unroll
        for (int ai = 0; ai < 2; ++ai)
#pragma unroll
            for (int m = 0; m < 4; ++m) { bf16_t* rowp = O + (size_t)(row0 + ai * HALF + m * 16) * ldc + col0;
#pragma unroll
                for (int bj = 0; bj < 2; ++bj) { const f32x4 v0 = acc[ai][bj][m][0], v1 = acc[ai][bj][m][1];
                    u32x4 w; w.x = cvt_pk_bf16(v0[0], v0[1]); w.y = cvt_pk_bf16(v0[2], v0[3]); w.z = cvt_pk_bf16(v1[0], v1[1]); w.w = cvt_pk_bf16(v1[2], v1[3]);
                    EPI_ST16((u32x4*)(rowp + bj * HALF), w); } }
    }
};
__device__ __forceinline__ float silu_mul(float g, float u) { return g * __builtin_amdgcn_rcpf(1.0f + __builtin_amdgcn_exp2f(g * -1.4426950408889634f)) * u; }
__device__ __forceinline__ f32x2 silu_mul2(f32x2 g, f32x2 u) {
    const f32x2 t = g * -1.4426950408889634f;
    f32x2 d = {__builtin_amdgcn_exp2f(t.x), __builtin_amdgcn_exp2f(t.y)}; d = d + 1.0f;
    const f32x2 r = {__builtin_amdgcn_rcpf(d.x), __builtin_amdgcn_rcpf(d.y)};
    return (g * u) * r;
}
__device__ __forceinline__ unsigned glu_pk(f32x2 a, f32x2 g) {
    const f32x2 t = g * -1.4426950408889634f;
    f32x2 d = {__builtin_amdgcn_exp2f(t.x), __builtin_amdgcn_exp2f(t.y)}; d = d + 1.0f;
    const f32x2 r = {__builtin_amdgcn_rcpf(d.x), __builtin_amdgcn_rcpf(d.y)};
    const f32x2 o = a * r; return cvt_pk_bf16(o.x, o.y);
}
__device__ __forceinline__ unsigned silu_pk(f32x2 g, f32x2 u) { const f32x2 o = silu_mul2(g, u); return cvt_pk_bf16(o.x, o.y); }
struct EpiSwiGLU {
    static constexpr bool PERM = true, AFTER_DRAIN = false;
    bf16_t* O; int ldc;
    __device__ __forceinline__ void operator()(const f32x4 (&acc)[2][2][4][2], const Unit& u, int wr, int wc, int fr, int fq) const {
        const int row0 = u.pm * BM + wr * 64 + fr, col0 = u.pn * HALF + wc * 32 + 8 * fq;
#pragma unroll
        for (int ai = 0; ai < 2; ++ai)
#pragma unroll
            for (int m = 0; m < 4; ++m) { bf16_t* rowp = O + (size_t)(row0 + ai * HALF + m * 16) * ldc + col0;
                const f32x4 g0 = acc[ai][0][m][0], g1 = acc[ai][0][m][1], u0 = acc[ai][1][m][0], u1 = acc[ai][1][m][1];
                u32x4 w; w.x = silu_pk((f32x2){g0[0], g0[1]}, (f32x2){u0[0], u0[1]}); w.y = silu_pk((f32x2){g0[2], g0[3]}, (f32x2){u0[2], u0[3]});
                w.z = silu_pk((f32x2){g1[0], g1[1]}, (f32x2){u1[0], u1[1]}); w.w = silu_pk((f32x2){g1[2], g1[3]}, (f32x2){u1[2], u1[3]});
                EPI_ST16((u32x4*)rowp, w); }
    }
};
template <bool HALFN> struct EpiResid {
    static constexpr bool PERM = false, AFTER_DRAIN = false;
    const float* base_c; const float* base_l; float* out; const float* gate;
    __device__ __forceinline__ void operator()(const f32x4 (&acc)[2][2][4][2], const Unit& u, int wr, int wc, int fr, int fq) const {
        constexpr int NBJ = HALFN ? 1 : 2;
        const int row0 = u.pm * BM + wr * 64 + fr, col0 = u.pn * (HALFN ? HALF : BM) + wc * 32 + 4 * fq;
        const int mb = u.pm < 16 ? 0 : 1 + ((u.pm - 16) >> 4);
        const float* gp = gate + (size_t)mb * 12288 + col0; const float* bp = u.pm < 16 ? base_c : base_l;
        f32x4 gv[NBJ][2];
#pragma unroll
        for (int bj = 0; bj < NBJ; ++bj)
#pragma unroll
            for (int n = 0; n < 2; ++n) gv[bj][n] = *(const f32x4*)(gp + bj * HALF + n * 16);
        constexpr int NB = 4, PER = 2 * NBJ * 2;
        f32x4 bs[2][PER];
#define EPR_LOAD(b_, buf_) do { _Pragma("unroll") for (int g2 = 0; g2 < 2; ++g2) { const int grp = (b_) * 2 + g2, ai = grp >> 2, m = grp & 3; const size_t off = (size_t)(row0 + ai * HALF + m * 16) * 2048 + col0; \
        _Pragma("unroll") for (int bj = 0; bj < NBJ; ++bj) _Pragma("unroll") for (int n = 0; n < 2; ++n) bs[buf_][(g2 * NBJ + bj) * 2 + n] = *(const f32x4*)(bp + off + bj * HALF + n * 16); } } while (0)
#define EPR_STORE(b_, buf_) do { _Pragma("unroll") for (int g2 = 0; g2 < 2; ++g2) { const int grp = (b_) * 2 + g2, ai = grp >> 2, m = grp & 3; const size_t off = (size_t)(row0 + ai * HALF + m * 16) * 2048 + col0; \
        _Pragma("unroll") for (int bj = 0; bj < NBJ; ++bj) _Pragma("unroll") for (int n = 0; n < 2; ++n) *(f32x4*)(out + off + bj * HALF + n * 16) = bs[buf_][(g2 * NBJ + bj) * 2 + n] + gv[bj][n] * acc[ai][bj][m][n]; } } while (0)
        EPR_LOAD(0, 0);
        EPR_LOAD(1, 1); EPR_STORE(0, 0);
        EPR_LOAD(2, 0); EPR_STORE(1, 1);
        EPR_LOAD(3, 1); EPR_STORE(2, 0);
        EPR_STORE(3, 1);
        static_assert(NB == 4, "pipeline written out for 4 batches");
#undef EPR_LOAD
#undef EPR_STORE
    }
};
struct HeadOrder : StaticOrder {
    int Lmax;
    __host__ __device__ bool next(int i, Unit& u) const { const long L = (long)i * G + c; if (L >= Lmax) return false; return StaticOrder::next(i, u); }
};
struct TailHalfOrder : StaticOrder {
    int Lmin;
    __host__ __device__ bool next(int i, Unit& u) const {
        const int nrem = nwg - Lmin; const long idx = (long)i * G + c; if (idx >= 2L * nrem) return false;
        const int L = Lmin + (int)(idx % nrem), half = (int)(idx / nrem);
        StaticOrder t = *this; t.G = 1; t.c = 0; Unit f; t.StaticOrder::next(L, f);
        u.pm = f.pm; u.pn = 2 * f.pn + half; return true;
    }
};

struct EpiResidB {
    static constexpr bool PERM = true, AFTER_DRAIN = false;
    const float* basef_c; const float* basef_l; const bf16_t* baseb; bf16_t* outb; float* outf; const float* gate; int mode;
    template <bool BF32, bool OF32> __device__ __forceinline__ void run(const f32x4 (&acc)[2][2][4][2], const Unit& u, int wr, int wc, int fr, int fq) const {
        const int row0 = u.pm * BM + wr * 64 + fr, col0 = u.pn * BM + wc * 32 + 8 * fq;
        const int mb = u.pm < 16 ? 0 : 1 + ((u.pm - 16) >> 4);
        const float* gp = gate + (size_t)mb * 12288 + col0; const float* bp = u.pm < 16 ? basef_c : basef_l;
        f32x4 gv[2][2];
#pragma unroll
        for (int bj = 0; bj < 2; ++bj)
#pragma unroll
            for (int n = 0; n < 2; ++n) gv[bj][n] = *(const f32x4*)(gp + bj * HALF + 4 * n);
        constexpr int NV = BF32 ? 8 : 4;
        u32x4 raw[2][NV];
#define EPB_LOAD(b_, buf_) do { _Pragma("unroll") for (int g2 = 0; g2 < 2; ++g2) { const int grp = (b_) * 2 + g2, ai = grp >> 2, m = grp & 3; const size_t off = (size_t)(row0 + ai * HALF + m * 16) * 2048 + col0; \
        _Pragma("unroll") for (int bj = 0; bj < 2; ++bj) { if constexpr (BF32) { raw[buf_][(g2 * 2 + bj) * 2] = *(const u32x4*)(bp + off + bj * HALF); raw[buf_][(g2 * 2 + bj) * 2 + 1] = *(const u32x4*)(bp + off + bj * HALF + 4); } \
                                                         else raw[buf_][g2 * 2 + bj] = *(const u32x4*)(baseb + off + bj * HALF); } } } while (0)
#define EPB_STORE(b_, buf_) do { _Pragma("unroll") for (int g2 = 0; g2 < 2; ++g2) { const int grp = (b_) * 2 + g2, ai = grp >> 2, m = grp & 3; const size_t off = (size_t)(row0 + ai * HALF + m * 16) * 2048 + col0; \
        _Pragma("unroll") for (int bj = 0; bj < 2; ++bj) { f32x4 b0, b1; \
            if constexpr (BF32) { b0 = __builtin_bit_cast(f32x4, raw[buf_][(g2 * 2 + bj) * 2]); b1 = __builtin_bit_cast(f32x4, raw[buf_][(g2 * 2 + bj) * 2 + 1]); } \
            else { const u32x4 w_ = raw[buf_][g2 * 2 + bj]; b0 = (f32x4){__uint_as_float(w_.x << 16), __uint_as_float(w_.x & 0xffff0000u), __uint_as_float(w_.y << 16), __uint_as_float(w_.y & 0xffff0000u)}; \
                   b1 = (f32x4){__uint_as_float(w_.z << 16), __uint_as_float(w_.z & 0xffff0000u), __uint_as_float(w_.w << 16), __uint_as_float(w_.w & 0xffff0000u)}; } \
            const f32x4 r0 = b0 + gv[bj][0] * acc[ai][bj][m][0], r1 = b1 + gv[bj][1] * acc[ai][bj][m][1]; \
            if constexpr (OF32) { *(f32x4*)(outf + off + bj * HALF) = r0; *(f32x4*)(outf + off + bj * HALF + 4) = r1; } \
            else { u32x4 o_; o_.x = cvt_pk_bf16(r0[0], r0[1]); o_.y = cvt_pk_bf16(r0[2], r0[3]); o_.z = cvt_pk_bf16(r1[0], r1[1]); o_.w = cvt_pk_bf16(r1[2], r1[3]); EPI_ST16((u32x4*)(outb + off + bj * HALF), o_); } } } } while (0)
        EPB_LOAD(0, 0);
        EPB_LOAD(1, 1); EPB_STORE(0, 0);
        EPB_LOAD(2, 0); EPB_STORE(1, 1);
        EPB_LOAD(3, 1); EPB_STORE(2, 0);
        EPB_STORE(3, 1);
#undef EPB_LOAD
#undef EPB_STORE
    }
    __device__ __forceinline__ void operator()(const f32x4 (&acc)[2][2][4][2], const Unit& u, int wr, int wc, int fr, int fq) const {
        if (mode == 0) run<true, false>(acc, u, wr, wc, fr, fq); else if (mode == 1) run<false, false>(acc, u, wr, wc, fr, fq); else run<false, true>(acc, u, wr, wc, fr, fq);
    }
};

#ifdef PROBE_P2NULL
struct EpiNull {
    static constexpr bool PERM = true, AFTER_DRAIN = false;
    float* O;
    __device__ __forceinline__ void operator()(const f32x4 (&acc)[2][2][4][2], const Unit& u, int wr, int wc, int fr, int fq) const {
        if (*(const volatile int*)O == 12345) {
#pragma unroll
            for (int ai = 0; ai < 2; ++ai)
#pragma unroll
                for (int bj = 0; bj < 2; ++bj)
#pragma unroll
                    for (int m = 0; m < 4; ++m) { O[((ai * 2 + bj) * 4 + m) * 8 + fr + wr + wc + fq] = acc[ai][bj][m][0][0] + acc[ai][bj][m][1][1] + acc[ai][bj][m][0][2] + acc[ai][bj][m][1][3] + acc[ai][bj][m][0][1] + acc[ai][bj][m][1][0] + acc[ai][bj][m][0][3] + acc[ai][bj][m][1][2]; }
        }
    }
};
#endif
template <int NM, int NN, int GM = WGM, bool REV = false> struct StaticOrderC {
    static_assert(NM % GM == 0, "row tiles in whole groups");
    static_assert(!REV || (NM * NN) % NXCD == 0, "REV is written for equal chunks");
    int G, c;
    __host__ __device__ void init(int G_, int c_) { G = G_; c = c_; }
    __host__ __device__ bool next(int i, Unit& u) const {
        constexpr int nwg = NM * NN, q = nwg / NXCD, r = nwg % NXCD, nig = GM * NN;
        const long L = (long)i * G + c; if (L >= nwg) return false;
        int wgid = (int)L; { const int xcd = wgid % NXCD, off = wgid / NXCD; wgid = (xcd < r ? xcd * (q + 1) : r * (q + 1) + (xcd - r) * q) + (REV ? q - 1 - off : off); }
        const int gid = wgid / nig, fm = gid * GM, rem = wgid % nig;
        u.pm = fm + (rem % GM); u.pn = rem / GM; return true;
    }
    __device__ __forceinline__ void a_ready(const Unit&) const {}
    __device__ __forceinline__ void done(const Unit&) const {}
};

struct EpiQKV {
    static constexpr bool PERM = true, AFTER_DRAIN = false;
    bf16_t* Z; float* out; const float* gains; int l; PG8_LAS float* part;
    static constexpr unsigned OFF_AK = 75497472u, OFF_AV = 79691776u, OFF_BK = 83886080u, OFF_BV = 88080384u;
    __device__ __forceinline__ void operator()(const f32x4 (&acc)[2][2][4][2], const Unit& u, int wr, int wc, int fr_in, int fq_in) const {
        int fr = fr_in, fq = fq_in; asm volatile("" : "+v"(fr), "+v"(fq));
        const int pn = u.pn, row0 = u.pm * BM + wr * 64 + fr;
        const bool ctx = u.pm < 16;
        if (pn >= 10) {
#pragma unroll
            for (int ai = 0; ai < 2; ++ai)
#pragma unroll
                for (int m = 0; m < 4; ++m) { bf16_t* rowp = Z + (size_t)(row0 + ai * HALF + m * 16) * 3584 + 2560 + (pn - 10) * HALF + wc * 32 + 8 * fq;
                    const f32x4 a0 = acc[ai][0][m][0], a1 = acc[ai][0][m][1], g0 = acc[ai][1][m][0], g1 = acc[ai][1][m][1];
                    u32x4 w; w.x = glu_pk((f32x2){a0[0], a0[1]}, (f32x2){g0[0], g0[1]}); w.y = glu_pk((f32x2){a0[2], a0[3]}, (f32x2){g0[2], g0[3]});
                    w.z = glu_pk((f32x2){a1[0], a1[1]}, (f32x2){g1[0], g1[1]}); w.w = glu_pk((f32x2){a1[2], a1[3]}, (f32x2){g1[2], g1[3]});
                    *(u32x4*)rowp = w; }
        } else if (pn == 3 || pn == 9) {
#pragma unroll
            for (int ai = 0; ai < 2; ++ai)
#pragma unroll
                for (int m = 0; m < 4; ++m) { const int R = row0 + ai * HALF + m * 16; bf16_t* rowp = Z + (size_t)R * 3584 + pn * BM + wc * 32 + 8 * fq;
#pragma unroll
                    for (int bj = 0; bj < 2; ++bj) { const f32x4 v0 = acc[ai][bj][m][0], v1 = acc[ai][bj][m][1];
                        u32x4 w; w.x = cvt_pk_bf16(v0[0], v0[1]); w.y = cvt_pk_bf16(v0[2], v0[3]); w.z = cvt_pk_bf16(v1[0], v1[1]); w.w = cvt_pk_bf16(v1[2], v1[3]);
                        *(u32x4*)(rowp + bj * HALF) = w;
                        if (ctx) { const unsigned oo = (pn == 3 ? OFF_AV : OFF_BV) + (unsigned)(((((R >> 8) * 4 + l) * 256 + (R & 255)) * 2 + bj) * 128 + wc * 32 + 8 * fq); float* op = out + oo; *(f32x4*)op = v0; *(f32x4*)(op + 4) = v1; } } }
        } else {
            const bool isK = (pn == 2 || pn == 8);
            const float* g = gains + (pn < 2 ? 0 : pn == 2 ? 128 : pn < 8 ? 256 : 384);
#pragma unroll
            for (int ai = 0; ai < 2; ++ai)
#pragma unroll
                for (int m = 0; m < 4; ++m)
#pragma unroll
                    for (int bj = 0; bj < 2; ++bj) { const f32x4 a = acc[ai][bj][m][0], b = acc[ai][bj][m][1];
                        float s = (a[0] * a[0] + a[1] * a[1]) + (a[2] * a[2] + a[3] * a[3]) + (b[0] * b[0] + b[1] * b[1]) + (b[2] * b[2] + b[3] * b[3]);
                        { auto r_ = __builtin_amdgcn_permlane16_swap(__float_as_uint(s), __float_as_uint(s), false, false); s = __uint_as_float(r_[0]) + __uint_as_float(r_[1]); } { auto r_ = __builtin_amdgcn_permlane32_swap(__float_as_uint(s), __float_as_uint(s), false, false); s = __uint_as_float(r_[0]) + __uint_as_float(r_[1]); }
                        if (fq == 0) part[((ai * HALF + wr * 64 + m * 16 + fr) * 2 + bj) * 4 + wc] = s; }
            __builtin_amdgcn_sched_barrier(0);
            asm volatile("s_waitcnt lgkmcnt(0)" ::: "memory"); __builtin_amdgcn_s_barrier(); asm volatile("" ::: "memory");
            const f32x4 g1 = *(const f32x4*)(g + 16 * wc + 4 * fq), g2 = *(const f32x4*)(g + 64 + 16 * wc + 4 * fq);
            float invr[4];
#pragma unroll
            for (int e = 0; e < 4; ++e) { const int jj = (16 * wc + 4 * fq + e) & 31; invr[e] = __builtin_amdgcn_exp2f(-(float)jj * (13.287712379549449f / 32.0f)) * 0.15915494309189535f; }
#pragma unroll
            for (int ai = 0; ai < 2; ++ai)
#pragma unroll
                for (int m = 0; m < 4; ++m) { const int rl = ai * HALF + wr * 64 + m * 16 + fr, R = u.pm * BM + rl;
                    float cs[4] = {1.f, 1.f, 1.f, 1.f}, sn[4] = {0.f, 0.f, 0.f, 0.f};
                    if (!ctx) { const int t = (R - 4096) & 4095; const float pos = (float)(wc < 2 ? (t >> 6) : (t & 63));
#pragma unroll
                        for (int e = 0; e < 4; ++e) { const float rev = pos * invr[e]; cs[e] = __builtin_amdgcn_cosf(rev); sn[e] = __builtin_amdgcn_sinf(rev); } }
#pragma unroll
                    for (int bj = 0; bj < 2; ++bj) { const f32x4 p = *(const PG8_LAS f32x4*)(part + (rl * 2 + bj) * 4);
                        const float rstd = __builtin_amdgcn_rsqf(((p[0] + p[1]) + (p[2] + p[3])) * (1.0f / 128.0f) + 1e-6f);
                        const f32x4 v1 = acc[ai][bj][m][0] * rstd * g1, v2 = acc[ai][bj][m][1] * rstd * g2;
                        if (isK && ctx) { const unsigned oo = (pn == 2 ? OFF_AK : OFF_BK) + (unsigned)(((((R >> 8) * 4 + l) * 256 + (R & 255)) * 2 + bj) * 128 + 16 * wc + 4 * fq); float* op = out + oo; *(f32x4*)op = v1; *(f32x4*)(op + 64) = v2; }
                        float o1[4], o2[4];
#pragma unroll
                        for (int e = 0; e < 4; e += 2) { const f32x2 a1 = {v1[e], v1[e + 1]}, a2 = {v2[e], v2[e + 1]}, c2 = {cs[e], cs[e + 1]}, s2 = {sn[e], sn[e + 1]};
                            const f32x2 r1 = __builtin_elementwise_fma(a1, c2, -(a2 * s2)), r2 = __builtin_elementwise_fma(a2, c2, a1 * s2);
                            o1[e] = r1.x; o1[e + 1] = r1.y; o2[e] = r2.x; o2[e + 1] = r2.y; }
                        const unsigned q1x = cvt_pk_bf16(o1[0], o1[1]), q1y = cvt_pk_bf16(o1[2], o1[3]), q2x = cvt_pk_bf16(o2[0], o2[1]), q2y = cvt_pk_bf16(o2[2], o2[3]);
                        const auto s0 = __builtin_amdgcn_permlane16_swap(q1x, q2x, false, false); const auto s1 = __builtin_amdgcn_permlane16_swap(q1y, q2y, false, false);
                        u32x4 w; w.x = s0[0]; w.y = s1[0]; w.z = s0[1]; w.w = s1[1];
                        bf16_t* zp = Z + (size_t)R * 3584 + pn * BM + bj * HALF + 16 * wc + ((fq & 1) ? 64 + 4 * (fq - 1) : 4 * fq);
                        *(u32x4*)zp = w; }
                    __builtin_amdgcn_sched_barrier(0); }
        }
    }
};

template <class Epi, class Sched, bool ALIGN_EPI = false, bool SP2 = false, bool HALFN = false  >
__device__ __forceinline__ void gemm_phase(PG8_LAS unsigned char* lds, const Gemm g, const Sched& S, const Epi& E, const int wave_u  ) {
    unsigned lz_ = 0u; asm volatile("" : "+v"(lz_)); int lane_l = (int)__builtin_amdgcn_mbcnt_hi(~0u, __builtin_amdgcn_mbcnt_lo(~0u, lz_));
    const int tid = wave_u * 64 + lane_l, wid = __builtin_amdgcn_readfirstlane(tid >> 6), lane = tid & 63, wr = wid >> 2, wc = wid & 3, fr = lane & 15, fq = lane >> 4;
    static_assert(!HALFN || SP2, "HALFN is written for the SP2 loop only");
    const int K = g.K, nt = K / BK;
    unsigned voffA[2], voffB[2];
#pragma unroll
    for (int i = 0; i < 2; ++i) { int R, C; stage_rc(tid * 16 + i * 8192, R, C); const int Rb = Epi::PERM ? ((R & ~31) + perm32(R & 31)) : R;
        voffA[i] = (unsigned)(R * K + C) * 2u; voffB[i] = (unsigned)(Rb * K + C) * 2u; }
    const size_t kstep = (size_t)(BK * 2);
    const size_t hstep = (size_t)HALF * K * 2;
    const size_t tstep = 2 * hstep;
    const unsigned ldsw = (unsigned)wid * 1024u;
    const int aoff = lds_byte(wr * 64 + fr, fq * 8), boff = lds_byte(wc * 32 + fr, fq * 8);
#define PG8_SA(b, h) (((b) * 2 + (h)) * HTB)
#define PG8_SB(b, h) ((4 + (b) * 2 + (h)) * HTB)
#define PG8_STAGE(bufoff, gbase, voff) do { _Pragma("unroll") for (int _i = 0; _i < 2; ++_i) \
        __builtin_amdgcn_global_load_lds((const unsigned*)((const char*)(gbase) + (voff)[_i]), (PG8_LAS unsigned*)(lds + (bufoff) + ldsw + _i * 8192), 16, 0, 0); } while (0)
#define PG8_LDA(dst, b, h) do { _Pragma("unroll") for (int m = 0; m < 4; ++m) _Pragma("unroll") for (int k = 0; k < 2; ++k) dst[m][k] = *(const PG8_LAS bf16x8*)(lds + PG8_SA(b, h) + aoff + m * 2048 + k * 1024); } while (0)
#define PG8_LDB(dst, b, h) do { _Pragma("unroll") for (int n = 0; n < 2; ++n) _Pragma("unroll") for (int k = 0; k < 2; ++k) dst[n][k] = *(const PG8_LAS bf16x8*)(lds + PG8_SB(b, h) + boff + n * 2048 + k * 1024); } while (0)
#define PG8_MMA(ai, bj, At, Bt) do { __builtin_amdgcn_s_setprio(1); _Pragma("unroll") for (int m = 0; m < 4; ++m) _Pragma("unroll") for (int n = 0; n < 2; ++n) _Pragma("unroll") for (int k = 0; k < 2; ++k) \
        acc[ai][bj][m][n] = __builtin_amdgcn_mfma_f32_16x16x32_bf16(Bt[n][k], At[m][k], acc[ai][bj][m][n], 0, 0, 0); __builtin_amdgcn_s_setprio(0); } while (0)
#define PG8_WAIT_V(n) asm volatile("s_waitcnt vmcnt(" #n ")" ::: "memory")
#define PG8_WAIT_L(n) asm volatile("s_waitcnt lgkmcnt(" #n ")" ::: "memory")
#define PG8_BAR __builtin_amdgcn_s_barrier()
#define PG8_SCHED __builtin_amdgcn_sched_barrier(0)
    Unit cur, nxt; int ui = 0;
    if (!S.next(0, cur)) return;
    f32x4 acc[2][2][4][2];
#pragma unroll
    for (int a = 0; a < 2; ++a)
#pragma unroll
        for (int b = 0; b < 2; ++b)
#pragma unroll
            for (int m = 0; m < 4; ++m)
#pragma unroll
                for (int n = 0; n < 2; ++n) acc[a][b][m][n] = (f32x4){0.f, 0.f, 0.f, 0.f};
    bf16x8 At[4][2], B0[2][2], B1[2][2];
    const char* cA = (const char*)g.A + (size_t)cur.pm * tstep; const char* cB = (const char*)g.Bt + (size_t)cur.pn * (HALFN ? hstep : tstep);
    S.a_ready(cur);
    if constexpr (SP2) {
        PG8_STAGE(PG8_SB(0, 0), cB, voffB); PG8_STAGE(PG8_SB(0, 1), cB + hstep, voffB); PG8_STAGE(PG8_SA(0, 0), cA, voffA); PG8_STAGE(PG8_SA(0, 1), cA + hstep, voffA);
        if (wr == 1) PG8_BAR;
        PG8_WAIT_V(2); PG8_BAR;
        PG8_STAGE(PG8_SB(1, 0), cB + kstep, voffB); PG8_STAGE(PG8_SA(1, 0), cA + kstep, voffA); PG8_STAGE(PG8_SB(1, 1), cB + hstep + kstep, voffB);
        PG8_WAIT_V(6); PG8_BAR;
    } else {
        PG8_STAGE(PG8_SB(0, 0), cB, voffB); PG8_STAGE(PG8_SA(0, 0), cA, voffA); PG8_STAGE(PG8_SB(0, 1), cB + hstep, voffB); PG8_STAGE(PG8_SA(0, 1), cA + hstep, voffA);
        if (wr == 1) PG8_BAR;
        PG8_WAIT_V(4); PG8_BAR;
        PG8_STAGE(PG8_SB(1, 0), cB + kstep, voffB); PG8_STAGE(PG8_SA(1, 0), cA + kstep, voffA); PG8_STAGE(PG8_SB(1, 1), cB + hstep + kstep, voffB);
        PG8_WAIT_V(6); PG8_BAR;
    }
    for (;;) {
        const bool has_next = S.next(ui + 1, nxt);
        const char* nA = has_next ? (const char*)g.A + (size_t)nxt.pm * tstep : cA; const char* nB = has_next ? (const char*)g.Bt + (size_t)nxt.pn * (HALFN ? hstep : tstep) : cB;
        for (int t = 0; t < nt; t += 2) {
            const bool last = (t == nt - 2);
            const char* a1 = cA + (size_t)(t + 1) * kstep;
            const char* a2 = last ? nA : cA + (size_t)(t + 2) * kstep; const char* b2 = last ? nB : cB + (size_t)(t + 2) * kstep;
            const char* a3 = a2 + kstep; const char* b3 = b2 + kstep;
            if (last && has_next) S.a_ready(nxt);
            if constexpr (SP2) {
            PG8_LDB(B0, 0, 0); if constexpr (!HALFN) PG8_LDB(B1, 0, 1); PG8_SCHED; PG8_LDA(At, 0, 0); PG8_STAGE(PG8_SA(1, 1), a1 + hstep, voffA);
            PG8_WAIT_V(8); PG8_WAIT_L(0); PG8_BAR; PG8_MMA(0, 0, At, B0); if constexpr (!HALFN) PG8_MMA(0, 1, At, B1); PG8_BAR; PG8_SCHED;
            PG8_LDA(At, 0, 1); PG8_STAGE(PG8_SB(0, 0), b2, voffB); PG8_STAGE(PG8_SB(0, 1), b2 + hstep, voffB); PG8_STAGE(PG8_SA(0, 0), a2, voffA);
            PG8_WAIT_V(8); PG8_WAIT_L(0); PG8_BAR; PG8_MMA(1, 0, At, B0); if constexpr (!HALFN) PG8_MMA(1, 1, At, B1); PG8_BAR; PG8_SCHED;
            PG8_LDB(B0, 1, 0); if constexpr (!HALFN) PG8_LDB(B1, 1, 1); PG8_SCHED; PG8_LDA(At, 1, 0); PG8_STAGE(PG8_SA(0, 1), a2 + hstep, voffA);
            PG8_WAIT_V(8); PG8_WAIT_L(0); PG8_BAR; PG8_MMA(0, 0, At, B0); if constexpr (!HALFN) PG8_MMA(0, 1, At, B1); PG8_BAR; PG8_SCHED;
            PG8_LDA(At, 1, 1); PG8_STAGE(PG8_SB(1, 0), b3, voffB); PG8_STAGE(PG8_SB(1, 1), b3 + hstep, voffB); PG8_STAGE(PG8_SA(1, 0), a3, voffA);
            PG8_WAIT_V(8); PG8_WAIT_L(0); PG8_BAR; PG8_MMA(1, 0, At, B0); if constexpr (!HALFN) PG8_MMA(1, 1, At, B1); PG8_BAR; PG8_SCHED;
            } else {
            PG8_LDB(B0, 0, 0); PG8_SCHED; PG8_LDA(At, 0, 0); PG8_STAGE(PG8_SA(1, 1), a1 + hstep, voffA);
            PG8_WAIT_L(8); PG8_BAR; PG8_WAIT_L(0); PG8_MMA(0, 0, At, B0); PG8_BAR; PG8_SCHED;
            PG8_LDB(B1, 0, 1); PG8_STAGE(PG8_SB(0, 0), b2, voffB);
            PG8_BAR; PG8_WAIT_L(0); PG8_MMA(0, 1, At, B1); PG8_BAR;
            PG8_LDA(At, 0, 1); PG8_STAGE(PG8_SA(0, 0), a2, voffA);
            PG8_BAR; PG8_WAIT_L(0); PG8_MMA(1, 0, At, B0); PG8_BAR; PG8_SCHED;
            PG8_STAGE(PG8_SB(0, 1), b2 + hstep, voffB);
            PG8_WAIT_V(6); PG8_BAR; PG8_MMA(1, 1, At, B1); PG8_BAR;
            PG8_LDB(B0, 1, 0); PG8_SCHED; PG8_LDA(At, 1, 0); PG8_STAGE(PG8_SA(0, 1), a2 + hstep, voffA);
            PG8_WAIT_L(8); PG8_BAR; PG8_WAIT_L(0); PG8_MMA(0, 0, At, B0); PG8_BAR; PG8_SCHED;
            PG8_LDB(B1, 1, 1); PG8_STAGE(PG8_SB(1, 0), b3, voffB);
            PG8_BAR; PG8_WAIT_L(0); PG8_MMA(0, 1, At, B1); PG8_BAR;
            PG8_LDA(At, 1, 1); PG8_STAGE(PG8_SA(1, 0), a3, voffA);
            PG8_BAR; PG8_WAIT_L(0); PG8_MMA(1, 0, At, B0); PG8_BAR; PG8_SCHED;
            PG8_STAGE(PG8_SB(1, 1), b3 + hstep, voffB);
            PG8_WAIT_V(6); PG8_BAR; PG8_MMA(1, 1, At, B1); PG8_BAR;
            }
        }
        if constexpr (ALIGN_EPI) { if (wr == 0) PG8_BAR; }
        if constexpr (!Epi::AFTER_DRAIN) { E(acc, cur, wr, wc, fr, fq); S.done(cur); }
        if (!has_next) break;
#pragma unroll
        for (int a = 0; a < 2; ++a)
#pragma unroll
            for (int b = 0; b < 2; ++b)
#pragma unroll
                for (int m = 0; m < 4; ++m)
#pragma unroll
                    for (int n = 0; n < 2; ++n) acc[a][b][m][n] = (f32x4){0.f, 0.f, 0.f, 0.f};
        cur = nxt; cA = nA; cB = nB; ++ui;
        if constexpr (ALIGN_EPI) { if (wr == 1) PG8_BAR; }
    }
    PG8_WAIT_V(0);
    if constexpr (!ALIGN_EPI) { if (wr == 0) PG8_BAR; }
    PG8_BAR;
    if constexpr (Epi::AFTER_DRAIN) { E.fused(acc, cur, wr, wc, fr, fq, lds, wid, lane); S.done(cur); }
#undef PG8_SA
#undef PG8_SB
#undef PG8_STAGE
#undef PG8_LDA
#undef PG8_LDB
#undef PG8_MMA
#undef PG8_WAIT_V
#undef PG8_WAIT_L
#undef PG8_BAR
#undef PG8_SCHED
}
}
#define LAS __attribute__((address_space(3)))
#define XB_TMO      128
#define XB_XCNT(j)  (256  + 64 * (j))
#define XB_XSUB(j)  (1280 + 64 * (j))
#define XB_XGEN(j)  (2304 + 64 * (j))
#define XB_TOP      3328
#define XB_TOPGEN   3392
#define XCD_BAR_WORDS 3456
#define XB_SPIN_CAP (1u << 18)

__device__ __forceinline__ unsigned xb_ld(unsigned* p)              { return __hip_atomic_load(p, __ATOMIC_RELAXED, __HIP_MEMORY_SCOPE_AGENT); }
__device__ __forceinline__ unsigned xb_add(unsigned* p, unsigned v) { return __hip_atomic_fetch_add(p, v, __ATOMIC_RELAXED, __HIP_MEMORY_SCOPE_AGENT); }
__device__ __forceinline__ unsigned xb_xcc_id() { return (unsigned)__builtin_amdgcn_s_getreg((3 << 11) | 20) & 0xFu; }
#define XB_SPIN(cond, bar) do { unsigned _sp = 0; while (cond) { __builtin_amdgcn_s_sleep(1); \
    if ((++_sp & 255u) == 0u) { if (xb_ld(&(bar)[XB_TMO])) break; if (_sp > XB_SPIN_CAP) { atomicAdd(&(bar)[XB_TMO], 1u); break; } } } } while (0)

struct XcdBarrier {
    unsigned* bar; unsigned x;
    volatile LAS unsigned* st;
};

__device__ __forceinline__ XcdBarrier xcd_barrier_post(unsigned* bar, volatile LAS unsigned* st) {
    XcdBarrier b; b.bar = bar; b.x = xb_xcc_id(); b.st = st;
    if (threadIdx.x == 0) (void)xb_add(&bar[XB_XCNT(b.x)], 1u);
    return b;
}
__device__ __forceinline__ void xcd_barrier_complete(unsigned* bar, unsigned x, unsigned& nloc, unsigned& nx) {
    const unsigned G = gridDim.x * gridDim.y * gridDim.z;
    unsigned sum, cnt, mine, sp = 0u;
    for (;;) {
        sum = 0u; cnt = 0u; mine = 0u;
#pragma unroll
        for (unsigned j = 0; j < 16; ++j) { const unsigned c = xb_ld(&bar[XB_XCNT(j)]); sum += c; cnt += (c > 0u) ? 1u : 0u; mine = (j == x) ? c : mine; }
        if (sum == G) break;
        __builtin_amdgcn_s_sleep(1);
        if ((++sp & 255u) == 0u) { if (xb_ld(&bar[XB_TMO])) break; if (sp > XB_SPIN_CAP) { atomicAdd(&bar[XB_TMO], 1u); break; } }
    }
    nloc = mine > 0u ? mine : 1u; nx = cnt > 0u ? cnt : 1u;
}

__device__ __forceinline__ void xcd_barrier(const XcdBarrier& b) {
    unsigned* bar_u = b.bar; asm volatile("" : "+s"(bar_u));
    asm volatile("s_waitcnt vmcnt(0)" ::: "memory");
    __syncthreads();
    if (threadIdx.x == 0) {
        unsigned* bar = bar_u; const unsigned bx_ = xb_xcc_id();
        __builtin_amdgcn_s_waitcnt(0);
        unsigned nloc = b.st[0], nx = b.st[1];
        if (nloc == 0u) { xcd_barrier_complete(bar, bx_, nloc, nx); b.st[0] = nloc; b.st[1] = nx; }
        const unsigned old = xb_add(&bar[XB_XSUB(bx_)], 1u);
        const unsigned gen = old / nloc;
        if (old + 1u == (gen + 1u) * nloc) {
            __builtin_amdgcn_fence(__ATOMIC_RELEASE, "agent");
            asm volatile("s_waitcnt vmcnt(0)" ::: "memory");
            const unsigned og = xb_add(&bar[XB_TOP], 1u);
            const unsigned tg = og / nx;
            if (og + 1u == (tg + 1u) * nx) xb_add(&bar[XB_TOPGEN], 1u);
            else XB_SPIN(xb_ld(&bar[XB_TOPGEN]) == tg, bar);
            __builtin_amdgcn_fence(__ATOMIC_ACQUIRE, "agent");
            xb_add(&bar[XB_XGEN(bx_)], 1u);
            asm volatile("s_waitcnt vmcnt(0)" ::: "memory");
        } else {
            XB_SPIN(xb_ld(&bar[XB_XGEN(bx_)]) == gen, bar);
            __builtin_amdgcn_fence(__ATOMIC_ACQUIRE, "agent");
            asm volatile("s_waitcnt vmcnt(0)" ::: "memory");
        }
    }
    __syncthreads();
}
namespace att {
#define ATT_LAS __attribute__((address_space(3)))
#define ATT_GAS __attribute__((address_space(1)))
typedef unsigned short bf16_t;
typedef short bf16x8 __attribute__((ext_vector_type(8)));
typedef short s16x4 __attribute__((ext_vector_type(4)));
typedef float f32x16 __attribute__((ext_vector_type(16)));
typedef unsigned u32x4 __attribute__((ext_vector_type(4)));
constexpr int D = 128, NW = 8, QBLK = 32, KVBLK = 64;
constexpr float SCALE = 0.088388347648318440f, THR = 8.f, LOG2E = 1.4426950408889634f, QSCALE = SCALE * LOG2E  , THRL = THR * LOG2E;
constexpr int SHM_V = KVBLK * D * 2, SHM_K = KVBLK * D * 2, NBUF = 3, SHM_ATTN = NBUF * (SHM_V + SHM_K) + NW * 64 * 4;
#define KSWZ(row, colB) ((row) * 256 + ((colB) ^ (((row) & 7) << 4)))
#define SBAR() __builtin_amdgcn_sched_barrier(0)
__device__ __forceinline__ int crow(int r, int hi) { return (r & 3) + 8 * (r >> 2) + 4 * hi; }
__device__ __forceinline__ unsigned cvtpk(float lo, float hi) { unsigned r; asm volatile("v_cvt_pk_bf16_f32 %0, %1, %2" : "=v"(r) : "v"(lo), "v"(hi)); return r; }
__device__ __forceinline__ void partialSM(f32x16& p0, f32x16& p1, float& m_reg, float& mn, float& alpha) {
  float pmax = p0[0];
#pragma unroll
  for (int r = 1; r < 16; ++r) pmax = fmaxf(pmax, p0[r]);
#pragma unroll
  for (int r = 0; r < 16; ++r) pmax = fmaxf(pmax, p1[r]);
  { auto rr = __builtin_amdgcn_permlane32_swap(__float_as_uint(pmax), __float_as_uint(pmax), false, false);
    pmax = fmaxf(__uint_as_float(rr[0]), __uint_as_float(rr[1])); }
  pmax = fmaxf(pmax, -1e30f);
  mn = pmax; alpha = 1.f; m_reg = pmax;
#pragma unroll
  for (int r = 0; r < 16; ++r) p0[r] -= pmax;
#pragma unroll
  for (int r = 0; r < 16; ++r) p1[r] -= pmax;
#pragma unroll
  for (int r = 0; r < 16; ++r) p0[r] = __builtin_amdgcn_exp2f(p0[r]);
}
__device__ __forceinline__ void finishSM(f32x16& p0, f32x16& p1, float alpha, float& l_reg, bf16x8& pa0, bf16x8& pa1, bf16x8& pa2, bf16x8& pa3) {
#pragma unroll
  for (int r = 0; r < 16; ++r) p1[r] = __builtin_amdgcn_exp2f(p1[r]);
  float ps = 0;
#pragma unroll
  for (int r = 0; r < 16; ++r) ps += p0[r];
#pragma unroll
  for (int r = 0; r < 16; ++r) ps += p1[r];
  { auto rr = __builtin_amdgcn_permlane32_swap(__float_as_uint(ps), __float_as_uint(ps), false, false);
    ps = __uint_as_float(rr[0]) + __uint_as_float(rr[1]); }
  l_reg = l_reg * alpha + ps;
#define PK4(P, BASE, OUT) do { u32x4 w = {cvtpk(P[BASE + 0], P[BASE + 1]), cvtpk(P[BASE + 2], P[BASE + 3]), cvtpk(P[BASE + 4], P[BASE + 5]), cvtpk(P[BASE + 6], P[BASE + 7])}; \
    OUT = *reinterpret_cast<bf16x8*>(&w); } while (0)
  PK4(p0, 0, pa0); PK4(p0, 8, pa1); PK4(p1, 0, pa2); PK4(p1, 8, pa3);
#undef PK4
}
__device__ __forceinline__ void mask_win(f32x16& p0, f32x16& p1, int dq) {
  unsigned nb_ = 0xff800000u; asm volatile("" : "+s"(nb_)); const float NEG = __uint_as_float(nb_);
#pragma unroll
  for (int r = 0; r < 16; ++r) { const int c = (r & 3) + 8 * (r >> 2);
    if ((unsigned)(dq - c) >= 257u) p0[r] = NEG;
    if ((unsigned)(dq - c - 32) >= 257u) p1[r] = NEG; }
}
template <int OFF> __device__ __forceinline__ bf16x8 k_rd(int a) { bf16x8 r; asm volatile("ds_read_b128 %0, %1 offset:%2" : "=v"(r) : "v"(a), "i"(OFF) : "memory"); return r; }
#define TIE2(N, A, B) asm volatile("s_waitcnt lgkmcnt(" #N ")" : "+v"(A), "+v"(B))
#define QK_MMA(X0, X1, D) do { p0 = __builtin_amdgcn_mfma_f32_32x32x16_bf16(X0, qr[D], p0, 0, 0, 0); p1 = __builtin_amdgcn_mfma_f32_32x32x16_bf16(X1, qr[D], p1, 0, 0, 0); } while (0)
template <int KB> __device__ __forceinline__ void qkt(f32x16& p0, f32x16& p1, int ka0, int ka1, int ka2, int ka3, const bf16x8* qr, const f32x16& negm) {
#ifdef QK_DEPTH3
  bf16x8 a0 = k_rd<KB>(ka0), a1 = k_rd<KB + 8192>(ka0);
  bf16x8 b0 = k_rd<KB>(ka1), b1 = k_rd<KB + 8192>(ka1);
  bf16x8 c0 = k_rd<KB>(ka2), c1 = k_rd<KB + 8192>(ka2);
  TIE2(4, a0, a1); p0 = __builtin_amdgcn_mfma_f32_32x32x16_bf16(a0, qr[0], negm, 0, 0, 0); p1 = __builtin_amdgcn_mfma_f32_32x32x16_bf16(a1, qr[0], negm, 0, 0, 0); a0 = k_rd<KB>(ka3); a1 = k_rd<KB + 8192>(ka3);
  TIE2(4, b0, b1); QK_MMA(b0, b1, 1); b0 = k_rd<KB + 128>(ka0); b1 = k_rd<KB + 128 + 8192>(ka0);
  TIE2(4, c0, c1); QK_MMA(c0, c1, 2); c0 = k_rd<KB + 128>(ka1); c1 = k_rd<KB + 128 + 8192>(ka1);
  TIE2(4, a0, a1); QK_MMA(a0, a1, 3); a0 = k_rd<KB + 128>(ka2); a1 = k_rd<KB + 128 + 8192>(ka2);
  TIE2(4, b0, b1); QK_MMA(b0, b1, 4); b0 = k_rd<KB + 128>(ka3); b1 = k_rd<KB + 128 + 8192>(ka3);
  TIE2(4, c0, c1); QK_MMA(c0, c1, 5);
  TIE2(2, a0, a1); QK_MMA(a0, a1, 6);
  TIE2(0, b0, b1); QK_MMA(b0, b1, 7);
#else
  bf16x8 a0 = k_rd<KB>(ka0), a1 = k_rd<KB + 8192>(ka0);
  bf16x8 b0 = k_rd<KB>(ka1), b1 = k_rd<KB + 8192>(ka1);
  TIE2(2, a0, a1); p0 = __builtin_amdgcn_mfma_f32_32x32x16_bf16(a0, qr[0], negm, 0, 0, 0); p1 = __builtin_amdgcn_mfma_f32_32x32x16_bf16(a1, qr[0], negm, 0, 0, 0); a0 = k_rd<KB>(ka2); a1 = k_rd<KB + 8192>(ka2);
  TIE2(2, b0, b1); QK_MMA(b0, b1, 1); b0 = k_rd<KB>(ka3); b1 = k_rd<KB + 8192>(ka3);
  TIE2(2, a0, a1); QK_MMA(a0, a1, 2); a0 = k_rd<KB + 128>(ka0); a1 = k_rd<KB + 128 + 8192>(ka0);
  TIE2(2, b0, b1); QK_MMA(b0, b1, 3); b0 = k_rd<KB + 128>(ka1); b1 = k_rd<KB + 128 + 8192>(ka1);
  TIE2(2, a0, a1); QK_MMA(a0, a1, 4); a0 = k_rd<KB + 128>(ka2); a1 = k_rd<KB + 128 + 8192>(ka2);
  TIE2(2, b0, b1); QK_MMA(b0, b1, 5); b0 = k_rd<KB + 128>(ka3); b1 = k_rd<KB + 128 + 8192>(ka3);
  TIE2(2, a0, a1); QK_MMA(a0, a1, 6);
  TIE2(0, b0, b1); QK_MMA(b0, b1, 7);
#endif
}
#undef QK_MMA
__device__ __forceinline__ int v_st(int k, int c) { return ((k >> 3) * 4 + (c >> 5)) * 512 + ((k & 7) * 32 + (c & 31)) * 2; }
__device__ __forceinline__ int v_rd_base(int lane) { return ((lane & 3) << 3) | (((lane >> 2) & 3) << 6) | (((lane >> 4) & 1) << 5) | (((lane >> 5) & 1) << 8); }
constexpr int v_rd_off(int d0, int ks, int half) { return d0 * 512 + ks * 4096 + half * 2048; }
template <int OFF> __device__ __forceinline__ s16x4 tr_read(int vb) {
  s16x4 r; asm volatile("ds_read_b64_tr_b16 %0, %1 offset:%2" : "=v"(r) : "v"(vb), "i"(OFF) : "memory"); return r;
}
struct VFrag { s16x4 v0, v1, v2, v3, v4, v5, v6, v7; };
#define V_RD0(F, vb) do { F.v0 = tr_read<v_rd_off(0, 0, 0)>(vb); F.v1 = tr_read<v_rd_off(0, 0, 1)>(vb); F.v2 = tr_read<v_rd_off(0, 1, 0)>(vb); F.v3 = tr_read<v_rd_off(0, 1, 1)>(vb); \
    F.v4 = tr_read<v_rd_off(0, 2, 0)>(vb); F.v5 = tr_read<v_rd_off(0, 2, 1)>(vb); F.v6 = tr_read<v_rd_off(0, 3, 0)>(vb); F.v7 = tr_read<v_rd_off(0, 3, 1)>(vb); } while (0)
#define PK(L, H) (bf16x8){L[0], L[1], L[2], L[3], H[0], H[1], H[2], H[3]}
template <int D0> __device__ __forceinline__ void pv_blk(f32x16& od, VFrag& f, int vb, bf16x8 pa0, bf16x8 pa1, bf16x8 pa2, bf16x8 pa3) {
  if constexpr (D0 < 3) {
    TIE2(6, f.v0, f.v1); od = __builtin_amdgcn_mfma_f32_32x32x16_bf16(pa0, PK(f.v0, f.v1), od, 0, 0, 0); f.v0 = tr_read<v_rd_off(D0 + 1, 0, 0)>(vb); f.v1 = tr_read<v_rd_off(D0 + 1, 0, 1)>(vb);
    TIE2(6, f.v2, f.v3); od = __builtin_amdgcn_mfma_f32_32x32x16_bf16(pa1, PK(f.v2, f.v3), od, 0, 0, 0); f.v2 = tr_read<v_rd_off(D0 + 1, 1, 0)>(vb); f.v3 = tr_read<v_rd_off(D0 + 1, 1, 1)>(vb);
    TIE2(6, f.v4, f.v5); od = __builtin_amdgcn_mfma_f32_32x32x16_bf16(pa2, PK(f.v4, f.v5), od, 0, 0, 0); f.v4 = tr_read<v_rd_off(D0 + 1, 2, 0)>(vb); f.v5 = tr_read<v_rd_off(D0 + 1, 2, 1)>(vb);
    TIE2(6, f.v6, f.v7); od = __builtin_amdgcn_mfma_f32_32x32x16_bf16(pa3, PK(f.v6, f.v7), od, 0, 0, 0); f.v6 = tr_read<v_rd_off(D0 + 1, 3, 0)>(vb); f.v7 = tr_read<v_rd_off(D0 + 1, 3, 1)>(vb);
  } else {
    TIE2(6, f.v0, f.v1); od = __builtin_amdgcn_mfma_f32_32x32x16_bf16(pa0, PK(f.v0, f.v1), od, 0, 0, 0);
    TIE2(4, f.v2, f.v3); od = __builtin_amdgcn_mfma_f32_32x32x16_bf16(pa1, PK(f.v2, f.v3), od, 0, 0, 0);
    TIE2(2, f.v4, f.v5); od = __builtin_amdgcn_mfma_f32_32x32x16_bf16(pa2, PK(f.v4, f.v5), od, 0, 0, 0);
    TIE2(0, f.v6, f.v7); od = __builtin_amdgcn_mfma_f32_32x32x16_bf16(pa3, PK(f.v6, f.v7), od, 0, 0, 0);
  }
}
__device__ __forceinline__ void pv_d0(f32x16* o, VFrag& f, int vb, bf16x8 pa0, bf16x8 pa1, bf16x8 pa2, bf16x8 pa3) {
  pv_blk<0>(o[0], f, vb, pa0, pa1, pa2, pa3); pv_blk<1>(o[1], f, vb, pa0, pa1, pa2, pa3); pv_blk<2>(o[2], f, vb, pa0, pa1, pa2, pa3); pv_blk<3>(o[3], f, vb, pa0, pa1, pa2, pa3);
}

struct AUnit {
  const bf16_t* Q; const bf16_t* K0; const bf16_t* K1; bf16_t* O;
  int nt0, nt1;
  float sink_l2;
  int mask;
  int qk0;
};
constexpr int LDQ = 3584, LD0 = 256, LD1 = 3584, LDO = 2048, VOFF0 = 2097152, VOFF1 = 256;
struct AStage { bf16x8 vs0, vs1, ks0, ks1; };
template <class Dec> __device__ __forceinline__ bool attn_unit(const AUnit& u, const Dec& D, const int Ln, const bool pre, bf16x8 (&qr)[8], AStage (&sr_)[2], ATT_LAS char* lds, const int wave_u) {
  unsigned lz_ = 0u; asm volatile("" : "+v"(lz_)); int lane_l = (int)__builtin_amdgcn_mbcnt_hi(~0u, __builtin_amdgcn_mbcnt_lo(~0u, lz_));
  const int tid = wave_u * 64 + lane_l, wid = __builtin_amdgcn_readfirstlane(tid >> 6), lane = tid & 63, r32 = lane & 31, hi = lane >> 5;
  ATT_LAS char* V_lds = lds; ATT_LAS char* K_lds = lds + NBUF * SHM_V;
  ATT_LAS float* ws = (ATT_LAS float*)(lds + NBUF * (SHM_V + SHM_K)) + wid * 64; ATT_LAS float* li_l = ws; ATT_LAS float* al_l = ws + 32;
  const int sink_b = __builtin_amdgcn_readfirstlane((int)__float_as_uint(u.sink_l2));
  float m_reg = 0.f, l_reg = 0; f32x16 o[4] = {}; f32x16 negm = {};
#define QLOAD(U_) do { unsigned lzq_ = 0u; asm volatile("" : "+v"(lzq_)); const int lq2_ = (int)__builtin_amdgcn_mbcnt_hi(~0u, __builtin_amdgcn_mbcnt_lo(~0u, lzq_)); \
    const unsigned qob_ = ((unsigned)(wid * QBLK + (lq2_ & 31)) * LDQ + (lq2_ >> 5) * 8) * 2u; const ATT_GAS char* Qw_ = (const ATT_GAS char*)(U_).Q; \
    _Pragma("unroll") for (int d0 = 0; d0 < 8; ++d0) qr[d0] = *reinterpret_cast<const ATT_GAS bf16x8*>(Qw_ + (qob_ + d0 * 32)); } while (0)
  if (!pre) QLOAD(u);
  const int sr = tid >> 4, sc = (tid & 15) * 8, vst0 = v_st(sr, sc), vst1 = v_st(32 + sr, sc), kws = KSWZ(sr, sc * 2);
  const int vb0 = (int)(unsigned)(__UINTPTR_TYPE__)V_lds + v_rd_base(lane);
  const int nt0 = u.nt0, NT = u.nt0 + u.nt1;
  const unsigned offa0 = (unsigned)(sr * LD0 + sc) * 2u, offb0 = offa0 + 64u * LD0, offa1 = (unsigned)(sr * LD1 + sc) * 2u, offb1 = offa1 + 64u * LD1;
#define SLOADU(i, K0_, K1_, NT0_, t) do { const int t_ = (t); const int n0_ = (NT0_); const bool s0_ = t_ < n0_;                                    \
    const ATT_GAS char* kp_ = (const ATT_GAS char*)(s0_ ? (const ATT_GAS bf16_t*)(K0_) + (size_t)t_ * (KVBLK * LD0) : (const ATT_GAS bf16_t*)(K1_) + (size_t)(t_ - n0_) * (KVBLK * LD1)); \
    const ATT_GAS char* vp_ = kp_ + (s0_ ? 2 * VOFF0 : 2 * VOFF1); const unsigned oa_ = s0_ ? offa0 : offa1, ob_ = s0_ ? offb0 : offb1;                \
    sr_[i].vs0 = *reinterpret_cast<const ATT_GAS bf16x8*>(vp_ + oa_); sr_[i].vs1 = *reinterpret_cast<const ATT_GAS bf16x8*>(vp_ + ob_);           \
    sr_[i].ks0 = *reinterpret_cast<const ATT_GAS bf16x8*>(kp_ + oa_); sr_[i].ks1 = *reinterpret_cast<const ATT_GAS bf16x8*>(kp_ + ob_); } while (0)
#define SLOAD(i, t) SLOADU(i, u.K0, u.K1, nt0, t)
#define SLOADN(i, t) do { const int tq_ = (t); if (tq_ > NTm1 && pf) { int lq_ = Ln; asm volatile("" : "+s"(lq_)); AUnit un_; D(lq_, un_); SLOADU(i, un_.K0, un_.K1, un_.nt0, tq_ - NT); } \
    else SLOAD(i, tq_ < NTm1 ? tq_ : NTm1); } while (0)
#define SWRITE(off, i) do { *(ATT_LAS bf16x8*)(V_lds + (off) + vst0) = sr_[i].vs0; *(ATT_LAS bf16x8*)(V_lds + (off) + vst1) = sr_[i].vs1; \
    *(ATT_LAS bf16x8*)(K_lds + (off) + kws) = sr_[i].ks0; *(ATT_LAS bf16x8*)(K_lds + (off) + kws + 32 * 256) = sr_[i].ks1; } while (0)
#define SWAIT() asm volatile("s_waitcnt vmcnt(4)" ::: "memory")
#define RESC(a) do { if (__any((a) < 1.f)) { if (hi == 0) al_l[r32] = (a); asm volatile("s_waitcnt lgkmcnt(0)" ::: "memory"); \
    _Pragma("unroll") for (int d = 0; d < 4; ++d) _Pragma("unroll") for (int r = 0; r < 16; ++r) o[d][r] *= al_l[crow(r, hi)]; } } while (0)
#ifdef NOMASK
#define MASKT(P0_, P1_, t) do { } while (0)
#else
#define MASKT(P0_, P1_, t) do { if (u.mask && (t) >= nt0) mask_win(P0_, P1_, (u.qk0 + wid * QBLK + 128 - ((t) - nt0) * KVBLK) + r32 - 4 * hi); } while (0)
#endif
#define TIE4(N, A, B, C, D) asm volatile("s_waitcnt lgkmcnt(" #N ")" : "+v"(A), "+v"(B), "+v"(C), "+v"(D))
#define PVM0(OD, PA, X, Y) do { OD = __builtin_amdgcn_mfma_f32_32x32x16_bf16(PA, PK(X, Y), OD, 0, 0, 0); } while (0)
#define PVM(OD, PA, X, Y, N) do { TIE2(N, X, Y); OD = __builtin_amdgcn_mfma_f32_32x32x16_bf16(PA, PK(X, Y), OD, 0, 0, 0); } while (0)
#define PVR(X, Y, D0, KS, VB) do { X = tr_read<v_rd_off(D0, KS, 0)>(VB); Y = tr_read<v_rd_off(D0, KS, 1)>(VB); } while (0)
#define BLOCK2(P0_, P1_, MN_, AL_, VB_) do { \
    TIE4(4, vf.v0, vf.v1, vf.v2, vf.v3); PVM0(o[0], pa0, vf.v0, vf.v1); PVR(vf.v0, vf.v1, 1, 0, VB_); float pm_ = fmaxf(fmaxf(P0_[0], P0_[1]), P0_[2]); pm_ = fmaxf(fmaxf(pm_, P0_[3]), P0_[4]); pm_ = fmaxf(fmaxf(pm_, P0_[5]), P0_[6]); pm_ = fmaxf(fmaxf(pm_, P0_[7]), P0_[8]); SBAR(); \
    PVM0(o[0], pa1, vf.v2, vf.v3); PVR(vf.v2, vf.v3, 1, 1, VB_); pm_ = fmaxf(fmaxf(pm_, P0_[9]), P0_[10]); pm_ = fmaxf(fmaxf(pm_, P0_[11]), P0_[12]); pm_ = fmaxf(fmaxf(pm_, P0_[13]), P0_[14]); pm_ = fmaxf(fmaxf(pm_, P0_[15]), P1_[0]); SBAR(); \
    TIE4(4, vf.v4, vf.v5, vf.v6, vf.v7); PVM0(o[0], pa2, vf.v4, vf.v5); PVR(vf.v4, vf.v5, 1, 2, VB_); pm_ = fmaxf(fmaxf(pm_, P1_[1]), P1_[2]); pm_ = fmaxf(fmaxf(pm_, P1_[3]), P1_[4]); pm_ = fmaxf(fmaxf(pm_, P1_[5]), P1_[6]); pm_ = fmaxf(fmaxf(pm_, P1_[7]), P1_[8]); SBAR(); \
    PVM0(o[0], pa3, vf.v6, vf.v7); PVR(vf.v6, vf.v7, 1, 3, VB_); pm_ = fmaxf(fmaxf(pm_, P1_[9]), P1_[10]); pm_ = fmaxf(fmaxf(pm_, P1_[11]), P1_[12]); pm_ = fmaxf(fmaxf(pm_, P1_[13]), P1_[14]); pm_ = fmaxf(pm_, P1_[15]); SBAR(); \
    TIE4(4, vf.v0, vf.v1, vf.v2, vf.v3); PVM0(o[1], pa0, vf.v0, vf.v1); PVR(vf.v0, vf.v1, 2, 0, VB_); const bool keep_ = __all(pm_ <= THRL);   SBAR(); \
    PVM0(o[1], pa1, vf.v2, vf.v3); PVR(vf.v2, vf.v3, 2, 1, VB_); MN_ = m_reg; AL_ = 1.f; if (__builtin_expect(!keep_, 0)) { { auto rr_ = __builtin_amdgcn_permlane32_swap(__float_as_uint(pm_), __float_as_uint(pm_), false, false); pm_ = fmaxf(__uint_as_float(rr_[0]), __uint_as_float(rr_[1])); } const float d_ = fmaxf(pm_, 0.f); \
          \
        asm("v_add_f32 %0, %0, %1" : "+v"(m_reg) : "v"(d_)); asm("v_exp_f32 %0, %1" : "+v"(AL_) : "v"(-d_)); const float nm_ = -m_reg; \
        _Pragma("unroll") for (int r_ = 0; r_ < 16; ++r_) { asm("v_sub_f32 %0, %0, %1" : "+v"(P0_[r_]) : "v"(d_)); asm("v_sub_f32 %0, %0, %1" : "+v"(P1_[r_]) : "v"(d_)); asm("v_mov_b32 %0, %1" : "+v"(negm[r_]) : "v"(nm_)); } MN_ = m_reg; } SBAR(); \
    TIE4(4, vf.v4, vf.v5, vf.v6, vf.v7); PVM0(o[1], pa2, vf.v4, vf.v5); PVR(vf.v4, vf.v5, 2, 2, VB_); P0_[0] = __builtin_amdgcn_exp2f(P0_[0]); P0_[1] = __builtin_amdgcn_exp2f(P0_[1]); SBAR(); \
    PVM0(o[1], pa3, vf.v6, vf.v7); PVR(vf.v6, vf.v7, 2, 3, VB_); P0_[2] = __builtin_amdgcn_exp2f(P0_[2]); P0_[3] = __builtin_amdgcn_exp2f(P0_[3]); SBAR(); \
    TIE4(4, vf.v0, vf.v1, vf.v2, vf.v3); PVM0(o[2], pa0, vf.v0, vf.v1); PVR(vf.v0, vf.v1, 3, 0, VB_); P0_[4] = __builtin_amdgcn_exp2f(P0_[4]); P0_[5] = __builtin_amdgcn_exp2f(P0_[5]); SBAR(); \
    PVM0(o[2], pa1, vf.v2, vf.v3); PVR(vf.v2, vf.v3, 3, 1, VB_); P0_[6] = __builtin_amdgcn_exp2f(P0_[6]); P0_[7] = __builtin_amdgcn_exp2f(P0_[7]); SBAR(); \
    TIE4(4, vf.v4, vf.v5, vf.v6, vf.v7); PVM0(o[2], pa2, vf.v4, vf.v5); PVR(vf.v4, vf.v5, 3, 2, VB_); P0_[8] = __builtin_amdgcn_exp2f(P0_[8]); P0_[9] = __builtin_amdgcn_exp2f(P0_[9]); SBAR(); \
    PVM0(o[2], pa3, vf.v6, vf.v7); PVR(vf.v6, vf.v7, 3, 3, VB_); P0_[10] = __builtin_amdgcn_exp2f(P0_[10]); P0_[11] = __builtin_amdgcn_exp2f(P0_[11]); SBAR(); \
    TIE4(4, vf.v0, vf.v1, vf.v2, vf.v3); PVM0(o[3], pa0, vf.v0, vf.v1); P0_[12] = __builtin_amdgcn_exp2f(P0_[12]); P0_[13] = __builtin_amdgcn_exp2f(P0_[13]); SBAR(); \
    PVM0(o[3], pa1, vf.v2, vf.v3); P0_[14] = __builtin_amdgcn_exp2f(P0_[14]); P0_[15] = __builtin_amdgcn_exp2f(P0_[15]); SBAR(); \
    TIE4(0, vf.v4, vf.v5, vf.v6, vf.v7); PVM0(o[3], pa2, vf.v4, vf.v5);  SBAR(); \
    PVM0(o[3], pa3, vf.v6, vf.v7); asm volatile("" : "+v"(P0_), "+v"(P1_)); SBAR(); } while (0)

  f32x16 pA0, pA1, pB0, pB1; float mnA, mnB, alA, alB; bf16x8 pa0, pa1, pa2, pa3; VFrag vf;
  constexpr int SE = 0, SO = 1, KB = NBUF * SHM_V;
  const int lb = (int)(unsigned)(__UINTPTR_TYPE__)lds;
  const int ka0 = lb + KSWZ(r32, (0 * 16 + hi * 8) * 2), ka1 = lb + KSWZ(r32, (1 * 16 + hi * 8) * 2), ka2 = lb + KSWZ(r32, (2 * 16 + hi * 8) * 2), ka3 = lb + KSWZ(r32, (3 * 16 + hi * 8) * 2);
  const int NTm1 = NT - 1;
  int o_p = 0, o_c = SHM_V, o_n = 2 * SHM_V;
#define ROT() do { const int t_ = o_p; o_p = o_c; o_c = o_n; o_n = t_; } while (0)
  const bool pf = Ln >= 0 && NT >= 4;
  if (!pre) SLOAD(SE, 0);
  SWRITE(0, SE); SLOAD(SE, 1); __syncthreads();
  qkt<KB>(pA0, pA1, ka0, ka1, ka2, ka3, qr, negm); MASKT(pA0, pA1, 0); partialSM(pA0, pA1, m_reg, mnA, alA);
  _Pragma("unroll") for (int r_ = 0; r_ < 16; ++r_) negm[r_] = -m_reg;
  SWRITE(SHM_V, SE); SLOAD(SE, 2 < NTm1 ? 2 : NTm1);
  for (int j = 1; j + 1 < NT; j += 2) {
    __syncthreads();
    SBAR(); qkt<KB>(pB0, pB1, ka0 + o_c, ka1 + o_c, ka2 + o_c, ka3 + o_c, qr, negm);
    finishSM(pA0, pA1, alA, l_reg, pa0, pa1, pa2, pa3); SBAR();
    SWRITE(o_n, SE);
    V_RD0(vf, vb0 + o_p); MASKT(pB0, pB1, j);
    SLOADN(SE, j + 2); SBAR();
    BLOCK2(pB0, pB1, mnB, alB, (vb0 + o_p));
    RESC(alB); ROT();
    __syncthreads();
    SBAR(); qkt<KB>(pA0, pA1, ka0 + o_c, ka1 + o_c, ka2 + o_c, ka3 + o_c, qr, negm);
    finishSM(pB0, pB1, alB, l_reg, pa0, pa1, pa2, pa3); SBAR();
    SWRITE(o_n, SE);
    V_RD0(vf, vb0 + o_p); MASKT(pA0, pA1, j + 1);
    SLOADN(SE, j + 3); SBAR();
    BLOCK2(pA0, pA1, mnA, alA, (vb0 + o_p));
    RESC(alA); ROT();
  }
  __syncthreads();
  SBAR(); qkt<KB>(pB0, pB1, ka0 + o_c, ka1 + o_c, ka2 + o_c, ka3 + o_c, qr, negm);
  finishSM(pA0, pA1, alA, l_reg, pa0, pa1, pa2, pa3); SBAR();
  if (pf) { int lq_ = Ln; asm volatile("" : "+s"(lq_)); AUnit un_; D(lq_, un_); QLOAD(un_); }
  V_RD0(vf, vb0 + o_p); MASKT(pB0, pB1, NT - 1); SBAR();
  BLOCK2(pB0, pB1, mnB, alB, (vb0 + o_p));
  RESC(alB);
  finishSM(pB0, pB1, alB, l_reg, pa0, pa1, pa2, pa3); SBAR();
  V_RD0(vf, vb0 + o_c); pv_d0(o, vf, vb0 + o_c, pa0, pa1, pa2, pa3);
#undef ROT
  l_reg += __builtin_amdgcn_exp2f(__uint_as_float((unsigned)sink_b) - m_reg);
  unsigned lze_ = 0u; asm volatile("" : "+v"(lze_)); const int lane_e = (int)__builtin_amdgcn_mbcnt_hi(~0u, __builtin_amdgcn_mbcnt_lo(~0u, lze_)), r32e = lane_e & 31, hie = lane_e >> 5;
  ATT_LAS float* lie = (ATT_LAS float*)(lds + NBUF * (SHM_V + SHM_K)) + wid * 64;
  if (hie == 0) lie[r32e] = l_reg;
  __syncthreads();
  float rli[16];
#pragma unroll
  for (int r = 0; r < 16; ++r) rli[r] = __builtin_amdgcn_rcpf(lie[crow(r, hie)]);
  constexpr int OST = 272;
  ATT_LAS char* ost = lds + wid * (QBLK * OST);
#pragma unroll
  for (int r = 0; r < 16; r += 2)
#pragma unroll
    for (int d0 = 0; d0 < 4; ++d0) { const unsigned w = cvtpk(o[d0][r] * rli[r], o[d0][r + 1] * rli[r + 1]);
      *(ATT_LAS unsigned short*)(ost + crow(r, hie) * OST + (d0 * 32 + r32e) * 2) = (unsigned short)w;
      *(ATT_LAS unsigned short*)(ost + crow(r + 1, hie) * OST + (d0 * 32 + r32e) * 2) = (unsigned short)(w >> 16); }
  asm volatile("s_waitcnt lgkmcnt(0)" ::: "memory");
  ATT_GAS bf16_t* Ow = (ATT_GAS bf16_t*)u.O + (size_t)(wid * QBLK) * LDO;
#pragma unroll
  for (int i = 0; i < 8; ++i) { const int row = 4 * i + (lane_e >> 4), ch = lane_e & 15;
    const u32x4 v = *(const ATT_LAS u32x4*)(ost + row * OST + ch * 16);
    *(ATT_GAS u32x4*)(Ow + (size_t)row * LDO + ch * 8) = v; }
  return pf;
#undef SLOAD
#undef SLOADU
#undef SLOADN
#undef QLOAD
#undef SWRITE
#undef SWAIT
#undef RESC
#undef MASKT
#undef PK
#undef PVM
#undef PVM0
#undef TIE4
#undef PVR
#undef BLOCK2
}
}
constexpr int NWAVES = 8;
constexpr int DM = 2048, DEPTH = 4, M_CTX = 4096, M_LAT = 32768, M_ALL = 36864, IN_W = 3584, FF = 5632, NGU = 11264, NMODROW = 9, MODW = 12288;
constexpr int COL_QA = 0, COL_KA = 512, COL_VA = 768, COL_QB = 1024, COL_KB = 2048, COL_VB = 2304, COL_CV = 2560, COL_CG = 3072;
constexpr int MIX_OA = 0, MIX_OB = 512, MIX_OC = 1536;
constexpr int CONV_W = 31, C_CH = 512;
constexpr float EPS = 1e-6f;
constexpr size_t MiB = 1u << 20;
constexpr size_t WS_CTL = 0, CTL_ZERO_BYTES = 1 * MiB;
constexpr size_t WS_MOD = 1 * MiB;
constexpr size_t WS_GAINS = 3 * MiB - 65536;
constexpr size_t WS_ROPE = 3 * MiB;
constexpr size_t WS_WIN = 6 * MiB;
constexpr size_t WS_WOUT = 62 * MiB;
constexpr size_t WS_WGU = 94 * MiB;
constexpr size_t WS_WDN = 270 * MiB;
constexpr size_t WS_CACHE = 358 * MiB;
constexpr size_t WS_H = 374 * MiB;
constexpr size_t WS_Z = 518 * MiB;
constexpr size_t WS_MIX = 770 * MiB;
constexpr size_t WS_ACT = WS_Z;
constexpr size_t WS_XB = 914 * MiB;
constexpr size_t WS_END = 1058 * MiB;
static_assert(WS_Z + (size_t)M_ALL * IN_W * 2 == WS_MIX && WS_MIX + (size_t)M_ALL * DM * 2 == WS_XB && WS_ACT + (size_t)M_ALL * FF * 2 == WS_XB && WS_XB + (size_t)M_ALL * DM * 2 == WS_END, "ws map");
static_assert(WS_WIN + (size_t)DEPTH * IN_W * DM * 2 == WS_WOUT && WS_WOUT + (size_t)DEPTH * DM * DM * 2 == WS_WGU && WS_WGU + (size_t)DEPTH * NGU * DM * 2 == WS_WDN && WS_WDN + (size_t)DEPTH * DM * FF * 2 == WS_CACHE, "ws map");
constexpr int CW_BAR = 4096;
constexpr size_t OUT_YP = 0, OUT_YS = 8388608, OUT_AK = 75497472, OUT_AV = 79691776, OUT_BK = 83886080, OUT_BV = 88080384, OUT_TOTAL = 92274688;
static_assert(pg8::EpiQKV::OFF_AK == OUT_AK && pg8::EpiQKV::OFF_AV == OUT_AV && pg8::EpiQKV::OFF_BK == OUT_BK && pg8::EpiQKV::OFF_BV == OUT_BV, "output map");
constexpr int RING_BYTES = 131072, LDSCTL_OFF = RING_BYTES, MISC_OFF = LDSCTL_OFF + 320, XCH_OFF = RING_BYTES + 2048  , LDS_BYTES = 147456;
static_assert(MISC_OFF + 128 <= XCH_OFF && XCH_OFF + 8192 <= LDS_BYTES, "LDS map");

typedef unsigned short bf16;
typedef unsigned v4u __attribute__((ext_vector_type(4)));
typedef unsigned v2u __attribute__((ext_vector_type(2)));
typedef float f32x4 __attribute__((ext_vector_type(4)));
typedef float f32x2 __attribute__((ext_vector_type(2)));
#define LDS_WAIT() asm volatile("s_waitcnt lgkmcnt(0)" ::: "memory")
__device__ __forceinline__ unsigned pk2(float lo, float hi) { unsigned r; asm volatile("v_cvt_pk_bf16_f32 %0, %1, %2" : "=v"(r) : "v"(lo), "v"(hi)); return r; }
__device__ __forceinline__ float bflo(unsigned w) { return __uint_as_float(w << 16); }
__device__ __forceinline__ float bfhi(unsigned w) { return __uint_as_float(w & 0xffff0000u); }
template <int CTRL> __device__ __forceinline__ float dpp_mov(float v) { return __uint_as_float((unsigned)__builtin_amdgcn_update_dpp(0, (int)__float_as_uint(v), CTRL, 0xf, 0xf, true)); }
__device__ __forceinline__ float xsum_rows(float v) {
    { auto r = __builtin_amdgcn_permlane16_swap(__float_as_uint(v), __float_as_uint(v), false, false); v = __uint_as_float(r[0]) + __uint_as_float(r[1]); }
    { auto r = __builtin_amdgcn_permlane32_swap(__float_as_uint(v), __float_as_uint(v), false, false); v = __uint_as_float(r[0]) + __uint_as_float(r[1]); }
    return v;
}
__device__ __forceinline__ float wave_sum(float v) {
    v += dpp_mov<0xB1>(v);
    v += dpp_mov<0x4E>(v);
    v += dpp_mov<0x141>(v);
    v += dpp_mov<0x140>(v);
    return xsum_rows(v);
}

struct Args { const float* in[26]; float* out; unsigned char* ws; };
enum { I_XP = 0, I_XS, I_CAK, I_CAV, I_CBK, I_CBV, I_C, I_CCTX, I_WADA, I_BADA, I_WIN, I_WOUT, I_WGATE, I_WUP, I_WDOWN, I_N1G, I_N2G, I_QGA, I_KGA, I_QGB, I_KGB, I_SINK, I_CONVW, I_CONVB, I_CLNG, I_CLNB };

__device__ __forceinline__ int win_row(int c) {
    if (c >= 2560) { const int gate = c >= 3072, f = c - (gate ? 3072 : 2560); return 2560 + 256 * (f >> 7) + 128 * gate + (f & 127); }
    if ((c >= 768 && c < 1024) || c >= 2304) return c;
    const int f = c & 127, n = f >> 6, r = f & 63;
    return (c & ~127) + 32 * (r >> 4) + 8 * ((r >> 2) & 3) + 4 * n + (r & 3);
}
__device__ __forceinline__ void p0_transpose_item(const float* W, int K, int N, bf16* WT, int mode, LAS float* scr, int item, int lane) {
    const int nblk = N / 32, kb = item / nblk, nb = item % nblk, k0 = 64 * kb, n0 = 32 * nb;
    const int drow0 = mode == 0 ? n0 : 256 * (n0 >> 7) + (n0 & 127) + (mode == 2 ? 128 : 0);
    float wv[32];
#pragma unroll
    for (int i = 0; i < 32; ++i) { const int kk = 2 * i + (lane >> 5); wv[i] = W[(size_t)(k0 + kk) * N + n0 + (lane & 31)]; }
#pragma unroll
    for (int i = 0; i < 32; ++i) { const int kk = 2 * i + (lane >> 5); scr[kk * 33 + (lane & 31)] = wv[i]; }
    LDS_WAIT(); asm volatile("" ::: "memory");
    const int c = lane & 7;
#pragma unroll
    for (int j = 0; j < 4; ++j) { const int n = (lane >> 3) + 8 * j; const LAS float* s = scr + (8 * c) * 33 + n;
        v4u o; o.x = pk2(s[0 * 33], s[1 * 33]); o.y = pk2(s[2 * 33], s[3 * 33]); o.z = pk2(s[4 * 33], s[5 * 33]); o.w = pk2(s[6 * 33], s[7 * 33]);
        *(v4u*)(WT + (size_t)(mode == 3 ? win_row(n0 + n) : drow0 + n) * K + k0 + 8 * c) = o; }
    LDS_WAIT(); asm volatile("" ::: "memory");
}
constexpr int CV_A = 32 * 112, CV_B = 32 * 64, CV_C = 32 * 176, CV_D = 88 * 64, CV_PER_L = CV_A + CV_B + 2 * CV_C + CV_D;
__device__ __forceinline__ void convert_layer_items(const Args& a, int l, int lo, int hi, int gwl, int NGWL, LAS float* scr, int lane) {
    unsigned char* ws = a.ws;
    for (int it = lo + gwl; it < hi; it += NGWL) {
        int r = it;
        if (r < CV_A) { p0_transpose_item(a.in[I_WIN] + (size_t)l * DM * IN_W, DM, IN_W, (bf16*)(ws + WS_WIN) + (size_t)l * IN_W * DM, 3, scr, r, lane); continue; } r -= CV_A;
        if (r < CV_B) { p0_transpose_item(a.in[I_WOUT] + (size_t)l * DM * DM, DM, DM, (bf16*)(ws + WS_WOUT) + (size_t)l * DM * DM, 0, scr, r, lane); continue; } r -= CV_B;
        if (r < CV_C) { p0_transpose_item(a.in[I_WGATE] + (size_t)l * DM * FF, DM, FF, (bf16*)(ws + WS_WGU) + (size_t)l * NGU * DM, 1, scr, r, lane); continue; } r -= CV_C;
        if (r < CV_C) { p0_transpose_item(a.in[I_WUP] + (size_t)l * DM * FF, DM, FF, (bf16*)(ws + WS_WGU) + (size_t)l * NGU * DM, 2, scr, r, lane); continue; } r -= CV_C;
        p0_transpose_item(a.in[I_WDOWN] + (size_t)l * FF * DM, FF, DM, (bf16*)(ws + WS_WDN) + (size_t)l * DM * FF, 0, scr, r, lane);
    }
}
__device__ __forceinline__ void convert_in_tail(const Args& a, int l_next, int lo, int hi, int nunits, LAS unsigned char* lds, int G, const int wave_u) {
    unsigned lz_ = 0u; asm volatile("" : "+v"(lz_)); int lane_l = (int)__builtin_amdgcn_mbcnt_hi(~0u, __builtin_amdgcn_mbcnt_lo(~0u, lz_));
    const int rem = nunits % G, first = rem, nconv = G - rem;
    if ((int)blockIdx.x >= first) convert_layer_items(a, l_next, lo, hi, ((int)blockIdx.x - first) * NWAVES + wave_u, nconv * NWAVES, (LAS float*)(lds + wave_u * 8448), lane_l);
}
__device__ __forceinline__ void p0_prologue(const Args& a, LAS unsigned char* lds, int G, const int wave_u) {
    unsigned lz_ = 0u; asm volatile("" : "+v"(lz_)); int lane_l = (int)__builtin_amdgcn_mbcnt_hi(~0u, __builtin_amdgcn_mbcnt_lo(~0u, lz_)); const int lane = lane_l, wave = wave_u, tid = wave_u * 64 + lane_l; (void)tid; (void)lane; (void)wave;
    unsigned char* ws = a.ws;
    if ((int)blockIdx.x < DEPTH * 48) {
        LAS float* sl = (LAS float*)lds;
        LAS float* red = (LAS float*)(lds + 73728);
        for (int i = tid; i < NMODROW * DM; i += NWAVES * 64) { const int mb = i >> 11, k = i & 2047; const float x = mb == 0 ? a.in[I_CCTX][k] : a.in[I_C][(mb - 1) * DM + k]; sl[i] = x / (1.0f + expf(-x)); }
        __syncthreads();
        float* mod = (float*)(ws + WS_MOD);
        for (int item = blockIdx.x; item < DEPTH * 48; item += G) {
            const int l = item / 48, cb = item % 48;
            const float* W = a.in[I_WADA] + (size_t)l * DM * MODW + cb * 256 + 4 * lane;
            f32x4 acc[NMODROW];
#pragma unroll
            for (int mb = 0; mb < NMODROW; ++mb) acc[mb] = (f32x4){0.f, 0.f, 0.f, 0.f};
            const int k0 = wave * 256;
            for (int kb = 0; kb < 256; kb += 16) { f32x4 w[16];
#pragma unroll
                for (int q = 0; q < 16; ++q) w[q] = *(const f32x4*)(W + (size_t)(k0 + kb + q) * MODW);
#pragma unroll
                for (int q = 0; q < 16; ++q)
#pragma unroll
                    for (int mb = 0; mb < NMODROW; ++mb) { const float s = sl[mb * DM + k0 + kb + q]; acc[mb] += w[q] * s; } }
#pragma unroll
            for (int pass = 0; pass < 2; ++pass) { const int m0 = pass * 5, nm = pass ? 4 : 5;
#pragma unroll
                for (int mm = 0; mm < 5; ++mm) if (mm < nm) *(LAS f32x4*)(red + ((wave * 5 + mm) * 256 + 4 * lane)) = acc[m0 + mm];
                __syncthreads();
                for (int t = tid; t < nm * 256; t += NWAVES * 64) { const int mm = t >> 8, cc = t & 255; float s = a.in[I_BADA][l * MODW + cb * 256 + cc];
#pragma unroll
                    for (int w8 = 0; w8 < NWAVES; ++w8) s += red[(w8 * 5 + mm) * 256 + cc];
                    mod[(size_t)(l * NMODROW + m0 + mm) * MODW + cb * 256 + cc] = s; }
                __syncthreads(); }
        }
    }
    __syncthreads();
    convert_layer_items(a, 0, 0, CV_PER_L, blockIdx.x * NWAVES + wave, G * NWAVES, (LAS float*)(lds + wave * 8448), lane);
    {
        const size_t gt = (size_t)blockIdx.x * (NWAVES * 64) + tid, NT = (size_t)G * (NWAVES * 64);
        constexpr size_t PER = 2097152 / 8;
        for (size_t i = gt; i < 4 * PER; i += NT) { const int which = (int)(i / PER); const size_t j = i % PER;
            const float* src = a.in[I_CAK + which] + j * 8; const f32x4 x0 = *(const f32x4*)src, x1 = *(const f32x4*)(src + 4);
            v4u o; o.x = pk2(x0[0], x0[1]); o.y = pk2(x0[2], x0[3]); o.z = pk2(x1[0], x1[1]); o.w = pk2(x1[2], x1[3]);
            *(v4u*)((bf16*)(ws + WS_CACHE) + (size_t)which * 2097152 + j * 8) = o; }
        for (size_t i = gt; i < DEPTH * 512; i += NT) { const int l = (int)(i >> 9), ty = (int)(i >> 7) & 3, d = (int)(i & 127); ((float*)(ws + WS_GAINS))[i] = a.in[I_QGA + ty][l * 128 + d] * ((ty & 1) ? 1.0f : att::QSCALE); }
    }
}

__device__ __forceinline__ void norm_mod_phase(const float* xc, const float* xl, const bf16* xb  , const float* g, const float* modl, int sh_idx, int sc_idx, bf16* H, int G, const int wave_u) {
    unsigned lz_ = 0u; asm volatile("" : "+v"(lz_)); int lane_l = (int)__builtin_amdgcn_mbcnt_hi(~0u, __builtin_amdgcn_mbcnt_lo(~0u, lz_)); const int lane = lane_l, wave = wave_u, tid = wave_u * 64 + lane_l; (void)tid; (void)lane; (void)wave;
    const int gw = blockIdx.x * NWAVES + wave, NGW = G * NWAVES;
    float A[32], S[32];
    for (int base = gw * 18; base < M_ALL; base += NGW * 18) {
        int cur = -1;
        for (int r = base; r < base + 18; ++r) {
            const int mb = r < M_CTX ? 0 : 1 + ((r - M_CTX) >> 12);
            if (mb != cur) { cur = mb;
                const float* scp = modl + (size_t)mb * MODW + sc_idx * DM; const float* shp = modl + (size_t)mb * MODW + sh_idx * DM;
#pragma unroll
                for (int j = 0; j < 4; ++j)
#pragma unroll
                    for (int h = 0; h < 2; ++h) { const int c = 512 * j + 8 * lane + 4 * h; const f32x4 gv = *(const f32x4*)(g + c), sv = *(const f32x4*)(scp + c), hv = *(const f32x4*)(shp + c);
#pragma unroll
                        for (int e = 0; e < 4; ++e) { A[j * 8 + h * 4 + e] = gv[e] * (1.0f + sv[e]); S[j * 8 + h * 4 + e] = hv[e]; } } }
            f32x4 v[8]; float ss = 0.f;
            if (xb) { const bf16* xr = xb + (size_t)r * DM + 8 * lane; v4u w[4];
#pragma unroll
                for (int j = 0; j < 4; ++j) w[j] = *(const v4u*)(xr + 512 * j);
#pragma unroll
                for (int j = 0; j < 4; ++j) { v[2 * j] = (f32x4){bflo(w[j].x), bfhi(w[j].x), bflo(w[j].y), bfhi(w[j].y)}; v[2 * j + 1] = (f32x4){bflo(w[j].z), bfhi(w[j].z), bflo(w[j].w), bfhi(w[j].w)}; } }
            else { const float* xr = (r < M_CTX ? xc : xl) + (size_t)r * DM + 8 * lane;
#pragma unroll
                for (int j = 0; j < 4; ++j) { v[2 * j] = *(const f32x4*)(xr + 512 * j); v[2 * j + 1] = *(const f32x4*)(xr + 512 * j + 4); } }
#pragma unroll
            for (int q = 0; q < 8; ++q) ss += (v[q][0] * v[q][0] + v[q][1] * v[q][1]) + (v[q][2] * v[q][2] + v[q][3] * v[q][3]);
            const float rstd = __builtin_amdgcn_rsqf(wave_sum(ss) * (1.0f / DM) + EPS);
            bf16* hr = H + (size_t)r * DM + 8 * lane;
#pragma unroll
            for (int j = 0; j < 4; ++j) { float y[8];
#pragma unroll
                for (int e = 0; e < 8; ++e) y[e] = v[2 * j + (e >> 2)][e & 3] * rstd * A[j * 8 + e] + S[j * 8 + e];
                v4u o; o.x = pk2(y[0], y[1]); o.y = pk2(y[2], y[3]); o.z = pk2(y[4], y[5]); o.w = pk2(y[6], y[7]);
                *(v4u*)(hr + 512 * j) = o; }
        }
    }
}

struct QkvRaw { v4u w1[3], w2[3], wv, wg; f32x4 ca, cb, sa, sb; };
template <bool CTX>
__device__ __forceinline__ void qkv_load(const Args& a, const bf16* Z, int r, int lane, QkvRaw& q) {
    const int hs = lane >> 3, i8 = lane & 7;
    const bf16* zr = Z + (size_t)r * IN_W;
#pragma unroll
    for (int it = 0; it < 3; ++it) { const int seg = it * 8 + hs; const bf16* p1 = zr + (seg < 20 ? seg : 0) * 128 + 8 * i8; q.w1[it] = *(const v4u*)p1; q.w2[it] = *(const v4u*)(p1 + 64); }
    q.wv = *(const v4u*)(zr + COL_CV + 8 * lane); q.wg = *(const v4u*)(zr + COL_CG + 8 * lane);
    if constexpr (!CTX) { const float* rc = (const float*)(a.ws + WS_ROPE); const float* rs = rc + 4096 * 64; const int t = (r - M_CTX) & 4095;
        q.ca = *(const f32x4*)(rc + t * 64 + 8 * i8); q.cb = *(const f32x4*)(rc + t * 64 + 8 * i8 + 4); q.sa = *(const f32x4*)(rs + t * 64 + 8 * i8); q.sb = *(const f32x4*)(rs + t * 64 + 8 * i8 + 4); }
}
template <bool CTX>
__device__ __forceinline__ void qkv_row(const Args& a, int l, const QkvRaw& q, bf16* Zo, int r, int lane, const float* qga, const float* kga, const float* qgb, const float* kgb) {
    const int hs = lane >> 3, i8 = lane & 7;
    bf16* zo = Zo + (size_t)r * IN_W;
    const v4u* w1 = q.w1; const v4u* w2 = q.w2; const v4u wv = q.wv, wg = q.wg;
    float cs[8], sn[8];
#pragma unroll
    for (int e = 0; e < 8; ++e) { cs[e] = 1.f; sn[e] = 0.f; }
    if constexpr (!CTX) {
#pragma unroll
        for (int e = 0; e < 4; ++e) { cs[e] = q.ca[e]; cs[4 + e] = q.cb[e]; sn[e] = q.sa[e]; sn[4 + e] = q.sb[e]; } }
#pragma unroll
    for (int it = 0; it < 3; ++it) {
        const int seg = it * 8 + hs;
        const bool active = (it < 2) || hs < 4;
        const bool isK = (it == 0) ? (hs == 4 || hs == 5) : (it == 2 ? hs < 2 : false);
        const bool isV = (it == 0) ? (hs >= 6) : (it == 2 ? (hs == 2 || hs == 3) : false);
        const float* gp = (it == 0) ? (hs < 4 ? qga : kga) : (it == 1 ? qgb : kgb);
        const unsigned u1[4] = {w1[it].x, w1[it].y, w1[it].z, w1[it].w}, u2[4] = {w2[it].x, w2[it].y, w2[it].z, w2[it].w};
        float x1[8], x2[8];
#pragma unroll
        for (int e = 0; e < 4; ++e) { x1[2 * e] = bflo(u1[e]); x1[2 * e + 1] = bfhi(u1[e]); x2[2 * e] = bflo(u2[e]); x2[2 * e + 1] = bfhi(u2[e]); }
        float ss = 0.f;
#pragma unroll
        for (int e = 0; e < 8; ++e) ss += x1[e] * x1[e] + x2[e] * x2[e];
        ss += dpp_mov<0xB1>(ss); ss += dpp_mov<0x4E>(ss); ss += dpp_mov<0x141>(ss);
        const float rstd = __builtin_amdgcn_rsqf(ss * (1.0f / 128.0f) + EPS);
        const f32x4 g1a = *(const f32x4*)(gp + 8 * i8), g1b = *(const f32x4*)(gp + 8 * i8 + 4), g2a = *(const f32x4*)(gp + 64 + 8 * i8), g2b = *(const f32x4*)(gp + 64 + 8 * i8 + 4);
        float y1[8], y2[8];
#pragma unroll
        for (int e = 0; e < 8; ++e) { const float ga = e < 4 ? g1a[e & 3] : g1b[e & 3], gb = e < 4 ? g2a[e & 3] : g2b[e & 3]; y1[e] = isV ? x1[e] : x1[e] * rstd * ga; y2[e] = isV ? x2[e] : x2[e] * rstd * gb; }
        if constexpr (CTX) {
            if (it != 1 && (isK || isV)) {
                const int b = r >> 8, s = r & 255, kv = hs & 1;
                float* op = a.out + (it == 0 ? (isV ? OUT_AV : OUT_AK) : (isV ? OUT_BV : OUT_BK)) + ((((size_t)b * DEPTH + l) * 256 + s) * 2 + kv) * 128 + 8 * i8;
                *(f32x4*)op = (f32x4){y1[0], y1[1], y1[2], y1[3]}; *(f32x4*)(op + 4) = (f32x4){y1[4], y1[5], y1[6], y1[7]};
                *(f32x4*)(op + 64) = (f32x4){y2[0], y2[1], y2[2], y2[3]}; *(f32x4*)(op + 68) = (f32x4){y2[4], y2[5], y2[6], y2[7]};
            }
        }
        if (active && !isV) {
            float o1[8], o2[8];
#pragma unroll
            for (int e = 0; e < 8; ++e) { o1[e] = y1[e] * cs[e] - y2[e] * sn[e]; o2[e] = y2[e] * cs[e] + y1[e] * sn[e]; }
            bf16* p1 = zo + seg * 128 + 8 * i8;
            *(v4u*)p1 = (v4u){pk2(o1[0], o1[1]), pk2(o1[2], o1[3]), pk2(o1[4], o1[5]), pk2(o1[6], o1[7])};
            *(v4u*)(p1 + 64) = (v4u){pk2(o2[0], o2[1]), pk2(o2[2], o2[3]), pk2(o2[4], o2[5]), pk2(o2[6], o2[7])};
        }
    }
    { const unsigned vv[4] = {wv.x, wv.y, wv.z, wv.w}, gg[4] = {wg.x, wg.y, wg.z, wg.w}; unsigned oo[4];
#pragma unroll
      for (int e = 0; e < 4; ++e) { const float g0 = bflo(gg[e]), g1 = bfhi(gg[e]);
          oo[e] = pk2(bflo(vv[e]) * __builtin_amdgcn_rcpf(1.0f + __expf(-g0)), bfhi(vv[e]) * __builtin_amdgcn_rcpf(1.0f + __expf(-g1))); }
      *(v4u*)(zo + COL_CV + 8 * lane) = (v4u){oo[0], oo[1], oo[2], oo[3]}; }
}
__device__ __forceinline__ void qkv_post_phase(const Args& a, int l, bf16* Z, bf16* Zo, int G, const int wave_u) {
    unsigned lz_ = 0u; asm volatile("" : "+v"(lz_)); int lane_l = (int)__builtin_amdgcn_mbcnt_hi(~0u, __builtin_amdgcn_mbcnt_lo(~0u, lz_)); const int lane = lane_l, wave = wave_u;
    const int gw = blockIdx.x * NWAVES + wave, NGW = G * NWAVES;
    const float* qga = a.in[I_QGA] + l * 128; const float* kga = a.in[I_KGA] + l * 128; const float* qgb = a.in[I_QGB] + l * 128; const float* kgb = a.in[I_KGB] + l * 128;
    { QkvRaw cur, nxt; int r = gw; if (r < M_CTX) qkv_load<true>(a, Z, r, lane, cur);
      for (; r < M_CTX; r += NGW) { const int rn = r + NGW; if (rn < M_CTX) qkv_load<true>(a, Z, rn, lane, nxt); qkv_row<true>(a, l, cur, Zo, r, lane, qga, kga, qgb, kgb); cur = nxt; } }
    { QkvRaw cur, nxt; int r = M_CTX + gw; if (r < M_ALL) qkv_load<false>(a, Z, r, lane, cur);
      for (; r < M_ALL; r += NGW) { const int rn = r + NGW; if (rn < M_ALL) qkv_load<false>(a, Z, rn, lane, nxt); qkv_row<false>(a, l, cur, Zo, r, lane, qga, kga, qgb, kgb); cur = nxt; } }
}

constexpr int DYN_CTX = 192, DYN_END = DYN_CTX + M_ALL / 64;
__device__ __forceinline__ void conv_phase(const Args& a, int l, const bf16* Z, bf16* MIX, LAS unsigned char* lds, unsigned* qctr, int first, const int wave_u) {
    if (first >= DYN_END) return;
    unsigned lz_ = 0u; asm volatile("" : "+v"(lz_)); int lane_l = (int)__builtin_amdgcn_mbcnt_hi(~0u, __builtin_amdgcn_mbcnt_lo(~0u, lz_)); const int lane = lane_l, wave = wave_u, tid = wave_u * 64 + lane_l; (void)tid; (void)lane; (void)wave;
    LAS float* cw = (LAS float*)lds;
    volatile LAS unsigned* qslot = (volatile LAS unsigned*)(lds + MISC_OFF + 80);
    for (int i = tid; i < CONV_W * C_CH; i += NWAVES * 64) cw[i] = a.in[I_CONVW][(size_t)l * CONV_W * C_CH + i];
    __syncthreads();
    float cb[8], lg[8], lb[8];
    { const float* p = a.in[I_CONVB] + l * C_CH + 8 * lane; const float* q = a.in[I_CLNG] + l * C_CH + 8 * lane; const float* s = a.in[I_CLNB] + l * C_CH + 8 * lane;
#pragma unroll
      for (int e = 0; e < 8; ++e) { cb[e] = p[e]; lg[e] = q[e]; lb[e] = s[e]; } }
    int sl = 0;
    for (int cur = first; cur < DYN_END; ) {
        unsigned pulled = 0u; if (tid == 0) pulled = atomicAdd(qctr, 1u);
        const int item = (cur - DYN_CTX) * NWAVES + wave;
        {

        const int R0 = item * 8;
        const int s0 = R0 < M_CTX ? (R0 & ~255) : M_CTX + ((R0 - M_CTX) & ~4095), s1 = s0 + (R0 < M_CTX ? 256 : 4096);
        f32x2 acc[8][4];
#pragma unroll
        for (int i = 0; i < 8; ++i)
#pragma unroll
            for (int e = 0; e < 4; ++e) acc[i][e] = (f32x2){cb[2 * e], cb[2 * e + 1]};
        v4u raw[2][8];
#define CV_LOADB(b_, buf_) do { _Pragma("unroll") for (int q = 0; q < 8; ++q) { const int p = 8 * (b_) + q; if (p > 37) continue; const int row = R0 - 15 + p; const bool ok = row >= s0 && row < s1; const int rowc = ok ? row : R0; \
            raw[buf_][q] = *(const v4u*)(Z + (size_t)rowc * IN_W + COL_CV + 8 * lane); if (!ok) raw[buf_][q] = (v4u){0u, 0u, 0u, 0u}; } } while (0)
#define CV_WA(j_) (*(const LAS f32x4*)(cw + (j_) * C_CH + 8 * lane))
#define CV_WB(j_) (*(const LAS f32x4*)(cw + (j_) * C_CH + 8 * lane + 4))
#define CV_COMP(b_, buf_) do { f32x2 U[8][4]; \
            _Pragma("unroll") for (int q = 0; q < 8; ++q) { if (8 * (b_) + q > 37) continue; const v4u w = raw[buf_][q]; \
                U[q][0] = (f32x2){bflo(w.x), bfhi(w.x)}; U[q][1] = (f32x2){bflo(w.y), bfhi(w.y)}; U[q][2] = (f32x2){bflo(w.z), bfhi(w.z)}; U[q][3] = (f32x2){bflo(w.w), bfhi(w.w)}; } \
            constexpr int jlo_ = 8 * (b_) - 7 < 0 ? 0 : 8 * (b_) - 7, jhi_ = 8 * (b_) + 7 >= CONV_W ? CONV_W - 1 : 8 * (b_) + 7; \
            f32x4 wan_ = CV_WA(jlo_), wbn_ = CV_WB(jlo_);         \
            _Pragma("unroll") for (int jj = 0; jj < 15; ++jj) { const int j = 8 * (b_) - 7 + jj; if (j < jlo_ || j > jhi_) continue; \
                const f32x4 wa = wan_, wb = wbn_; if (j + 1 <= jhi_) { wan_ = CV_WA(j + 1); wbn_ = CV_WB(j + 1); } __builtin_amdgcn_sched_barrier(0); \
                const f32x2 w2[4] = {(f32x2){wa[0], wa[1]}, (f32x2){wa[2], wa[3]}, (f32x2){wb[0], wb[1]}, (f32x2){wb[2], wb[3]}}; \
                _Pragma("unroll") for (int i = 0; i < 8; ++i) { const int p = j + i, q = p - 8 * (b_); if (q < 0 || q >= 8 || p > 37) continue; \
                    _Pragma("unroll") for (int e = 0; e < 4; ++e) acc[i][e] = __builtin_elementwise_fma(U[q][e], w2[e], acc[i][e]); } \
                __builtin_amdgcn_sched_barrier(0); } } while (0)
#define CV_SB() __builtin_amdgcn_sched_barrier(0)
        CV_LOADB(0, 0); CV_SB();
        CV_LOADB(1, 1); CV_SB(); CV_COMP(0, 0); CV_SB();
        CV_LOADB(2, 0); CV_SB(); CV_COMP(1, 1); CV_SB();
        CV_LOADB(3, 1); CV_SB(); CV_COMP(2, 0); CV_SB();
        CV_LOADB(4, 0); CV_SB(); CV_COMP(3, 1); CV_SB();
        CV_COMP(4, 0); CV_SB();
#undef CV_SB
#undef CV_LOADB
#undef CV_COMP
#undef CV_WA
#undef CV_WB
#pragma unroll
        for (int i = 0; i < 8; ++i) {
            float av[8];
#pragma unroll
            for (int e = 0; e < 4; ++e) { av[2 * e] = acc[i][e].x; av[2 * e + 1] = acc[i][e].y; }
            float s = 0.f;
#pragma unroll
            for (int e = 0; e < 8; ++e) s += av[e];
            const float mean = wave_sum(s) * (1.0f / C_CH); float q = 0.f;
#pragma unroll
            for (int e = 0; e < 8; ++e) { const float d = av[e] - mean; q += d * d; }
            const float rstd = __builtin_amdgcn_rsqf(wave_sum(q) * (1.0f / C_CH) + EPS);
            float y[8];
#pragma unroll
            for (int e = 0; e < 8; ++e) { const float t = (av[e] - mean) * rstd * lg[e] + lb[e]; y[e] = t * __builtin_amdgcn_rcpf(1.0f + __builtin_amdgcn_exp2f(t * -1.4426950408889634f)); }
            v4u o; o.x = pk2(y[0], y[1]); o.y = pk2(y[2], y[3]); o.z = pk2(y[4], y[5]); o.w = pk2(y[6], y[7]);
            *(v4u*)(MIX + (size_t)(R0 + i) * DM + MIX_OC + 8 * lane) = o;
        }
        }
        if (tid == 0) qslot[sl] = pulled;
        __syncthreads();
        cur = __builtin_amdgcn_readfirstlane((int)qslot[sl]); sl ^= 1;
    }
}

struct ADec {
    const bf16* Z; bf16* MIX; const bf16* cache; const float* sink; int l;
    __device__ __forceinline__ void operator()(const int L, att::AUnit& u) const {
        if (L < 1024) {
            const int x = L & 7, j = (L >> 3) & 31, i = L >> 8, pair = 2 * x + (i >> 1), uu = (i & 1) * 32 + j, b = pair >> 1, kvh = pair & 1, h = kvh * 4 + (uu >> 4), qb = uu & 15;
            const size_t row0 = (size_t)M_CTX + (size_t)b * 4096;
            u.Q = Z + (row0 + qb * 256) * IN_W + COL_QB + h * 128;
            u.K0 = cache + (size_t)2 * 2097152 + ((size_t)(b * DEPTH + l) * 256 * 2 + kvh) * 128; u.nt0 = 4;
            u.K1 = Z + row0 * IN_W + COL_KB + kvh * 128; u.nt1 = 64;
            u.O = MIX + (row0 + qb * 256) * DM + MIX_OB + h * 128;
            u.sink_l2 = -__builtin_inff(); u.mask = 0; u.qk0 = 0;
        } else if (L < 1536) {
            const int Lp = L - 1024, x = Lp & 7, j = (Lp >> 3) & 31, i = Lp >> 8, pair = 2 * x + i, b = pair >> 1, kvh = pair & 1, h = kvh * 2 + (j >> 4), qb = j & 15;
            const size_t row0 = (size_t)M_CTX + (size_t)b * 4096;
            const int q0 = qb * 256, ks = q0 - 128 < 0 ? 0 : q0 - 128, ke = q0 + 384 > 4096 ? 4096 : q0 + 384;
            u.Q = Z + (row0 + q0) * IN_W + COL_QA + h * 128;
            u.K0 = cache + ((size_t)(b * DEPTH + l) * 256 * 2 + kvh) * 128; u.nt0 = 4;
            u.K1 = Z + (row0 + ks) * IN_W + COL_KA + kvh * 128; u.nt1 = (ke - ks) / 64;
            u.O = MIX + (row0 + q0) * DM + MIX_OA + h * 128;
            u.sink_l2 = sink[h] * att::LOG2E; u.mask = 1; u.qk0 = q0 - ks;
        } else if (L < 1664) {
            const int Lp = L - 1536, b = Lp >> 3, h = Lp & 7, kvh = h >> 2; const size_t row0 = (size_t)b * 256;
            u.Q = Z + row0 * IN_W + COL_QB + h * 128;
            u.K1 = Z + row0 * IN_W + COL_KB + kvh * 128; u.nt1 = 4; u.K0 = u.K1; u.nt0 = 0;
            u.O = MIX + row0 * DM + MIX_OB + h * 128;
            u.sink_l2 = -__builtin_inff(); u.mask = 0; u.qk0 = 0;
        } else {
            const int Lp = L - 1664, b = Lp >> 2, h = Lp & 3, kvh = h >> 1; const size_t row0 = (size_t)b * 256;
            u.Q = Z + row0 * IN_W + COL_QA + h * 128;
            u.K1 = Z + row0 * IN_W + COL_KA + kvh * 128; u.nt1 = 4; u.K0 = u.K1; u.nt0 = 0;
            u.O = MIX + row0 * DM + MIX_OA + h * 128;
            u.sink_l2 = sink[h] * att::LOG2E; u.mask = 0; u.qk0 = 0;
        }
    }
};
__device__ __forceinline__ int attn_phase(const Args& a, int l, const bf16* Z, bf16* MIX, LAS unsigned char* lds, unsigned* qctr, int G, const int wave_u) {
    const ADec D{Z, MIX, (const bf16*)(a.ws + WS_CACHE), a.in[I_SINK] + l * 4, l};
    unsigned lz_ = 0u; asm volatile("" : "+v"(lz_)); const int tid = wave_u * 64 + (int)__builtin_amdgcn_mbcnt_hi(~0u, __builtin_amdgcn_mbcnt_lo(~0u, lz_));
    volatile LAS unsigned* qslot = (volatile LAS unsigned*)(lds + MISC_OFF + 80);
    int L = (int)blockIdx.x, sl = 0;
    if (L >= 1536) { if (tid == 0) qslot[0] = atomicAdd(qctr, 1u); __syncthreads(); const int v = __builtin_amdgcn_readfirstlane((int)qslot[0]); __syncthreads(); if (v >= DYN_CTX) return v; L = 1536 + v; }
    bool pre = false; att::bf16x8 qr[8]; att::AStage st[2];
    for (;;) {
        const int Ln = (L < 1536 && L + G < 1536) ? L + G : -1;
        att::AUnit u; D(L, u);
        pre = att::attn_unit(u, D, Ln, pre, qr, st, (ATT_LAS char*)lds, wave_u);
        if (Ln < 0 && tid == 0) qslot[sl] = atomicAdd(qctr, 1u);
        __syncthreads();
        if (Ln >= 0) { L = Ln; continue; }
        const int v = __builtin_amdgcn_readfirstlane((int)qslot[sl]); sl ^= 1;
        if (v >= DYN_CTX) return v;
        L = 1536 + v;
    }
}

#ifndef ALIGN_RESID
#define ALIGN_RESID true
#endif
#ifndef P8_REV
#define P8_REV false
#endif
#ifndef P7_WGM
#define P7_WGM 8
#endif
#ifndef P7_ALIGN
#define P7_ALIGN true
#endif
#ifndef P7_SP2
#define P7_SP2 true
#endif
#ifdef PROBE_DIL
#if PROBE_DIL == 1
#define DIL_NOW() ((unsigned long long)clock64())
#else
#define DIL_NOW() ((unsigned long long)wall_clock64())
#endif
#define DIL_BEGIN(ph) unsigned long long dil_t0_ = 0ull; if (l == 1 && blockIdx.x == 0 && wave_u == 0) dil_t0_ = DIL_NOW()
#define DIL_END(ph) do { if (l == 1 && blockIdx.x == 0 && wave_u == 0) { const unsigned long long d_ = DIL_NOW() - dil_t0_; *(LAS unsigned long long*)(lds + MISC_OFF + 64) = d_; } } while (0)
#ifndef DIL_PH
#define DIL_PH 8
#endif
#if DIL_PH == 8
#define DIL_BEGIN8() DIL_BEGIN(8)
#define DIL_END8() DIL_END(8)
#define DIL_BEGIN4() do { } while (0)
#define DIL_END4() do { } while (0)
#else
#define DIL_BEGIN4() DIL_BEGIN(4)
#define DIL_END4() DIL_END(4)
#define DIL_BEGIN8() do { } while (0)
#define DIL_END8() do { } while (0)
#endif
#else
#define DIL_BEGIN4() do { } while (0)
#define DIL_END4() do { } while (0)
#define DIL_BEGIN8() do { } while (0)
#define DIL_END8() do { } while (0)
#endif
#if defined(PROBE_DIL) && defined(DIL_IV)
#undef DIL_BEGIN4
#undef DIL_END4
#undef DIL_BEGIN8
#undef DIL_END8
#define DIL_BEGIN4() do { } while (0)
#define DIL_END4() do { } while (0)
#define DIL_BEGIN8() do { } while (0)
#define DIL_END8() do { } while (0)
#define DIL_MARK(k) do { if (l == 1 && blockIdx.x == 0 && wave_u == 0) { if ((k) == DIL_IV - 1) dil_tm = DIL_NOW(); if ((k) == DIL_IV) { const unsigned long long d_ = DIL_NOW() - dil_tm; *(LAS unsigned long long*)(lds + MISC_OFF + 64) = d_; } } } while (0)
#else
#define DIL_MARK(k) do { } while (0)
#endif
#ifndef PROBE_WGSTAT_THR
#define PROBE_WGSTAT_THR 80000
#endif
#define NREP2 2
#ifdef PROBE_P7X2
#define NREP_P7 NREP2
#else
#define NREP_P7 1
#endif
#ifdef PROBE_P4X2
#define NREP_P4 NREP2
#else
#define NREP_P4 1
#endif
#ifdef PROBE_P2X2
#define NREP_P2 NREP2
#else
#define NREP_P2 1
#endif
#ifdef PROBE_P5X2
#define NREP_P5 NREP2
#else
#define NREP_P5 1
#endif
#ifdef PROBE_P8X2
#define NREP_P8 NREP2
#else
#define NREP_P8 1
#endif
#ifdef PROBE_P3X2
#define NREP_P3 NREP2
#else
#define NREP_P3 1
#endif
#ifdef PROBE_CONVX2
#define NREP_CONV NREP2
#else
#define NREP_CONV 1
#endif
#ifdef PROBE_P0X2
#define NREP_P0 NREP2
#else
#define NREP_P0 NREP_TH
#endif
#ifdef PROBE_THINX2
#define NREP_TH NREP2
#else
#define NREP_TH 1
#endif
#ifndef PH_MASK
#define PH_MASK 0x3ff
#endif
#define PH(n) ((PH_MASK >> (n)) & 1)
__global__ void __launch_bounds__(NWAVES * 64, 2) fwd_kernel(Args args) {
    extern __shared__ __attribute__((aligned(16))) unsigned char lds_raw[];
    LAS unsigned char* lds = (LAS unsigned char*)lds_raw;
    const int tid = threadIdx.x, G = gridDim.x, wave_u = __builtin_amdgcn_readfirstlane(tid >> 6);
    unsigned char* ws = args.ws;
    for (int u = tid; u < (LDS_BYTES - LDSCTL_OFF) / 4; u += NWAVES * 64) ((LAS unsigned*)(lds + LDSCTL_OFF))[u] = 0u;
    __syncthreads();
    XcdBarrier bar = xcd_barrier_post((unsigned*)(ws + WS_CTL) + CW_BAR, (volatile LAS unsigned*)(lds + MISC_OFF) + 8);

    bf16* H = (bf16*)(ws + WS_H); bf16* Z = (bf16*)(ws + WS_Z); bf16* MIX = (bf16*)(ws + WS_MIX); bf16* ACT = (bf16*)(ws + WS_ACT); bf16* XB = (bf16*)(ws + WS_XB);
    float* out = args.out;

#if defined(PROBE_DIL) && defined(DIL_P0)
    if (blockIdx.x == 0 && wave_u == 0) *(LAS unsigned long long*)(lds + MISC_OFF + 72) = DIL_NOW();
#endif
    for (int rep = 0; rep < NREP_P0; ++rep) { if (rep) xcd_barrier(bar);
    if (PH(0)) p0_prologue(args, lds, G, wave_u); }
    xcd_barrier(bar);
#if defined(PROBE_DIL) && defined(DIL_P0)
    if (blockIdx.x == 0 && wave_u == 0) { asm volatile("s_waitcnt lgkmcnt(0)" ::: "memory"); *(LAS unsigned long long*)(lds + MISC_OFF + 64) = DIL_NOW() - *(LAS unsigned long long*)(lds + MISC_OFF + 72); }
#endif

#if defined(PROBE_DIL) && defined(DIL_IV)
    unsigned long long dil_tm = 0ull;
#endif
    for (int l = 0; l < DEPTH; ++l) {
        DIL_MARK(0);
        const float* modl = (const float*)(ws + WS_MOD) + (size_t)l * NMODROW * MODW;
        const float* xc = args.in[I_XP];
        const float* xl = args.in[I_XS] - (size_t)M_CTX * DM;
        for (int rep = 0; rep < NREP_TH; ++rep) { if (rep) xcd_barrier(bar);
        if (PH(1)) norm_mod_phase(xc, xl, l == 0 ? (const bf16*)nullptr : XB, args.in[I_N1G] + l * DM, modl, 0, 1, H, G, wave_u); }
        xcd_barrier(bar);
        DIL_MARK(1);
        if (PH(2)) { pg8::Gemm g{H, (const bf16*)(ws + WS_WIN) + (size_t)l * IN_W * DM, M_ALL, IN_W, DM}; pg8::StaticOrderC<M_ALL / 256, IN_W / 256> S; S.init(G, (int)blockIdx.x);
          pg8::EpiQKV E{Z, out, (const float*)(ws + WS_GAINS) + l * 512, l, (LAS float*)(lds + XCH_OFF)};
          for (int rep = 0; rep < NREP_P2; ++rep) { if (rep) xcd_barrier(bar); pg8::gemm_phase<pg8::EpiQKV, pg8::StaticOrderC<M_ALL / 256, IN_W / 256>, true, true>(lds, g, S, E, wave_u); }
#ifdef PROBE_P2NULL
          xcd_barrier(bar); { pg8::EpiNull En{(float*)(ws + WS_CTL + 49152)}; pg8::gemm_phase<pg8::EpiNull, pg8::StaticOrderC<M_ALL / 256, IN_W / 256>, PROBE_P2NULL == 1, true>(lds, g, S, En, wave_u); }
#endif
        }
        xcd_barrier(bar);
        DIL_MARK(2);
        DIL_BEGIN4();
#if defined(PROBE_WGSTAT) && (!defined(PROBE_WGSTAT_PH) || PROBE_WGSTAT_PH == 4)
        if (l == 1 && wave_u == 0) { *(LAS unsigned long long*)(lds + MISC_OFF + 72) = (unsigned long long)wall_clock64(); }
#endif
        for (int rep = 0; rep < NREP_P4; ++rep) { if (rep) xcd_barrier(bar);
#pragma nounroll
        for (int crep = 0; crep < NREP_CONV; ++crep)
        { unsigned* qctr = (unsigned*)(ws + WS_CTL + 32768) + l * 16;
          const int cfirst = attn_phase(args, l, Z, MIX, lds, qctr, G, wave_u);
          conv_phase(args, l, Z, MIX, lds, qctr, cfirst, wave_u); } }
        DIL_END4();
#if defined(PROBE_WGSTAT) && (!defined(PROBE_WGSTAT_PH) || PROBE_WGSTAT_PH == 4)
        if (l == 1 && wave_u == 0) { asm volatile("s_waitcnt lgkmcnt(0)" ::: "memory"); const unsigned long long d_ = (unsigned long long)wall_clock64() - *(LAS unsigned long long*)(lds + MISC_OFF + 72);
            unsigned lz2_ = 0u; asm volatile("" : "+v"(lz2_)); if (__builtin_amdgcn_mbcnt_hi(~0u, __builtin_amdgcn_mbcnt_lo(~0u, lz2_)) == 0) { unsigned long long* st_ = (unsigned long long*)(ws + WS_CTL + 65536);
                atomicMax(st_, (d_ << 16) | (unsigned long long)blockIdx.x); atomicMax(st_ + 1, ((0xffffffffull - d_) << 16) | (unsigned long long)blockIdx.x); if (d_ > (unsigned long long)PROBE_WGSTAT_THR) atomicAdd(st_ + 2, 1ull); } }
#endif
        xcd_barrier(bar);
        DIL_MARK(3);
        if (PH(6)) { pg8::Gemm g{MIX, (const bf16*)(ws + WS_WOUT) + (size_t)l * DM * DM, M_ALL, DM, DM}; pg8::StaticOrderC<M_ALL / 256, DM / 256> S; S.init(G, (int)blockIdx.x);
#pragma nounroll
          for (int rep = NREP_P5 - 1; rep >= 0; --rep) { pg8::EpiResidB E{xc, xl, XB, rep ? (bf16*)(ws + WS_END) : XB, out, modl + 2 * DM, l == 0 ? 0 : 1};
            pg8::gemm_phase<pg8::EpiResidB, pg8::StaticOrderC<M_ALL / 256, DM / 256>, ALIGN_RESID, true>(lds, g, S, E, wave_u); if (rep) xcd_barrier(bar); }
          if (l + 1 < DEPTH) convert_in_tail(args, l + 1, 0, CV_A + CV_B, (M_ALL / 256) * (DM / 256), lds, G, wave_u); }
        xcd_barrier(bar);
        DIL_MARK(4);
        for (int rep = 0; rep < NREP_TH; ++rep) { if (rep) xcd_barrier(bar);
        if (PH(7)) norm_mod_phase(xc, xl, XB, args.in[I_N2G] + l * DM, modl, 3, 4, H, G, wave_u); }
        xcd_barrier(bar);
        DIL_MARK(5);
        DIL_BEGIN8();
#if defined(PROBE_WGSTAT) && defined(PROBE_WGSTAT_PH) && PROBE_WGSTAT_PH == 8
        if (l == 1 && wave_u == 0) { *(LAS unsigned long long*)(lds + MISC_OFF + 72) = (unsigned long long)wall_clock64(); }
#endif
        if (PH(8)) { pg8::Gemm g{H, (const bf16*)(ws + WS_WGU) + (size_t)l * NGU * DM, M_ALL, NGU, DM}; pg8::StaticOrderC<M_ALL / 256, NGU / 256, P7_WGM> S; S.init(G, (int)blockIdx.x);
          pg8::EpiSwiGLU E{ACT, FF};
          for (int rep = 0; rep < NREP_P7; ++rep) { if (rep) xcd_barrier(bar); pg8::gemm_phase<pg8::EpiSwiGLU, pg8::StaticOrderC<M_ALL / 256, NGU / 256, P7_WGM>, P7_ALIGN, P7_SP2>(lds, g, S, E, wave_u); }

        }
        DIL_END8();
#if defined(PROBE_WGSTAT) && defined(PROBE_WGSTAT_PH) && PROBE_WGSTAT_PH == 8
        if (l == 1 && wave_u == 0) { asm volatile("s_waitcnt lgkmcnt(0)" ::: "memory"); const unsigned long long d_ = (unsigned long long)wall_clock64() - *(LAS unsigned long long*)(lds + MISC_OFF + 72);
            unsigned lz2_ = 0u; asm volatile("" : "+v"(lz2_)); if (__builtin_amdgcn_mbcnt_hi(~0u, __builtin_amdgcn_mbcnt_lo(~0u, lz2_)) == 0) { unsigned long long* st_ = (unsigned long long*)(ws + WS_CTL + 65536);
                atomicMax(st_, (d_ << 16) | (unsigned long long)blockIdx.x); atomicMax(st_ + 1, ((0xffffffffull - d_) << 16) | (unsigned long long)blockIdx.x); if (d_ > (unsigned long long)PROBE_WGSTAT_THR) atomicAdd(st_ + 2, 1ull); } }
#endif
        xcd_barrier(bar);
        DIL_MARK(6);
        if (PH(9)) { pg8::Gemm g{ACT, (const bf16*)(ws + WS_WDN) + (size_t)l * DM * FF, M_ALL, DM, FF}; pg8::StaticOrderC<M_ALL / 256, DM / 256, pg8::WGM, P8_REV> S; S.init(G, (int)blockIdx.x);
#pragma nounroll
          for (int rep = NREP_P8 - 1; rep >= 0; --rep) { pg8::EpiResidB E{xc, xl, XB, rep ? (bf16*)(ws + WS_END) : XB, rep ? (float*)(ws + WS_END) : out, modl + 5 * DM, l + 1 < DEPTH ? 1 : 2};
            pg8::gemm_phase<pg8::EpiResidB, pg8::StaticOrderC<M_ALL / 256, DM / 256, pg8::WGM, P8_REV>, ALIGN_RESID, true>(lds, g, S, E, wave_u); if (rep) xcd_barrier(bar); }
          if (l + 1 < DEPTH) convert_in_tail(args, l + 1, CV_A + CV_B, CV_PER_L, (M_ALL / 256) * (DM / 256), lds, G, wave_u); }
        if (l + 1 < DEPTH) xcd_barrier(bar);
        DIL_MARK(7);
    }
#ifdef PROBE_WGSTAT
    if (blockIdx.x == 0 && wave_u == 0) { const unsigned long long* st_ = (const unsigned long long*)(ws + WS_CTL + 65536);
        const unsigned long long mx_ = __atomic_load_n(st_, __ATOMIC_RELAXED), mi_ = __atomic_load_n(st_ + 1, __ATOMIC_RELAXED), mn_ = ((0xffffffffull - (mi_ >> 16)) << 16) | (mi_ & 0xffffull), cnt_ = __atomic_load_n(st_ + 2, __ATOMIC_RELAXED);
        unsigned long long ticks = 0;
        if (PROBE_WGSTAT == 1) ticks = (mx_ >> 16) * 4ull;
        else if (PROBE_WGSTAT == 2) ticks = (mx_ & 0xffffull) * 1000ull;
        else if (PROBE_WGSTAT == 3) ticks = cnt_ * 1000ull;
        else if (PROBE_WGSTAT == 4) ticks = (mn_ >> 16) * 4ull;
        else ticks = (mn_ & 0xffffull) * 1000ull;
        const unsigned long long t0 = wall_clock64(); while ((unsigned long long)wall_clock64() - t0 < ticks) __builtin_amdgcn_s_sleep(32); }
#endif
#ifdef PROBE_DIL
    if (blockIdx.x == 0 && wave_u == 0) { asm volatile("s_waitcnt lgkmcnt(0)" ::: "memory"); const unsigned long long d_ = *(LAS unsigned long long*)(lds + MISC_OFF + 64);
        const unsigned long long ticks = (PROBE_DIL == 1) ? d_ * 4ull / 24ull : d_ * 4ull;
        const unsigned long long t0 = wall_clock64(); while ((unsigned long long)wall_clock64() - t0 < ticks) __builtin_amdgcn_s_sleep(32); }
#endif
}

extern "C" void kernel_launch(void* const* d_in, const int* in_sizes, int n_in, void* d_out, int out_size, void* d_ws, size_t ws_size, hipStream_t stream) {
    static int grid = 0;
    if (grid == 0) {
        if (n_in != 26 || in_sizes[0] != M_CTX * DM || in_sizes[1] != M_LAT * DM || (size_t)out_size != OUT_TOTAL || ws_size < WS_END) {
            fprintf(stderr, "kernel_launch: shape mismatch: n_in %d in0 %d in1 %d out %d ws %zu (need >= %zu); nothing launched\n", n_in, n_in > 0 ? in_sizes[0] : -1, n_in > 1 ? in_sizes[1] : -1, out_size, ws_size, (size_t)WS_END); grid = -1; return; }
        int dev = 0, cus = 0, per_cu = 0;
        if (hipGetDevice(&dev) != hipSuccess || hipDeviceGetAttribute(&cus, hipDeviceAttributeMultiprocessorCount, dev) != hipSuccess) { fprintf(stderr, "kernel_launch: device query failed\n"); grid = -1; return; }
        if (hipFuncSetAttribute((const void*)fwd_kernel, hipFuncAttributeMaxDynamicSharedMemorySize, LDS_BYTES) != hipSuccess) { fprintf(stderr, "kernel_launch: hipFuncSetAttribute failed\n"); grid = -1; return; }
        if (hipOccupancyMaxActiveBlocksPerMultiprocessor(&per_cu, (const void*)fwd_kernel, NWAVES * 64, LDS_BYTES) != hipSuccess || per_cu < 1)
            fprintf(stderr, "kernel_launch: note: occupancy query reports %d workgroups per CU\n", per_cu);
        (void)hipGetLastError();
        grid = cus;
    }
    if (grid < 0) return;
    if (hipMemsetAsync((char*)d_ws + WS_CTL, 0, CTL_ZERO_BYTES, stream) != hipSuccess) { fprintf(stderr, "kernel_launch: memset failed\n"); return; }
    Args a{};
    for (int i = 0; i < 26; ++i) a.in[i] = (const float*)d_in[i];
    a.out = (float*)d_out; a.ws = (unsigned char*)d_ws;
    hipLaunchKernelGGL(fwd_kernel, dim3(grid), dim3(NWAVES * 64), LDS_BYTES, stream, a);
    const hipError_t le = hipPeekAtLastError();
    if (le != hipSuccess) fprintf(stderr, "kernel_launch: launch failed: %s\n", hipGetErrorName(le));
}
```

```cpp
#include <hip/hip_runtime.h>
#include <cstdio>
#include <cstdint>

namespace pg8 {
#define PG8_LAS __attribute__((address_space(3)))
typedef unsigned short bf16_t;
typedef short bf16x8 __attribute__((ext_vector_type(8)));
typedef float f32x4 __attribute__((ext_vector_type(4)));
typedef unsigned u32x4 __attribute__((ext_vector_type(4)));
constexpr int BM = 256, BK = 64, HALF = 128, HTB = HALF * BK * 2  , STAGE_BYTES = 8 * HTB, NXCD = 8, WGM = 8;

__host__ __device__ __forceinline__ int lds_byte(int r, int c) { const int st = (r >> 4) * 2 + (c >> 5), rr = r & 15, cc = c & 31, ob = rr * 64 + cc * 2; return st * 1024 + (ob ^ (((ob >> 9) & 1) << 5)); }
__host__ __device__ __forceinline__ void stage_rc(int b, int& R, int& C) { const int st = b / 1024, sb = b % 1024, swz = sb ^ (((sb >> 9) & 1) << 5); R = (st >> 1) * 16 + swz / 64; C = (st & 1) * 32 + (swz % 64) / 2; }
__host__ __device__ __forceinline__ int perm32(int rho) { const int n = rho >> 4, i = rho & 15; return 8 * (i >> 2) + 4 * n + (i & 3); }

struct Unit { int pm, pn; };
struct Gemm { const bf16_t* A; const bf16_t* Bt; int M, N, K; };

struct StaticOrder {
    int nM, nN, nwg, G, c;
    __host__ __device__ void init(int M, int N, int G_, int c_) { nM = M / BM; nN = N / BM; nwg = nM * nN; G = G_; c = c_; }
    __host__ __device__ bool next(int i, Unit& u) const {
        const long L = (long)i * G + c; if (L >= nwg) return false;
        int wgid = (int)L; { const int q = nwg / NXCD, r = nwg % NXCD, xcd = wgid % NXCD, off = wgid / NXCD; wgid = (xcd < r ? xcd * (q + 1) : r * (q + 1) + (xcd - r) * q) + off; }
        const int nig = WGM * nN, gid = wgid / nig, fm = gid * WGM, gsz = (nM - fm) < WGM ? (nM - fm) : WGM;
        u.pm = fm + ((wgid % nig) % gsz); u.pn = (wgid % nig) / gsz; return true;
    }
    __device__ __forceinline__ void a_ready(const Unit&) const {}
    __device__ __forceinline__ void done(const Unit&) const {}
};

__device__ __forceinline__ unsigned cvt_pk_bf16(float lo, float hi) { unsigned r; asm volatile("v_cvt_pk_bf16_f32 %0, %1, %2" : "=v"(r) : "v"(lo), "v"(hi)); return r; }
typedef float f32x2 __attribute__((ext_vector_type(2)));
#ifdef EPI_NT
#define EPI_ST16(p, v) __builtin_nontemporal_store((v), (p))
#else
#define EPI_ST16(p, v) (*(p) = (v))
#endif
struct EpiZ {
    static constexpr bool PERM = true, AFTER_DRAIN = false;
    bf16_t* O; int ldc;
    __device__ __forceinline__ void operator()(const f32x4 (&acc)[2][2][4][2], const Unit& u, int wr, int wc, int fr, int fq) const {
        const int row0 = u.pm * BM + wr * 64 + fr, col0 = u.pn * BM + wc * 32 + 8 * fq;
#pragma unroll
        for (int ai = 0; ai < 2; ++ai)
#pragma unroll
            for (int m = 0; m < 4; ++m) { bf16_t* rowp = O + (size_t)(row0 + ai * HALF + m * 16) * ldc + col0;
#pragma unroll
                for (int bj = 0; bj < 2; ++bj) { const f32x4 v0 = acc[ai][bj][m][0], v1 = acc[ai][bj][m][1];
                    u32x4 w; w.x = cvt_pk_bf16(v0[0], v0[1]); w.y = cvt_pk_bf16(v0[2], v0[3]); w.z = cvt_pk_bf16(v1[0], v1[1]); w.w = cvt_pk_bf16(v1[2], v1[3]);
                    EPI_ST16((u32x4*)(rowp + bj * HALF), w); } }
    }
};
__device__ __forceinline__ float silu_mul(float g, float u) { return g * __builtin_amdgcn_rcpf(1.0f + __builtin_amdgcn_exp2f(g * -1.4426950408889634f)) * u; }
__device__ __forceinline__ f32x2 silu_mul2(f32x2 g, f32x2 u) {
    const f32x2 t = g * -1.4426950408889634f;
    f32x2 d = {__builtin_amdgcn_exp2f(t.x), __builtin_amdgcn_exp2f(t.y)}; d = d + 1.0f;
    const f32x2 r = {__builtin_amdgcn_rcpf(d.x), __builtin_amdgcn_rcpf(d.y)};
    return (g * u) * r;
}
__device__ __forceinline__ unsigned glu_pk(f32x2 a, f32x2 g) {
    const f32x2 t = g * -1.4426950408889634f;
    f32x2 d = {__builtin_amdgcn_exp2f(t.x), __builtin_amdgcn_exp2f(t.y)}; d = d + 1.0f;
    const f32x2 r = {__builtin_amdgcn_rcpf(d.x), __builtin_amdgcn_rcpf(d.y)};
    const f32x2 o = a * r; return cvt_pk_bf16(o.x, o.y);
}
__device__ __forceinline__ unsigned silu_pk(f32x2 g, f32x2 u) { const f32x2 o = silu_mul2(g, u); return cvt_pk_bf16(o.x, o.y); }
struct EpiSwiGLU {
    static constexpr bool PERM = true, AFTER_DRAIN = false;
    bf16_t* O; int ldc;
    __device__ __forceinline__ void operator()(const f32x4 (&acc)[2][2][4][2], const Unit& u, int wr, int wc, int fr, int fq) const {
        const int row0 = u.pm * BM + wr * 64 + fr, col0 = u.pn * HALF + wc * 32 + 8 * fq;
#pragma unroll
        for (int ai = 0; ai < 2; ++ai)
#pragma unroll
            for (int m = 0; m < 4; ++m) { bf16_t* rowp = O + (size_t)(row0 + ai * HALF + m * 16) * ldc + col0;
                const f32x4 g0 = acc[ai][0][m][0], g1 = acc[ai][0][m][1], u0 = acc[ai][1][m][0], u1 = acc[ai][1][m][1];
                u32x4 w; w.x = silu_pk((f32x2){g0[0], g0[1]}, (f32x2){u0[0], u0[1]}); w.y = silu_pk((f32x2){g0[2], g0[3]}, (f32x2){u0[2], u0[3]});
                w.z = silu_pk((f32x2){g1[0], g1[1]}, (f32x2){u1[0], u1[1]}); w.w = silu_pk((f32x2){g1[2], g1[3]}, (f32x2){u1[2], u1[3]});
                EPI_ST16((u32x4*)rowp, w); }
    }
};
template <bool HALFN> struct EpiResid {
    static constexpr bool PERM = false, AFTER_DRAIN = false;
    const float* base_c; const float* base_l; float* out; const float* gate;
    __device__ __forceinline__ void operator()(const f32x4 (&acc)[2][2][4][2], const Unit& u, int wr, int wc, int fr, int fq) const {
        constexpr int NBJ = HALFN ? 1 : 2;
        const int row0 = u.pm * BM + wr * 64 + fr, col0 = u.pn * (HALFN ? HALF : BM) + wc * 32 + 4 * fq;
        const int mb = u.pm < 16 ? 0 : 1 + ((u.pm - 16) >> 4);
        const float* gp = gate + (size_t)mb * 12288 + col0; const float* bp = u.pm < 16 ? base_c : base_l;
        f32x4 gv[NBJ][2];
#pragma unroll
        for (int bj = 0; bj < NBJ; ++bj)
#pragma unroll
            for (int n = 0; n < 2; ++n) gv[bj][n] = *(const f32x4*)(gp + bj * HALF + n * 16);
        constexpr int NB = 4, PER = 2 * NBJ * 2;
        f32x4 bs[2][PER];
#define EPR_LOAD(b_, buf_) do { _Pragma("unroll") for (int g2 = 0; g2 < 2; ++g2) { const int grp = (b_) * 2 + g2, ai = grp >> 2, m = grp & 3; const size_t off = (size_t)(row0 + ai * HALF + m * 16) * 2048 + col0; \
        _Pragma("unroll") for (int bj = 0; bj < NBJ; ++bj) _Pragma("unroll") for (int n = 0; n < 2; ++n) bs[buf_][(g2 * NBJ + bj) * 2 + n] = *(const f32x4*)(bp + off + bj * HALF + n * 16); } } while (0)
#define EPR_STORE(b_, buf_) do { _Pragma("unroll") for (int g2 = 0; g2 < 2; ++g2) { const int grp = (b_) * 2 + g2, ai = grp >> 2, m = grp & 3; const size_t off = (size_t)(row0 + ai * HALF + m * 16) * 2048 + col0; \
        _Pragma("unroll") for (int bj = 0; bj < NBJ; ++bj) _Pragma("unroll") for (int n = 0; n < 2; ++n) *(f32x4*)(out + off + bj * HALF + n * 16) = bs[buf_][(g2 * NBJ + bj) * 2 + n] + gv[bj][n] * acc[ai][bj][m][n]; } } while (0)
        EPR_LOAD(0, 0);
        EPR_LOAD(1, 1); EPR_STORE(0, 0);
        EPR_LOAD(2, 0); EPR_STORE(1, 1);
        EPR_LOAD(3, 1); EPR_STORE(2, 0);
        EPR_STORE(3, 1);
        static_assert(NB == 4, "pipeline written out for 4 batches");
#undef EPR_LOAD
#undef EPR_STORE
    }
};
struct HeadOrder : StaticOrder {
    int Lmax;
    __host__ __device__ bool next(int i, Unit& u) const { const long L = (long)i * G + c; if (L >= Lmax) return false; return StaticOrder::next(i, u); }
};
struct TailHalfOrder : StaticOrder {
    int Lmin;
    __host__ __device__ bool next(int i, Unit& u) const {
        const int nrem = nwg - Lmin; const long idx = (long)i * G + c; if (idx >= 2L * nrem) return false;
        const int L = Lmin + (int)(idx % nrem), half = (int)(idx / nrem);
        StaticOrder t = *this; t.G = 1; t.c = 0; Unit f; t.StaticOrder::next(L, f);
        u.pm = f.pm; u.pn = 2 * f.pn + half; return true;
    }
};

struct EpiResidB {
    static constexpr bool PERM = true, AFTER_DRAIN = false;
    const float* basef_c; const float* basef_l; const bf16_t* baseb; bf16_t* outb; float* outf; const float* gate; int mode;
    template <bool BF32, bool OF32> __device__ __forceinline__ void run(const f32x4 (&acc)[2][2][4][2], const Unit& u, int wr, int wc, int fr, int fq) const {
        const int row0 = u.pm * BM + wr * 64 + fr, col0 = u.pn * BM + wc * 32 + 8 * fq;
        const int mb = u.pm < 16 ? 0 : 1 + ((u.pm - 16) >> 4);
        const float* gp = gate + (size_t)mb * 12288 + col0; const float* bp = u.pm < 16 ? basef_c : basef_l;
        f32x4 gv[2][2];
#pragma unroll
        for (int bj = 0; bj < 2; ++bj)
#pragma unroll
            for (int n = 0; n < 2; ++n) gv[bj][n] = *(const f32x4*)(gp + bj * HALF + 4 * n);
        constexpr int NV = BF32 ? 8 : 4;
        u32x4 raw[2][NV];
#define EPB_LOAD(b_, buf_) do { _Pragma("unroll") for (int g2 = 0; g2 < 2; ++g2) { const int grp = (b_) * 2 + g2, ai = grp >> 2, m = grp & 3; const size_t off = (size_t)(row0 + ai * HALF + m * 16) * 2048 + col0; \
        _Pragma("unroll") for (int bj = 0; bj < 2; ++bj) { if constexpr (BF32) { raw[buf_][(g2 * 2 + bj) * 2] = *(const u32x4*)(bp + off + bj * HALF); raw[buf_][(g2 * 2 + bj) * 2 + 1] = *(const u32x4*)(bp + off + bj * HALF + 4); } \
                                                         else raw[buf_][g2 * 2 + bj] = *(const u32x4*)(baseb + off + bj * HALF); } } } while (0)
#define EPB_STORE(b_, buf_) do { _Pragma("unroll") for (int g2 = 0; g2 < 2; ++g2) { const int grp = (b_) * 2 + g2, ai = grp >> 2, m = grp & 3; const size_t off = (size_t)(row0 + ai * HALF + m * 16) * 2048 + col0; \
        _Pragma("unroll") for (int bj = 0; bj < 2; ++bj) { f32x4 b0, b1; \
            if constexpr (BF32) { b0 = __builtin_bit_cast(f32x4, raw[buf_][(g2 * 2 + bj) * 2]); b1 = __builtin_bit_cast(f32x4, raw[buf_][(g2 * 2 + bj) * 2 + 1]); } \
            else { const u32x4 w_ = raw[buf_][g2 * 2 + bj]; b0 = (f32x4){__uint_as_float(w_.x << 16), __uint_as_float(w_.x & 0xffff0000u), __uint_as_float(w_.y << 16), __uint_as_float(w_.y & 0xffff0000u)}; \
                   b1 = (f32x4){__uint_as_float(w_.z << 16), __uint_as_float(w_.z & 0xffff0000u), __uint_as_float(w_.w << 16), __uint_as_float(w_.w & 0xffff0000u)}; } \
            const f32x4 r0 = b0 + gv[bj][0] * acc[ai][bj][m][0], r1 = b1 + gv[bj][1] * acc[ai][bj][m][1]; \
            if constexpr (OF32) { *(f32x4*)(outf + off + bj * HALF) = r0; *(f32x4*)(outf + off + bj * HALF + 4) = r1; } \
            else { u32x4 o_; o_.x = cvt_pk_bf16(r0[0], r0[1]); o_.y = cvt_pk_bf16(r0[2], r0[3]); o_.z = cvt_pk_bf16(r1[0], r1[1]); o_.w = cvt_pk_bf16(r1[2], r1[3]); EPI_ST16((u32x4*)(outb + off + bj * HALF), o_); } } } } while (0)
        EPB_LOAD(0, 0);
        EPB_LOAD(1, 1); EPB_STORE(0, 0);
        EPB_LOAD(2, 0); EPB_STORE(1, 1);
        EPB_LOAD(3, 1); EPB_STORE(2, 0);
        EPB_STORE(3, 1);
#undef EPB_LOAD
#undef EPB_STORE
    }
    __device__ __forceinline__ void operator()(const f32x4 (&acc)[2][2][4][2], const Unit& u, int wr, int wc, int fr, int fq) const {
        if (mode == 0) run<true, false>(acc, u, wr, wc, fr, fq); else if (mode == 1) run<false, false>(acc, u, wr, wc, fr, fq); else run<false, true>(acc, u, wr, wc, fr, fq);
    }
};

#ifdef PROBE_P2NULL
struct EpiNull {
    static constexpr bool PERM = true, AFTER_DRAIN = false;
    float* O;
    __device__ __forceinline__ void operator()(const f32x4 (&acc)[2][2][4][2], const Unit& u, int wr, int wc, int fr, int fq) const {
        if (*(const volatile int*)O == 12345) {
#pragma unroll
            for (int ai = 0; ai < 2; ++ai)
#pragma unroll
                for (int bj = 0; bj < 2; ++bj)
#pragma unroll
                    for (int m = 0; m < 4; ++m) { O[((ai * 2 + bj) * 4 + m) * 8 + fr + wr + wc + fq] = acc[ai][bj][m][0][0] + acc[ai][bj][m][1][1] + acc[ai][bj][m][0][2] + acc[ai][bj][m][1][3] + acc[ai][bj][m][0][1] + acc[ai][bj][m][1][0] + acc[ai][bj][m][0][3] + acc[ai][bj][m][1][2]; }
        }
    }
};
#endif
template <int NM, int NN, int GM = WGM, bool REV = false> struct StaticOrderC {
    static_assert(NM % GM == 0, "row tiles in whole groups");
    static_assert(!REV || (NM * NN) % NXCD == 0, "REV is written for equal chunks");
    int G, c;
    __host__ __device__ void init(int G_, int c_) { G = G_; c = c_; }
    __host__ __device__ bool next(int i, Unit& u) const {
        constexpr int nwg = NM * NN, q = nwg / NXCD, r = nwg % NXCD, nig = GM * NN;
        const long L = (long)i * G + c; if (L >= nwg) return false;
        int wgid = (int)L; { const int xcd = wgid % NXCD, off = wgid / NXCD; wgid = (xcd < r ? xcd * (q + 1) : r * (q + 1) + (xcd - r) * q) + (REV ? q - 1 - off : off); }
        const int gid = wgid / nig, fm = gid * GM, rem = wgid % nig;
        u.pm = fm + (rem % GM); u.pn = rem / GM; return true;
    }
    __device__ __forceinline__ void a_ready(const Unit&) const {}
    __device__ __forceinline__ void done(const Unit&) const {}
};

struct EpiQKV {
    static constexpr bool PERM = true, AFTER_DRAIN = false;
    bf16_t* Z; float* out; const float* gains; int l; PG8_LAS float* part;
    static constexpr unsigned OFF_AK = 75497472u, OFF_AV = 79691776u, OFF_BK = 83886080u, OFF_BV = 88080384u;
    __device__ __forceinline__ void operator()(const f32x4 (&acc)[2][2][4][2], const Unit& u, int wr, int wc, int fr_in, int fq_in) const {
        int fr = fr_in, fq = fq_in; asm volatile("" : "+v"(fr), "+v"(fq));
        const int pn = u.pn, row0 = u.pm * BM + wr * 64 + fr;
        const bool ctx = u.pm < 16;
        if (pn >= 10) {
#pragma unroll
            for (int ai = 0; ai < 2; ++ai)
#pragma unroll
                for (int m = 0; m < 4; ++m) { bf16_t* rowp = Z + (size_t)(row0 + ai * HALF + m * 16) * 3584 + 2560 + (pn - 10) * HALF + wc * 32 + 8 * fq;
                    const f32x4 a0 = acc[ai][0][m][0], a1 = acc[ai][0][m][1], g0 = acc[ai][1][m][0], g1 = acc[ai][1][m][1];
                    u32x4 w; w.x = glu_pk((f32x2){a0[0], a0[1]}, (f32x2){g0[0], g0[1]}); w.y = glu_pk((f32x2){a0[2], a0[3]}, (f32x2){g0[2], g0[3]});
                    w.z = glu_pk((f32x2){a1[0], a1[1]}, (f32x2){g1[0], g1[1]}); w.w = glu_pk((f32x2){a1[2], a1[3]}, (f32x2){g1[2], g1[3]});
                    *(u32x4*)rowp = w; }
        } else if (pn == 3 || pn == 9) {
#pragma unroll
            for (int ai = 0; ai < 2; ++ai)
#pragma unroll
                for (int m = 0; m < 4; ++m) { const int R = row0 + ai * HALF + m * 16; bf16_t* rowp = Z + (size_t)R * 3584 + pn * BM + wc * 32 + 8 * fq;
#pragma unroll
                    for (int bj = 0; bj < 2; ++bj) { const f32x4 v0 = acc[ai][bj][m][0], v1 = acc[ai][bj][m][1];
                        u32x4 w; w.x = cvt_pk_bf16(v0[0], v0[1]); w.y = cvt_pk_bf16(v0[2], v0[3]); w.z = cvt_pk_bf16(v1[0], v1[1]); w.w = cvt_pk_bf16(v1[2], v1[3]);
                        *(u32x4*)(rowp + bj * HALF) = w;
                        if (ctx) { const unsigned oo = (pn == 3 ? OFF_AV : OFF_BV) + (unsigned)(((((R >> 8) * 4 + l) * 256 + (R & 255)) * 2 + bj) * 128 + wc * 32 + 8 * fq); float* op = out + oo; *(f32x4*)op = v0; *(f32x4*)(op + 4) = v1; } } }
        } else {
            const bool isK = (pn == 2 || pn == 8);
            const float* g = gains + (pn < 2 ? 0 : pn == 2 ? 128 : pn < 8 ? 256 : 384);
#pragma unroll
            for (int ai = 0; ai < 2; ++ai)
#pragma unroll
                for (int m = 0; m < 4; ++m)
#pragma unroll
                    for (int bj = 0; bj < 2; ++bj) { const f32x4 a = acc[ai][bj][m][0], b = acc[ai][bj][m][1];
                        float s = (a[0] * a[0] + a[1] * a[1]) + (a[2] * a[2] + a[3] * a[3]) + (b[0] * b[0] + b[1] * b[1]) + (b[2] * b[2] + b[3] * b[3]);
                        { auto r_ = __builtin_amdgcn_permlane16_swap(__float_as_uint(s), __float_as_uint(s), false, false); s = __uint_as_float(r_[0]) + __uint_as_float(r_[1]); } { auto r_ = __builtin_amdgcn_permlane32_swap(__float_as_uint(s), __float_as_uint(s), false, false); s = __uint_as_float(r_[0]) + __uint_as_float(r_[1]); }
                        if (fq == 0) part[((ai * HALF + wr * 64 + m * 16 + fr) * 2 + bj) * 4 + wc] = s; }
            __builtin_amdgcn_sched_barrier(0);
            asm volatile("s_waitcnt lgkmcnt(0)" ::: "memory"); __builtin_amdgcn_s_barrier(); asm volatile("" ::: "memory");
            const f32x4 g1 = *(const f32x4*)(g + 16 * wc + 4 * fq), g2 = *(const f32x4*)(g + 64 + 16 * wc + 4 * fq);
            float invr[4];
#pragma unroll
            for (int e = 0; e < 4; ++e) { const int jj = (16 * wc + 4 * fq + e) & 31; invr[e] = __builtin_amdgcn_exp2f(-(float)jj * (13.287712379549449f / 32.0f)) * 0.15915494309189535f; }
#pragma unroll
            for (int ai = 0; ai < 2; ++ai)
#pragma unroll
                for (int m = 0; m < 4; ++m) { const int rl = ai * HALF + wr * 64 + m * 16 + fr, R = u.pm * BM + rl;
                    float cs[4] = {1.f, 1.f, 1.f, 1.f}, sn[4] = {0.f, 0.f, 0.f, 0.f};
                    if (!ctx) { const int t = (R - 4096) & 4095; const float pos = (float)(wc < 2 ? (t >> 6) : (t & 63));
#pragma unroll
                        for (int e = 0; e < 4; ++e) { const float rev = pos * invr[e]; cs[e] = __builtin_amdgcn_cosf(rev); sn[e] = __builtin_amdgcn_sinf(rev); } }
#pragma unroll
                    for (int bj = 0; bj < 2; ++bj) { const f32x4 p = *(const PG8_LAS f32x4*)(part + (rl * 2 + bj) * 4);
                        const float rstd = __builtin_amdgcn_rsqf(((p[0] + p[1]) + (p[2] + p[3])) * (1.0f / 128.0f) + 1e-6f);
                        const f32x4 v1 = acc[ai][bj][m][0] * rstd * g1, v2 = acc[ai][bj][m][1] * rstd * g2;
                        if (isK && ctx) { const unsigned oo = (pn == 2 ? OFF_AK : OFF_BK) + (unsigned)(((((R >> 8) * 4 + l) * 256 + (R & 255)) * 2 + bj) * 128 + 16 * wc + 4 * fq); float* op = out + oo; *(f32x4*)op = v1; *(f32x4*)(op + 64) = v2; }
                        float o1[4], o2[4];
#pragma unroll
                        for (int e = 0; e < 4; e += 2) { const f32x2 a1 = {v1[e], v1[e + 1]}, a2 = {v2[e], v2[e + 1]}, c2 = {cs[e], cs[e + 1]}, s2 = {sn[e], sn[e + 1]};
                            const f32x2 r1 = __builtin_elementwise_fma(a1, c2, -(a2 * s2)), r2 = __builtin_elementwise_fma(a2, c2, a1 * s2);
                            o1[e] = r1.x; o1[e + 1] = r1.y; o2[e] = r2.x; o2[e + 1] = r2.y; }
                        const unsigned q1x = cvt_pk_bf16(o1[0], o1[1]), q1y = cvt_pk_bf16(o1[2], o1[3]), q2x = cvt_pk_bf16(o2[0], o2[1]), q2y = cvt_pk_bf16(o2[2], o2[3]);
                        const auto s0 = __builtin_amdgcn_permlane16_swap(q1x, q2x, false, false); const auto s1 = __builtin_amdgcn_permlane16_swap(q1y, q2y, false, false);
                        u32x4 w; w.x = s0[0]; w.y = s1[0]; w.z = s0[1]; w.w = s1[1];
                        bf16_t* zp = Z + (size_t)R * 3584 + pn * BM + bj * HALF + 16 * wc + ((fq & 1) ? 64 + 4 * (fq - 1) : 4 * fq);
                        *(u32x4*)zp = w; }
                    __builtin_amdgcn_sched_barrier(0); }
        }
    }
};

template <class Epi, class Sched, bool ALIGN_EPI = false, bool SP2 = false, bool HALFN = false  >
__device__ __forceinline__ void gemm_phase(PG8_LAS unsigned char* lds, const Gemm g, const Sched& S, const Epi& E, const int wave_u  ) {
    unsigned lz_ = 0u; asm volatile("" : "+v"(lz_)); int lane_l = (int)__builtin_amdgcn_mbcnt_hi(~0u, __builtin_amdgcn_mbcnt_lo(~0u, lz_));
    const int tid = wave_u * 64 + lane_l, wid = __builtin_amdgcn_readfirstlane(tid >> 6), lane = tid & 63, wr = wid >> 2, wc = wid & 3, fr = lane & 15, fq = lane >> 4;
    static_assert(!HALFN || SP2, "HALFN is written for the SP2 loop only");
    const int K = g.K, nt = K / BK;
    unsigned voffA[2], voffB[2];
#pragma unroll
    for (int i = 0; i < 2; ++i) { int R, C; stage_rc(tid * 16 + i * 8192, R, C); const int Rb = Epi::PERM ? ((R & ~31) + perm32(R & 31)) : R;
        voffA[i] = (unsigned)(R * K + C) * 2u; voffB[i] = (unsigned)(Rb * K + C) * 2u; }
    const size_t kstep = (size_t)(BK * 2);
    const size_t hstep = (size_t)HALF * K * 2;
    const size_t tstep = 2 * hstep;
    const unsigned ldsw = (unsigned)wid * 1024u;
    const int aoff = lds_byte(wr * 64 + fr, fq * 8), boff = lds_byte(wc * 32 + fr, fq * 8);
#define PG8_SA(b, h) (((b) * 2 + (h)) * HTB)
#define PG8_SB(b, h) ((4 + (b) * 2 + (h)) * HTB)
#define PG8_STAGE(bufoff, gbase, voff) do { _Pragma("unroll") for (int _i = 0; _i < 2; ++_i) \
        __builtin_amdgcn_global_load_lds((const unsigned*)((const char*)(gbase) + (voff)[_i]), (PG8_LAS unsigned*)(lds + (bufoff) + ldsw + _i * 8192), 16, 0, 0); } while (0)
#define PG8_LDA(dst, b, h) do { _Pragma("unroll") for (int m = 0; m < 4; ++m) _Pragma("unroll") for (int k = 0; k < 2; ++k) dst[m][k] = *(const PG8_LAS bf16x8*)(lds + PG8_SA(b, h) + aoff + m * 2048 + k * 1024); } while (0)
#define PG8_LDB(dst, b, h) do { _Pragma("unroll") for (int n = 0; n < 2; ++n) _Pragma("unroll") for (int k = 0; k < 2; ++k) dst[n][k] = *(const PG8_LAS bf16x8*)(lds + PG8_SB(b, h) + boff + n * 2048 + k * 1024); } while (0)
#define PG8_MMA(ai, bj, At, Bt) do { __builtin_amdgcn_s_setprio(1); _Pragma("unroll") for (int m = 0; m < 4; ++m) _Pragma("unroll") for (int n = 0; n < 2; ++n) _Pragma("unroll") for (int k = 0; k < 2; ++k) \
        acc[ai][bj][m][n] = __builtin_amdgcn_mfma_f32_16x16x32_bf16(Bt[n][k], At[m][k], acc[ai][bj][m][n], 0, 0, 0); __builtin_amdgcn_s_setprio(0); } while (0)
#define PG8_MMAZ(ai, bj, At, Bt) do { __builtin_amdgcn_s_setprio(1); _Pragma("unroll") for (int m = 0; m < 4; ++m) _Pragma("unroll") for (int n = 0; n < 2; ++n) { \
        acc[ai][bj][m][n] = __builtin_amdgcn_mfma_f32_16x16x32_bf16(Bt[n][0], At[m][0], (f32x4){0.f, 0.f, 0.f, 0.f}, 0, 0, 0); \
        acc[ai][bj][m][n] = __builtin_amdgcn_mfma_f32_16x16x32_bf16(Bt[n][1], At[m][1], acc[ai][bj][m][n], 0, 0, 0); } __builtin_amdgcn_s_setprio(0); } while (0)
#define PG8_MMAF(ai, bj, At, Bt) do { if (first_) PG8_MMAZ(ai, bj, At, Bt); else PG8_MMA(ai, bj, At, Bt); } while (0)
#define PG8_WAIT_V(n) asm volatile("s_waitcnt vmcnt(" #n ")" ::: "memory")
#define PG8_WAIT_L(n) asm volatile("s_waitcnt lgkmcnt(" #n ")" ::: "memory")
#define PG8_BAR __builtin_amdgcn_s_barrier()
#define PG8_SCHED __builtin_amdgcn_sched_barrier(0)
    Unit cur, nxt; int ui = 0;
    if (!S.next(0, cur)) return;
    f32x4 acc[2][2][4][2];
    if constexpr (!SP2 || HALFN) {
#pragma unroll
    for (int a = 0; a < 2; ++a)
#pragma unroll
        for (int b = 0; b < 2; ++b)
#pragma unroll
            for (int m = 0; m < 4; ++m)
#pragma unroll
                for (int n = 0; n < 2; ++n) acc[a][b][m][n] = (f32x4){0.f, 0.f, 0.f, 0.f};
    }
    bf16x8 At[4][2], B0[2][2], B1[2][2];
    const char* cA = (const char*)g.A + (size_t)cur.pm * tstep; const char* cB = (const char*)g.Bt + (size_t)cur.pn * (HALFN ? hstep : tstep);
    S.a_ready(cur);
    if constexpr (SP2) {
        PG8_STAGE(PG8_SB(0, 0), cB, voffB); PG8_STAGE(PG8_SB(0, 1), cB + hstep, voffB); PG8_STAGE(PG8_SA(0, 0), cA, voffA); PG8_STAGE(PG8_SA(0, 1), cA + hstep, voffA);
        if (wr == 1) PG8_BAR;
        PG8_WAIT_V(2); PG8_BAR;
        PG8_STAGE(PG8_SB(1, 0), cB + kstep, voffB); PG8_STAGE(PG8_SA(1, 0), cA + kstep, voffA); PG8_STAGE(PG8_SB(1, 1), cB + hstep + kstep, voffB);
        PG8_WAIT_V(6); PG8_BAR;
    } else {
        PG8_STAGE(PG8_SB(0, 0), cB, voffB); PG8_STAGE(PG8_SA(0, 0), cA, voffA); PG8_STAGE(PG8_SB(0, 1), cB + hstep, voffB); PG8_STAGE(PG8_SA(0, 1), cA + hstep, voffA);
        if (wr == 1) PG8_BAR;
        PG8_WAIT_V(4); PG8_BAR;
        PG8_STAGE(PG8_SB(1, 0), cB + kstep, voffB); PG8_STAGE(PG8_SA(1, 0), cA + kstep, voffA); PG8_STAGE(PG8_SB(1, 1), cB + hstep + kstep, voffB);
        PG8_WAIT_V(6); PG8_BAR;
    }
    for (;;) {
        const bool has_next = S.next(ui + 1, nxt);
        const char* nA = has_next ? (const char*)g.A + (size_t)nxt.pm * tstep : cA; const char* nB = has_next ? (const char*)g.Bt + (size_t)nxt.pn * (HALFN ? hstep : tstep) : cB;
        for (int t = 0; t < nt; t += 2) {
            const bool last = (t == nt - 2); const bool first_ = (t == 0); (void)first_;
            const char* a1 = cA + (size_t)(t + 1) * kstep;
            const char* a2 = last ? nA : cA + (size_t)(t + 2) * kstep; const char* b2 = last ? nB : cB + (size_t)(t + 2) * kstep;
            const char* a3 = a2 + kstep; const char* b3 = b2 + kstep;
            if (last && has_next) S.a_ready(nxt);
            if constexpr (SP2) {
            PG8_LDB(B0, 0, 0); if constexpr (!HALFN) PG8_LDB(B1, 0, 1); PG8_SCHED; PG8_LDA(At, 0, 0); PG8_STAGE(PG8_SA(1, 1), a1 + hstep, voffA);
            PG8_WAIT_V(8); PG8_WAIT_L(0); PG8_BAR; if constexpr (HALFN) PG8_MMA(0, 0, At, B0); else { PG8_MMAF(0, 0, At, B0); PG8_MMAF(0, 1, At, B1); } PG8_BAR; PG8_SCHED;
            PG8_LDA(At, 0, 1); PG8_STAGE(PG8_SB(0, 0), b2, voffB); PG8_STAGE(PG8_SB(0, 1), b2 + hstep, voffB); PG8_STAGE(PG8_SA(0, 0), a2, voffA);
            PG8_WAIT_V(8); PG8_WAIT_L(0); PG8_BAR; if constexpr (HALFN) PG8_MMA(1, 0, At, B0); else { PG8_MMAF(1, 0, At, B0); PG8_MMAF(1, 1, At, B1); } PG8_BAR; PG8_SCHED;
            PG8_LDB(B0, 1, 0); if constexpr (!HALFN) PG8_LDB(B1, 1, 1); PG8_SCHED; PG8_LDA(At, 1, 0); PG8_STAGE(PG8_SA(0, 1), a2 + hstep, voffA);
            PG8_WAIT_V(8); PG8_WAIT_L(0); PG8_BAR; PG8_MMA(0, 0, At, B0); if constexpr (!HALFN) PG8_MMA(0, 1, At, B1); PG8_BAR; PG8_SCHED;
            PG8_LDA(At, 1, 1); PG8_STAGE(PG8_SB(1, 0), b3, voffB); PG8_STAGE(PG8_SB(1, 1), b3 + hstep, voffB); PG8_STAGE(PG8_SA(1, 0), a3, voffA);
            PG8_WAIT_V(8); PG8_WAIT_L(0); PG8_BAR; PG8_MMA(1, 0, At, B0); if constexpr (!HALFN) PG8_MMA(1, 1, At, B1); PG8_BAR; PG8_SCHED;
            } else {
            PG8_LDB(B0, 0, 0); PG8_SCHED; PG8_LDA(At, 0, 0); PG8_STAGE(PG8_SA(1, 1), a1 + hstep, voffA);
            PG8_WAIT_L(8); PG8_BAR; PG8_WAIT_L(0); PG8_MMA(0, 0, At, B0); PG8_BAR; PG8_SCHED;
            PG8_LDB(B1, 0, 1); PG8_STAGE(PG8_SB(0, 0), b2, voffB);
            PG8_BAR; PG8_WAIT_L(0); PG8_MMA(0, 1, At, B1); PG8_BAR;
            PG8_LDA(At, 0, 1); PG8_STAGE(PG8_SA(0, 0), a2, voffA);
            PG8_BAR; PG8_WAIT_L(0); PG8_MMA(1, 0, At, B0); PG8_BAR; PG8_SCHED;
            PG8_STAGE(PG8_SB(0, 1), b2 + hstep, voffB);
            PG8_WAIT_V(6); PG8_BAR; PG8_MMA(1, 1, At, B1); PG8_BAR;
            PG8_LDB(B0, 1, 0); PG8_SCHED; PG8_LDA(At, 1, 0); PG8_STAGE(PG8_SA(0, 1), a2 + hstep, voffA);
            PG8_WAIT_L(8); PG8_BAR; PG8_WAIT_L(0); PG8_MMA(0, 0, At, B0); PG8_BAR; PG8_SCHED;
            PG8_LDB(B1, 1, 1); PG8_STAGE(PG8_SB(1, 0), b3, voffB);
            PG8_BAR; PG8_WAIT_L(0); PG8_MMA(0, 1, At, B1); PG8_BAR;
            PG8_LDA(At, 1, 1); PG8_STAGE(PG8_SA(1, 0), a3, voffA);
            PG8_BAR; PG8_WAIT_L(0); PG8_MMA(1, 0, At, B0); PG8_BAR; PG8_SCHED;
            PG8_STAGE(PG8_SB(1, 1), b3 + hstep, voffB);
            PG8_WAIT_V(6); PG8_BAR; PG8_MMA(1, 1, At, B1); PG8_BAR;
            }
        }
        if constexpr (ALIGN_EPI) { if (wr == 0) PG8_BAR; }
        if constexpr (!Epi::AFTER_DRAIN) { unsigned lze_ = 0u; asm volatile("" : "+v"(lze_)); const int le_ = (int)__builtin_amdgcn_mbcnt_hi(~0u, __builtin_amdgcn_mbcnt_lo(~0u, lze_));
            E(acc, cur, wr, wc, le_ & 15, le_ >> 4); S.done(cur); }
        if (!has_next) break;
        if constexpr (!SP2 || HALFN) {
#pragma unroll
        for (int a = 0; a < 2; ++a)
#pragma unroll
            for (int b = 0; b < 2; ++b)
#pragma unroll
                for (int m = 0; m < 4; ++m)
#pragma unroll
                    for (int n = 0; n < 2; ++n) acc[a][b][m][n] = (f32x4){0.f, 0.f, 0.f, 0.f};
        }
        cur = nxt; cA = nA; cB = nB; ++ui;
        if constexpr (ALIGN_EPI) { if (wr == 1) PG8_BAR; }
    }
    PG8_WAIT_V(0);
    if constexpr (!ALIGN_EPI) { if (wr == 0) PG8_BAR; }
    PG8_BAR;
    if constexpr (Epi::AFTER_DRAIN) { E.fused(acc, cur, wr, wc, fr, fq, lds, wid, lane); S.done(cur); }
#undef PG8_SA
#undef PG8_SB
#undef PG8_STAGE
#undef PG8_LDA
#undef PG8_LDB
#undef PG8_MMA
#undef PG8_MMAZ
#undef PG8_MMAF
#undef PG8_WAIT_V
#undef PG8_WAIT_L
#undef PG8_BAR
#undef PG8_SCHED
}
}
#define LAS __attribute__((address_space(3)))
#define XB_TMO      128
#define XB_XCNT(j)  (256  + 64 * (j))
#define XB_XSUB(j)  (1280 + 64 * (j))
#define XB_XGEN(j)  (2304 + 64 * (j))
#define XB_TOP      3328
#define XB_TOPGEN   3392
#define XCD_BAR_WORDS 3456
#define XB_SPIN_CAP (1u << 18)

__device__ __forceinline__ unsigned xb_ld(unsigned* p)              { return __hip_atomic_load(p, __ATOMIC_RELAXED, __HIP_MEMORY_SCOPE_AGENT); }
__device__ __forceinline__ unsigned xb_add(unsigned* p, unsigned v) { return __hip_atomic_fetch_add(p, v, __ATOMIC_RELAXED, __HIP_MEMORY_SCOPE_AGENT); }
__device__ __forceinline__ unsigned xb_xcc_id() { return (unsigned)__builtin_amdgcn_s_getreg((3 << 11) | 20) & 0xFu; }
#define XB_SPIN(cond, bar) do { unsigned _sp = 0; while (cond) { __builtin_amdgcn_s_sleep(1); \
    if ((++_sp & 255u) == 0u) { if (xb_ld(&(bar)[XB_TMO])) break; if (_sp > XB_SPIN_CAP) { atomicAdd(&(bar)[XB_TMO], 1u); break; } } } } while (0)

struct XcdBarrier {
    unsigned* bar; unsigned x;
    volatile LAS unsigned* st;
};

__device__ __forceinline__ XcdBarrier xcd_barrier_post(unsigned* bar, volatile LAS unsigned* st) {
    XcdBarrier b; b.bar = bar; b.x = xb_xcc_id(); b.st = st;
    if (threadIdx.x == 0) (void)xb_add(&bar[XB_XCNT(b.x)], 1u);
    return b;
}
__device__ __forceinline__ void xcd_barrier_complete(unsigned* bar, unsigned x, unsigned& nloc, unsigned& nx) {
    const unsigned G = gridDim.x * gridDim.y * gridDim.z;
    unsigned sum, cnt, mine, sp = 0u;
    for (;;) {
        sum = 0u; cnt = 0u; mine = 0u;
#pragma unroll
        for (unsigned j = 0; j < 16; ++j) { const unsigned c = xb_ld(&bar[XB_XCNT(j)]); sum += c; cnt += (c > 0u) ? 1u : 0u; mine = (j == x) ? c : mine; }
        if (sum == G) break;
        __builtin_amdgcn_s_sleep(1);
        if ((++sp & 255u) == 0u) { if (xb_ld(&bar[XB_TMO])) break; if (sp > XB_SPIN_CAP) { atomicAdd(&bar[XB_TMO], 1u); break; } }
    }
    nloc = mine > 0u ? mine : 1u; nx = cnt > 0u ? cnt : 1u;
}

__device__ __forceinline__ void xcd_barrier(const XcdBarrier& b) {
    unsigned* bar_u = b.bar; asm volatile("" : "+s"(bar_u));
    asm volatile("s_waitcnt vmcnt(0)" ::: "memory");
    __syncthreads();
    if (threadIdx.x == 0) {
        unsigned* bar = bar_u; const unsigned bx_ = xb_xcc_id();
        __builtin_amdgcn_s_waitcnt(0);
        unsigned nloc = b.st[0], nx = b.st[1];
        if (nloc == 0u) { xcd_barrier_complete(bar, bx_, nloc, nx); b.st[0] = nloc; b.st[1] = nx; }
        const unsigned old = xb_add(&bar[XB_XSUB(bx_)], 1u);
        const unsigned gen = old / nloc;
        if (old + 1u == (gen + 1u) * nloc) {
            __builtin_amdgcn_fence(__ATOMIC_RELEASE, "agent");
            asm volatile("s_waitcnt vmcnt(0)" ::: "memory");
            const unsigned og = xb_add(&bar[XB_TOP], 1u);
            const unsigned tg = og / nx;
            if (og + 1u == (tg + 1u) * nx) xb_add(&bar[XB_TOPGEN], 1u);
            else XB_SPIN(xb_ld(&bar[XB_TOPGEN]) == tg, bar);
            __builtin_amdgcn_fence(__ATOMIC_ACQUIRE, "agent");
            xb_add(&bar[XB_XGEN(bx_)], 1u);
            asm volatile("s_waitcnt vmcnt(0)" ::: "memory");
        } else {
            XB_SPIN(xb_ld(&bar[XB_XGEN(bx_)]) == gen, bar);
            __builtin_amdgcn_fence(__ATOMIC_ACQUIRE, "agent");
            asm volatile("s_waitcnt vmcnt(0)" ::: "memory");
        }
    }
    __syncthreads();
}
namespace att {
#define ATT_LAS __attribute__((address_space(3)))
#define ATT_GAS __attribute__((address_space(1)))
typedef unsigned short bf16_t;
typedef short bf16x8 __attribute__((ext_vector_type(8)));
typedef short s16x4 __attribute__((ext_vector_type(4)));
typedef float f32x16 __attribute__((ext_vector_type(16)));
typedef unsigned u32x4 __attribute__((ext_vector_type(4)));
constexpr int D = 128, NW = 8, QBLK = 32, KVBLK = 64;
constexpr float SCALE = 0.088388347648318440f, THR = 8.f, LOG2E = 1.4426950408889634f, QSCALE = SCALE * LOG2E  , THRL = THR * LOG2E;
constexpr int SHM_V = KVBLK * D * 2, SHM_K = KVBLK * D * 2, NBUF = 3, SHM_ATTN = NBUF * (SHM_V + SHM_K) + NW * 64 * 4;
#define KSWZ(row, colB) ((row) * 256 + ((colB) ^ (((row) & 7) << 4)))
#define SBAR() __builtin_amdgcn_sched_barrier(0)
__device__ __forceinline__ int crow(int r, int hi) { return (r & 3) + 8 * (r >> 2) + 4 * hi; }
__device__ __forceinline__ unsigned cvtpk(float lo, float hi) { unsigned r; asm volatile("v_cvt_pk_bf16_f32 %0, %1, %2" : "=v"(r) : "v"(lo), "v"(hi)); return r; }
__device__ __forceinline__ void partialSM(f32x16& p0, f32x16& p1, float& m_reg, float& mn, float& alpha) {
  float pmax = p0[0];
#pragma unroll
  for (int r = 1; r < 16; ++r) pmax = fmaxf(pmax, p0[r]);
#pragma unroll
  for (int r = 0; r < 16; ++r) pmax = fmaxf(pmax, p1[r]);
  { auto rr = __builtin_amdgcn_permlane32_swap(__float_as_uint(pmax), __float_as_uint(pmax), false, false);
    pmax = fmaxf(__uint_as_float(rr[0]), __uint_as_float(rr[1])); }
  pmax = fmaxf(pmax, -1e30f);
  mn = pmax; alpha = 1.f; m_reg = pmax;
#pragma unroll
  for (int r = 0; r < 16; ++r) p0[r] -= pmax;
#pragma unroll
  for (int r = 0; r < 16; ++r) p1[r] -= pmax;
#pragma unroll
  for (int r = 0; r < 16; ++r) p0[r] = __builtin_amdgcn_exp2f(p0[r]);
}
__device__ __forceinline__ void finishSM(f32x16& p0, f32x16& p1, float alpha, float& l_reg, bf16x8& pa0, bf16x8& pa1, bf16x8& pa2, bf16x8& pa3) {
#pragma unroll
  for (int r = 0; r < 16; ++r) p1[r] = __builtin_amdgcn_exp2f(p1[r]);
  float ps = 0;
#pragma unroll
  for (int r = 0; r < 16; ++r) ps += p0[r];
#pragma unroll
  for (int r = 0; r < 16; ++r) ps += p1[r];
  { auto rr = __builtin_amdgcn_permlane32_swap(__float_as_uint(ps), __float_as_uint(ps), false, false);
    ps = __uint_as_float(rr[0]) + __uint_as_float(rr[1]); }
  l_reg = l_reg * alpha + ps;
#define PK4(P, BASE, OUT) do { u32x4 w = {cvtpk(P[BASE + 0], P[BASE + 1]), cvtpk(P[BASE + 2], P[BASE + 3]), cvtpk(P[BASE + 4], P[BASE + 5]), cvtpk(P[BASE + 6], P[BASE + 7])}; \
    OUT = *reinterpret_cast<bf16x8*>(&w); } while (0)
  PK4(p0, 0, pa0); PK4(p0, 8, pa1); PK4(p1, 0, pa2); PK4(p1, 8, pa3);
#undef PK4
}
__device__ __forceinline__ void mask_win(f32x16& p0, f32x16& p1, int dq) {
  unsigned nb_ = 0xff800000u; asm volatile("" : "+s"(nb_)); const float NEG = __uint_as_float(nb_);
#pragma unroll
  for (int r = 0; r < 16; ++r) { const int c = (r & 3) + 8 * (r >> 2);
    if ((unsigned)(dq - c) >= 257u) p0[r] = NEG;
    if ((unsigned)(dq - c - 32) >= 257u) p1[r] = NEG; }
}
template <int OFF> __device__ __forceinline__ bf16x8 k_rd(int a) { bf16x8 r; asm volatile("ds_read_b128 %0, %1 offset:%2" : "=v"(r) : "v"(a), "i"(OFF) : "memory"); return r; }
#define TIE2(N, A, B) asm volatile("s_waitcnt lgkmcnt(" #N ")" : "+v"(A), "+v"(B))
#define QK_MMA(X0, X1, D) do { p0 = __builtin_amdgcn_mfma_f32_32x32x16_bf16(X0, qr[D], p0, 0, 0, 0); p1 = __builtin_amdgcn_mfma_f32_32x32x16_bf16(X1, qr[D], p1, 0, 0, 0); } while (0)
template <int KB> __device__ __forceinline__ void qkt(f32x16& p0, f32x16& p1, int ka0, int ka1, int ka2, int ka3, const bf16x8* qr, const f32x16& negm) {
#ifdef QK_DEPTH3
  bf16x8 a0 = k_rd<KB>(ka0), a1 = k_rd<KB + 8192>(ka0);
  bf16x8 b0 = k_rd<KB>(ka1), b1 = k_rd<KB + 8192>(ka1);
  bf16x8 c0 = k_rd<KB>(ka2), c1 = k_rd<KB + 8192>(ka2);
  TIE2(4, a0, a1); p0 = __builtin_amdgcn_mfma_f32_32x32x16_bf16(a0, qr[0], negm, 0, 0, 0); p1 = __builtin_amdgcn_mfma_f32_32x32x16_bf16(a1, qr[0], negm, 0, 0, 0); a0 = k_rd<KB>(ka3); a1 = k_rd<KB + 8192>(ka3);
  TIE2(4, b0, b1); QK_MMA(b0, b1, 1); b0 = k_rd<KB + 128>(ka0); b1 = k_rd<KB + 128 + 8192>(ka0);
  TIE2(4, c0, c1); QK_MMA(c0, c1, 2); c0 = k_rd<KB + 128>(ka1); c1 = k_rd<KB + 128 + 8192>(ka1);
  TIE2(4, a0, a1); QK_MMA(a0, a1, 3); a0 = k_rd<KB + 128>(ka2); a1 = k_rd<KB + 128 + 8192>(ka2);
  TIE2(4, b0, b1); QK_MMA(b0, b1, 4); b0 = k_rd<KB + 128>(ka3); b1 = k_rd<KB + 128 + 8192>(ka3);
  TIE2(4, c0, c1); QK_MMA(c0, c1, 5);
  TIE2(2, a0, a1); QK_MMA(a0, a1, 6);
  TIE2(0, b0, b1); QK_MMA(b0, b1, 7);
#else
  bf16x8 a0 = k_rd<KB>(ka0), a1 = k_rd<KB + 8192>(ka0);
  bf16x8 b0 = k_rd<KB>(ka1), b1 = k_rd<KB + 8192>(ka1);
  TIE2(2, a0, a1); p0 = __builtin_amdgcn_mfma_f32_32x32x16_bf16(a0, qr[0], negm, 0, 0, 0); p1 = __builtin_amdgcn_mfma_f32_32x32x16_bf16(a1, qr[0], negm, 0, 0, 0); a0 = k_rd<KB>(ka2); a1 = k_rd<KB + 8192>(ka2);
  TIE2(2, b0, b1); QK_MMA(b0, b1, 1); b0 = k_rd<KB>(ka3); b1 = k_rd<KB + 8192>(ka3);
  TIE2(2, a0, a1); QK_MMA(a0, a1, 2); a0 = k_rd<KB + 128>(ka0); a1 = k_rd<KB + 128 + 8192>(ka0);
  TIE2(2, b0, b1); QK_MMA(b0, b1, 3); b0 = k_rd<KB + 128>(ka1); b1 = k_rd<KB + 128 + 8192>(ka1);
  TIE2(2, a0, a1); QK_MMA(a0, a1, 4); a0 = k_rd<KB + 128>(ka2); a1 = k_rd<KB + 128 + 8192>(ka2);
  TIE2(2, b0, b1); QK_MMA(b0, b1, 5); b0 = k_rd<KB + 128>(ka3); b1 = k_rd<KB + 128 + 8192>(ka3);
  TIE2(2, a0, a1); QK_MMA(a0, a1, 6);
  TIE2(0, b0, b1); QK_MMA(b0, b1, 7);
#endif
}
#undef QK_MMA
__device__ __forceinline__ int v_st(int k, int c) { return ((k >> 3) * 4 + (c >> 5)) * 512 + ((k & 7) * 32 + (c & 31)) * 2; }
__device__ __forceinline__ int v_rd_base(int lane) { return ((lane & 3) << 3) | (((lane >> 2) & 3) << 6) | (((lane >> 4) & 1) << 5) | (((lane >> 5) & 1) << 8); }
constexpr int v_rd_off(int d0, int ks, int half) { return d0 * 512 + ks * 4096 + half * 2048; }
template <int OFF> __device__ __forceinline__ s16x4 tr_read(int vb) {
  s16x4 r; asm volatile("ds_read_b64_tr_b16 %0, %1 offset:%2" : "=v"(r) : "v"(vb), "i"(OFF) : "memory"); return r;
}
struct VFrag { s16x4 v0, v1, v2, v3, v4, v5, v6, v7; };
#define V_RD0(F, vb) do { F.v0 = tr_read<v_rd_off(0, 0, 0)>(vb); F.v1 = tr_read<v_rd_off(0, 0, 1)>(vb); F.v2 = tr_read<v_rd_off(0, 1, 0)>(vb); F.v3 = tr_read<v_rd_off(0, 1, 1)>(vb); \
    F.v4 = tr_read<v_rd_off(0, 2, 0)>(vb); F.v5 = tr_read<v_rd_off(0, 2, 1)>(vb); F.v6 = tr_read<v_rd_off(0, 3, 0)>(vb); F.v7 = tr_read<v_rd_off(0, 3, 1)>(vb); } while (0)
#define PK(L, H) (bf16x8){L[0], L[1], L[2], L[3], H[0], H[1], H[2], H[3]}
template <int D0> __device__ __forceinline__ void pv_blk(f32x16& od, VFrag& f, int vb, bf16x8 pa0, bf16x8 pa1, bf16x8 pa2, bf16x8 pa3) {
  if constexpr (D0 < 3) {
    TIE2(6, f.v0, f.v1); od = __builtin_amdgcn_mfma_f32_32x32x16_bf16(pa0, PK(f.v0, f.v1), od, 0, 0, 0); f.v0 = tr_read<v_rd_off(D0 + 1, 0, 0)>(vb); f.v1 = tr_read<v_rd_off(D0 + 1, 0, 1)>(vb);
    TIE2(6, f.v2, f.v3); od = __builtin_amdgcn_mfma_f32_32x32x16_bf16(pa1, PK(f.v2, f.v3), od, 0, 0, 0); f.v2 = tr_read<v_rd_off(D0 + 1, 1, 0)>(vb); f.v3 = tr_read<v_rd_off(D0 + 1, 1, 1)>(vb);
    TIE2(6, f.v4, f.v5); od = __builtin_amdgcn_mfma_f32_32x32x16_bf16(pa2, PK(f.v4, f.v5), od, 0, 0, 0); f.v4 = tr_read<v_rd_off(D0 + 1, 2, 0)>(vb); f.v5 = tr_read<v_rd_off(D0 + 1, 2, 1)>(vb);
    TIE2(6, f.v6, f.v7); od = __builtin_amdgcn_mfma_f32_32x32x16_bf16(pa3, PK(f.v6, f.v7), od, 0, 0, 0); f.v6 = tr_read<v_rd_off(D0 + 1, 3, 0)>(vb); f.v7 = tr_read<v_rd_off(D0 + 1, 3, 1)>(vb);
  } else {
    TIE2(6, f.v0, f.v1); od = __builtin_amdgcn_mfma_f32_32x32x16_bf16(pa0, PK(f.v0, f.v1), od, 0, 0, 0);
    TIE2(4, f.v2, f.v3); od = __builtin_amdgcn_mfma_f32_32x32x16_bf16(pa1, PK(f.v2, f.v3), od, 0, 0, 0);
    TIE2(2, f.v4, f.v5); od = __builtin_amdgcn_mfma_f32_32x32x16_bf16(pa2, PK(f.v4, f.v5), od, 0, 0, 0);
    TIE2(0, f.v6, f.v7); od = __builtin_amdgcn_mfma_f32_32x32x16_bf16(pa3, PK(f.v6, f.v7), od, 0, 0, 0);
  }
}
__device__ __forceinline__ void pv_d0(f32x16* o, VFrag& f, int vb, bf16x8 pa0, bf16x8 pa1, bf16x8 pa2, bf16x8 pa3) {
  pv_blk<0>(o[0], f, vb, pa0, pa1, pa2, pa3); pv_blk<1>(o[1], f, vb, pa0, pa1, pa2, pa3); pv_blk<2>(o[2], f, vb, pa0, pa1, pa2, pa3); pv_blk<3>(o[3], f, vb, pa0, pa1, pa2, pa3);
}

struct AUnit {
  const bf16_t* Q; const bf16_t* K0; const bf16_t* K1; bf16_t* O;
  int nt0, nt1;
  float sink_l2;
  int mask;
  int qk0;
};
constexpr int LDQ = 3584, LD0 = 256, LD1 = 3584, LDO = 2048, VOFF0 = 2097152, VOFF1 = 256;
struct AStage { bf16x8 vs0, vs1, ks0, ks1; };
template <class Dec> __device__ __forceinline__ bool attn_unit(const AUnit& u, const Dec& D, const int Ln, const bool pre, bf16x8 (&qr)[8], AStage (&sr_)[2], ATT_LAS char* lds, const int wave_u) {
  unsigned lz_ = 0u; asm volatile("" : "+v"(lz_)); int lane_l = (int)__builtin_amdgcn_mbcnt_hi(~0u, __builtin_amdgcn_mbcnt_lo(~0u, lz_));
  const int tid = wave_u * 64 + lane_l, wid = __builtin_amdgcn_readfirstlane(tid >> 6), lane = tid & 63, r32 = lane & 31, hi = lane >> 5;
  ATT_LAS char* V_lds = lds; ATT_LAS char* K_lds = lds + NBUF * SHM_V;
  ATT_LAS float* ws = (ATT_LAS float*)(lds + NBUF * (SHM_V + SHM_K)) + wid * 64; ATT_LAS float* li_l = ws; ATT_LAS float* al_l = ws + 32;
  const int sink_b = __builtin_amdgcn_readfirstlane((int)__float_as_uint(u.sink_l2));
  float m_reg = 0.f, l_reg = 0; f32x16 o[4] = {}; f32x16 negm = {};
#define QLOAD(U_) do { unsigned lzq_ = 0u; asm volatile("" : "+v"(lzq_)); const int lq2_ = (int)__builtin_amdgcn_mbcnt_hi(~0u, __builtin_amdgcn_mbcnt_lo(~0u, lzq_)); \
    const unsigned qob_ = ((unsigned)(wid * QBLK + (lq2_ & 31)) * LDQ + (lq2_ >> 5) * 8) * 2u; const ATT_GAS char* Qw_ = (const ATT_GAS char*)(U_).Q; \
    _Pragma("unroll") for (int d0 = 0; d0 < 8; ++d0) qr[d0] = *reinterpret_cast<const ATT_GAS bf16x8*>(Qw_ + (qob_ + d0 * 32)); } while (0)
  if (!pre) QLOAD(u);
  const int sr = tid >> 4, sc = (tid & 15) * 8, vst0 = v_st(sr, sc), vst1 = v_st(32 + sr, sc), kws = KSWZ(sr, sc * 2);
  const int vb0 = (int)(unsigned)(__UINTPTR_TYPE__)V_lds + v_rd_base(lane);
  const int nt0 = u.nt0, NT = u.nt0 + u.nt1;
  const unsigned offa0 = (unsigned)(sr * LD0 + sc) * 2u, offb0 = offa0 + 64u * LD0, offa1 = (unsigned)(sr * LD1 + sc) * 2u, offb1 = offa1 + 64u * LD1;
#define SLOADU(i, K0_, K1_, NT0_, t) do { const int t_ = (t); const int n0_ = (NT0_); const bool s0_ = t_ < n0_;                                    \
    const ATT_GAS char* kp_ = (const ATT_GAS char*)(s0_ ? (const ATT_GAS bf16_t*)(K0_) + (size_t)t_ * (KVBLK * LD0) : (const ATT_GAS bf16_t*)(K1_) + (size_t)(t_ - n0_) * (KVBLK * LD1)); \
    const ATT_GAS char* vp_ = kp_ + (s0_ ? 2 * VOFF0 : 2 * VOFF1); const unsigned oa_ = s0_ ? offa0 : offa1, ob_ = s0_ ? offb0 : offb1;                \
    sr_[i].vs0 = *reinterpret_cast<const ATT_GAS bf16x8*>(vp_ + oa_); sr_[i].vs1 = *reinterpret_cast<const ATT_GAS bf16x8*>(vp_ + ob_);           \
    sr_[i].ks0 = *reinterpret_cast<const ATT_GAS bf16x8*>(kp_ + oa_); sr_[i].ks1 = *reinterpret_cast<const ATT_GAS bf16x8*>(kp_ + ob_); } while (0)
#define SLOAD(i, t) SLOADU(i, u.K0, u.K1, nt0, t)
#define SLOADN(i, t) do { const int tq_ = (t); if (tq_ > NTm1 && pf) { int lq_ = Ln; asm volatile("" : "+s"(lq_)); AUnit un_; D(lq_, un_); SLOADU(i, un_.K0, un_.K1, un_.nt0, tq_ - NT); } \
    else SLOAD(i, tq_ < NTm1 ? tq_ : NTm1); } while (0)
#define SWRITE(off, i) do { *(ATT_LAS bf16x8*)(V_lds + (off) + vst0) = sr_[i].vs0; *(ATT_LAS bf16x8*)(V_lds + (off) + vst1) = sr_[i].vs1; \
    *(ATT_LAS bf16x8*)(K_lds + (off) + kws) = sr_[i].ks0; *(ATT_LAS bf16x8*)(K_lds + (off) + kws + 32 * 256) = sr_[i].ks1; } while (0)
#define SWAIT() asm volatile("s_waitcnt vmcnt(4)" ::: "memory")
#define RESC(a) do { if (__any((a) < 1.f)) { if (hi == 0) al_l[r32] = (a); asm volatile("s_waitcnt lgkmcnt(0)" ::: "memory"); \
    _Pragma("unroll") for (int d = 0; d < 4; ++d) _Pragma("unroll") for (int r = 0; r < 16; ++r) o[d][r] *= al_l[crow(r, hi)]; } } while (0)
#ifdef NOMASK
#define MASKT(P0_, P1_, t) do { } while (0)
#else
#define MASKT(P0_, P1_, t) do { if (u.mask && (t) >= nt0) mask_win(P0_, P1_, (u.qk0 + wid * QBLK + 128 - ((t) - nt0) * KVBLK) + r32 - 4 * hi); } while (0)
#endif
#define TIE4(N, A, B, C, D) asm volatile("s_waitcnt lgkmcnt(" #N ")" : "+v"(A), "+v"(B), "+v"(C), "+v"(D))
#define PVM0(OD, PA, X, Y) do { OD = __builtin_amdgcn_mfma_f32_32x32x16_bf16(PA, PK(X, Y), OD, 0, 0, 0); } while (0)
#define PVM(OD, PA, X, Y, N) do { TIE2(N, X, Y); OD = __builtin_amdgcn_mfma_f32_32x32x16_bf16(PA, PK(X, Y), OD, 0, 0, 0); } while (0)
#define PVR(X, Y, D0, KS, VB) do { X = tr_read<v_rd_off(D0, KS, 0)>(VB); Y = tr_read<v_rd_off(D0, KS, 1)>(VB); } while (0)
#define BLOCK2(P0_, P1_, MN_, AL_, VB_) do { \
    TIE4(4, vf.v0, vf.v1, vf.v2, vf.v3); PVM0(o[0], pa0, vf.v0, vf.v1); PVR(vf.v0, vf.v1, 1, 0, VB_); float pm_ = fmaxf(fmaxf(P0_[0], P0_[1]), P0_[2]); pm_ = fmaxf(fmaxf(pm_, P0_[3]), P0_[4]); pm_ = fmaxf(fmaxf(pm_, P0_[5]), P0_[6]); pm_ = fmaxf(fmaxf(pm_, P0_[7]), P0_[8]); SBAR(); \
    PVM0(o[0], pa1, vf.v2, vf.v3); PVR(vf.v2, vf.v3, 1, 1, VB_); pm_ = fmaxf(fmaxf(pm_, P0_[9]), P0_[10]); pm_ = fmaxf(fmaxf(pm_, P0_[11]), P0_[12]); pm_ = fmaxf(fmaxf(pm_, P0_[13]), P0_[14]); pm_ = fmaxf(fmaxf(pm_, P0_[15]), P1_[0]); SBAR(); \
    TIE4(4, vf.v4, vf.v5, vf.v6, vf.v7); PVM0(o[0], pa2, vf.v4, vf.v5); PVR(vf.v4, vf.v5, 1, 2, VB_); pm_ = fmaxf(fmaxf(pm_, P1_[1]), P1_[2]); pm_ = fmaxf(fmaxf(pm_, P1_[3]), P1_[4]); pm_ = fmaxf(fmaxf(pm_, P1_[5]), P1_[6]); pm_ = fmaxf(fmaxf(pm_, P1_[7]), P1_[8]); SBAR(); \
    PVM0(o[0], pa3, vf.v6, vf.v7); PVR(vf.v6, vf.v7, 1, 3, VB_); pm_ = fmaxf(fmaxf(pm_, P1_[9]), P1_[10]); pm_ = fmaxf(fmaxf(pm_, P1_[11]), P1_[12]); pm_ = fmaxf(fmaxf(pm_, P1_[13]), P1_[14]); pm_ = fmaxf(pm_, P1_[15]); SBAR(); \
    TIE4(4, vf.v0, vf.v1, vf.v2, vf.v3); PVM0(o[1], pa0, vf.v0, vf.v1); PVR(vf.v0, vf.v1, 2, 0, VB_); const bool keep_ = __all(pm_ <= THRL);   SBAR(); \
    PVM0(o[1], pa1, vf.v2, vf.v3); PVR(vf.v2, vf.v3, 2, 1, VB_); MN_ = m_reg; AL_ = 1.f; if (__builtin_expect(!keep_, 0)) { { auto rr_ = __builtin_amdgcn_permlane32_swap(__float_as_uint(pm_), __float_as_uint(pm_), false, false); pm_ = fmaxf(__uint_as_float(rr_[0]), __uint_as_float(rr_[1])); } const float d_ = fmaxf(pm_, 0.f); \
          \
        asm("v_add_f32 %0, %0, %1" : "+v"(m_reg) : "v"(d_)); asm("v_exp_f32 %0, %1" : "+v"(AL_) : "v"(-d_)); const float nm_ = -m_reg; \
        _Pragma("unroll") for (int r_ = 0; r_ < 16; ++r_) { asm("v_sub_f32 %0, %0, %1" : "+v"(P0_[r_]) : "v"(d_)); asm("v_sub_f32 %0, %0, %1" : "+v"(P1_[r_]) : "v"(d_)); asm("v_mov_b32 %0, %1" : "+v"(negm[r_]) : "v"(nm_)); } MN_ = m_reg; } SBAR(); \
    TIE4(4, vf.v4, vf.v5, vf.v6, vf.v7); PVM0(o[1], pa2, vf.v4, vf.v5); PVR(vf.v4, vf.v5, 2, 2, VB_); P0_[0] = __builtin_amdgcn_exp2f(P0_[0]); P0_[1] = __builtin_amdgcn_exp2f(P0_[1]); SBAR(); \
    PVM0(o[1], pa3, vf.v6, vf.v7); PVR(vf.v6, vf.v7, 2, 3, VB_); P0_[2] = __builtin_amdgcn_exp2f(P0_[2]); P0_[3] = __builtin_amdgcn_exp2f(P0_[3]); SBAR(); \
    TIE4(4, vf.v0, vf.v1, vf.v2, vf.v3); PVM0(o[2], pa0, vf.v0, vf.v1); PVR(vf.v0, vf.v1, 3, 0, VB_); P0_[4] = __builtin_amdgcn_exp2f(P0_[4]); P0_[5] = __builtin_amdgcn_exp2f(P0_[5]); SBAR(); \
    PVM0(o[2], pa1, vf.v2, vf.v3); PVR(vf.v2, vf.v3, 3, 1, VB_); P0_[6] = __builtin_amdgcn_exp2f(P0_[6]); P0_[7] = __builtin_amdgcn_exp2f(P0_[7]); SBAR(); \
    TIE4(4, vf.v4, vf.v5, vf.v6, vf.v7); PVM0(o[2], pa2, vf.v4, vf.v5); PVR(vf.v4, vf.v5, 3, 2, VB_); P0_[8] = __builtin_amdgcn_exp2f(P0_[8]); P0_[9] = __builtin_amdgcn_exp2f(P0_[9]); SBAR(); \
    PVM0(o[2], pa3, vf.v6, vf.v7); PVR(vf.v6, vf.v7, 3, 3, VB_); P0_[10] = __builtin_amdgcn_exp2f(P0_[10]); P0_[11] = __builtin_amdgcn_exp2f(P0_[11]); SBAR(); \
    TIE4(4, vf.v0, vf.v1, vf.v2, vf.v3); PVM0(o[3], pa0, vf.v0, vf.v1); P0_[12] = __builtin_amdgcn_exp2f(P0_[12]); P0_[13] = __builtin_amdgcn_exp2f(P0_[13]); SBAR(); \
    PVM0(o[3], pa1, vf.v2, vf.v3); P0_[14] = __builtin_amdgcn_exp2f(P0_[14]); P0_[15] = __builtin_amdgcn_exp2f(P0_[15]); SBAR(); \
    TIE4(0, vf.v4, vf.v5, vf.v6, vf.v7); PVM0(o[3], pa2, vf.v4, vf.v5);  SBAR(); \
    PVM0(o[3], pa3, vf.v6, vf.v7); asm volatile("" : "+v"(P0_), "+v"(P1_)); SBAR(); } while (0)

  f32x16 pA0, pA1, pB0, pB1; float mnA, mnB, alA, alB; bf16x8 pa0, pa1, pa2, pa3; VFrag vf;
  constexpr int SE = 0, SO = 1, KB = NBUF * SHM_V;
  const int lb = (int)(unsigned)(__UINTPTR_TYPE__)lds;
  const int ka0 = lb + KSWZ(r32, (0 * 16 + hi * 8) * 2), ka1 = lb + KSWZ(r32, (1 * 16 + hi * 8) * 2), ka2 = lb + KSWZ(r32, (2 * 16 + hi * 8) * 2), ka3 = lb + KSWZ(r32, (3 * 16 + hi * 8) * 2);
  const int NTm1 = NT - 1;
  int o_p = 0, o_c = SHM_V, o_n = 2 * SHM_V;
#define ROT() do { const int t_ = o_p; o_p = o_c; o_c = o_n; o_n = t_; } while (0)
  const bool pf = Ln >= 0 && NT >= 4;
  if (!pre) SLOAD(SE, 0);
  SWRITE(0, SE); SLOAD(SE, 1); __syncthreads();
  qkt<KB>(pA0, pA1, ka0, ka1, ka2, ka3, qr, negm); MASKT(pA0, pA1, 0); partialSM(pA0, pA1, m_reg, mnA, alA);
  _Pragma("unroll") for (int r_ = 0; r_ < 16; ++r_) negm[r_] = -m_reg;
  SWRITE(SHM_V, SE); SLOAD(SE, 2 < NTm1 ? 2 : NTm1);
  for (int j = 1; j + 1 < NT; j += 2) {
    __syncthreads();
    SBAR(); qkt<KB>(pB0, pB1, ka0 + o_c, ka1 + o_c, ka2 + o_c, ka3 + o_c, qr, negm);
    finishSM(pA0, pA1, alA, l_reg, pa0, pa1, pa2, pa3); SBAR();
    SWRITE(o_n, SE);
    V_RD0(vf, vb0 + o_p); MASKT(pB0, pB1, j);
    SLOADN(SE, j + 2); SBAR();
    BLOCK2(pB0, pB1, mnB, alB, (vb0 + o_p));
    RESC(alB); ROT();
    __syncthreads();
    SBAR(); qkt<KB>(pA0, pA1, ka0 + o_c, ka1 + o_c, ka2 + o_c, ka3 + o_c, qr, negm);
    finishSM(pB0, pB1, alB, l_reg, pa0, pa1, pa2, pa3); SBAR();
    SWRITE(o_n, SE);
    V_RD0(vf, vb0 + o_p); MASKT(pA0, pA1, j + 1);
    SLOADN(SE, j + 3); SBAR();
    BLOCK2(pA0, pA1, mnA, alA, (vb0 + o_p));
    RESC(alA); ROT();
  }
  __syncthreads();
  SBAR(); qkt<KB>(pB0, pB1, ka0 + o_c, ka1 + o_c, ka2 + o_c, ka3 + o_c, qr, negm);
  finishSM(pA0, pA1, alA, l_reg, pa0, pa1, pa2, pa3); SBAR();
  if (pf) { int lq_ = Ln; asm volatile("" : "+s"(lq_)); AUnit un_; D(lq_, un_); QLOAD(un_); }
  V_RD0(vf, vb0 + o_p); MASKT(pB0, pB1, NT - 1); SBAR();
  BLOCK2(pB0, pB1, mnB, alB, (vb0 + o_p));
  RESC(alB);
  finishSM(pB0, pB1, alB, l_reg, pa0, pa1, pa2, pa3); SBAR();
  V_RD0(vf, vb0 + o_c); pv_d0(o, vf, vb0 + o_c, pa0, pa1, pa2, pa3);
#undef ROT
  l_reg += __builtin_amdgcn_exp2f(__uint_as_float((unsigned)sink_b) - m_reg);
  unsigned lze_ = 0u; asm volatile("" : "+v"(lze_)); const int lane_e = (int)__builtin_amdgcn_mbcnt_hi(~0u, __builtin_amdgcn_mbcnt_lo(~0u, lze_)), r32e = lane_e & 31, hie = lane_e >> 5;
  ATT_LAS float* lie = (ATT_LAS float*)(lds + NBUF * (SHM_V + SHM_K)) + wid * 64;
  if (hie == 0) lie[r32e] = l_reg;
  __syncthreads();
  float rli[16];
#pragma unroll
  for (int r = 0; r < 16; ++r) rli[r] = __builtin_amdgcn_rcpf(lie[crow(r, hie)]);
  constexpr int OST = 272;
  ATT_LAS char* ost = lds + wid * (QBLK * OST);
#pragma unroll
  for (int r = 0; r < 16; r += 2)
#pragma unroll
    for (int d0 = 0; d0 < 4; ++d0) { const unsigned w = cvtpk(o[d0][r] * rli[r], o[d0][r + 1] * rli[r + 1]);
      *(ATT_LAS unsigned short*)(ost + crow(r, hie) * OST + (d0 * 32 + r32e) * 2) = (unsigned short)w;
      *(ATT_LAS unsigned short*)(ost + crow(r + 1, hie) * OST + (d0 * 32 + r32e) * 2) = (unsigned short)(w >> 16); }
  asm volatile("s_waitcnt lgkmcnt(0)" ::: "memory");
  ATT_GAS bf16_t* Ow = (ATT_GAS bf16_t*)u.O + (size_t)(wid * QBLK) * LDO;
#pragma unroll
  for (int i = 0; i < 8; ++i) { const int row = 4 * i + (lane_e >> 4), ch = lane_e & 15;
    const u32x4 v = *(const ATT_LAS u32x4*)(ost + row * OST + ch * 16);
    *(ATT_GAS u32x4*)(Ow + (size_t)row * LDO + ch * 8) = v; }
  return pf;
#undef SLOAD
#undef SLOADU
#undef SLOADN
#undef QLOAD
#undef SWRITE
#undef SWAIT
#undef RESC
#undef MASKT
#undef PK
#undef PVM
#undef PVM0
#undef TIE4
#undef PVR
#undef BLOCK2
}
}
constexpr int NWAVES = 8;
constexpr int DM = 2048, DEPTH = 4, M_CTX = 4096, M_LAT = 32768, M_ALL = 36864, IN_W = 3584, FF = 5632, NGU = 11264, NMODROW = 9, MODW = 12288;
constexpr int COL_QA = 0, COL_KA = 512, COL_VA = 768, COL_QB = 1024, COL_KB = 2048, COL_VB = 2304, COL_CV = 2560, COL_CG = 3072;
constexpr int MIX_OA = 0, MIX_OB = 512, MIX_OC = 1536;
constexpr int CONV_W = 31, C_CH = 512;
constexpr float EPS = 1e-6f;
constexpr size_t MiB = 1u << 20;
constexpr size_t WS_CTL = 0, CTL_ZERO_BYTES = 1 * MiB;
constexpr size_t WS_MOD = 1 * MiB;
constexpr size_t WS_GAINS = 3 * MiB - 65536;
constexpr size_t WS_ROPE = 3 * MiB;
constexpr size_t WS_WIN = 6 * MiB;
constexpr size_t WS_WOUT = 62 * MiB;
constexpr size_t WS_WGU = 94 * MiB;
constexpr size_t WS_WDN = 270 * MiB;
constexpr size_t WS_CACHE = 358 * MiB;
constexpr size_t WS_H = 374 * MiB;
constexpr size_t WS_Z = 518 * MiB;
constexpr size_t WS_MIX = 770 * MiB;
constexpr size_t WS_ACT = WS_Z;
constexpr size_t WS_XB = 914 * MiB;
constexpr size_t WS_END = 1058 * MiB;
static_assert(WS_Z + (size_t)M_ALL * IN_W * 2 == WS_MIX && WS_MIX + (size_t)M_ALL * DM * 2 == WS_XB && WS_ACT + (size_t)M_ALL * FF * 2 == WS_XB && WS_XB + (size_t)M_ALL * DM * 2 == WS_END, "ws map");
static_assert(WS_WIN + (size_t)DEPTH * IN_W * DM * 2 == WS_WOUT && WS_WOUT + (size_t)DEPTH * DM * DM * 2 == WS_WGU && WS_WGU + (size_t)DEPTH * NGU * DM * 2 == WS_WDN && WS_WDN + (size_t)DEPTH * DM * FF * 2 == WS_CACHE, "ws map");
constexpr int CW_BAR = 4096;
constexpr size_t OUT_YP = 0, OUT_YS = 8388608, OUT_AK = 75497472, OUT_AV = 79691776, OUT_BK = 83886080, OUT_BV = 88080384, OUT_TOTAL = 92274688;
static_assert(pg8::EpiQKV::OFF_AK == OUT_AK && pg8::EpiQKV::OFF_AV == OUT_AV && pg8::EpiQKV::OFF_BK == OUT_BK && pg8::EpiQKV::OFF_BV == OUT_BV, "output map");
constexpr int RING_BYTES = 131072, LDSCTL_OFF = RING_BYTES, MISC_OFF = LDSCTL_OFF + 320, XCH_OFF = RING_BYTES + 2048  , LDS_BYTES = 147456;
static_assert(MISC_OFF + 128 <= XCH_OFF && XCH_OFF + 8192 <= LDS_BYTES, "LDS map");

typedef unsigned short bf16;
typedef unsigned v4u __attribute__((ext_vector_type(4)));
typedef unsigned v2u __attribute__((ext_vector_type(2)));
typedef float f32x4 __attribute__((ext_vector_type(4)));
typedef float f32x2 __attribute__((ext_vector_type(2)));
#define LDS_WAIT() asm volatile("s_waitcnt lgkmcnt(0)" ::: "memory")
__device__ __forceinline__ unsigned pk2(float lo, float hi) { unsigned r; asm volatile("v_cvt_pk_bf16_f32 %0, %1, %2" : "=v"(r) : "v"(lo), "v"(hi)); return r; }
__device__ __forceinline__ float bflo(unsigned w) { return __uint_as_float(w << 16); }
__device__ __forceinline__ float bfhi(unsigned w) { return __uint_as_float(w & 0xffff0000u); }
template <int CTRL> __device__ __forceinline__ float dpp_mov(float v) { return __uint_as_float((unsigned)__builtin_amdgcn_update_dpp(0, (int)__float_as_uint(v), CTRL, 0xf, 0xf, true)); }
__device__ __forceinline__ float xsum_rows(float v) {
    { auto r = __builtin_amdgcn_permlane16_swap(__float_as_uint(v), __float_as_uint(v), false, false); v = __uint_as_float(r[0]) + __uint_as_float(r[1]); }
    { auto r = __builtin_amdgcn_permlane32_swap(__float_as_uint(v), __float_as_uint(v), false, false); v = __uint_as_float(r[0]) + __uint_as_float(r[1]); }
    return v;
}
__device__ __forceinline__ float wave_sum(float v) {
    v += dpp_mov<0xB1>(v);
    v += dpp_mov<0x4E>(v);
    v += dpp_mov<0x141>(v);
    v += dpp_mov<0x140>(v);
    return xsum_rows(v);
}

struct Args { const float* in[26]; float* out; unsigned char* ws; };
enum { I_XP = 0, I_XS, I_CAK, I_CAV, I_CBK, I_CBV, I_C, I_CCTX, I_WADA, I_BADA, I_WIN, I_WOUT, I_WGATE, I_WUP, I_WDOWN, I_N1G, I_N2G, I_QGA, I_KGA, I_QGB, I_KGB, I_SINK, I_CONVW, I_CONVB, I_CLNG, I_CLNB };

__device__ __forceinline__ int win_row(int c) {
    if (c >= 2560) { const int gate = c >= 3072, f = c - (gate ? 3072 : 2560); return 2560 + 256 * (f >> 7) + 128 * gate + (f & 127); }
    if ((c >= 768 && c < 1024) || c >= 2304) return c;
    const int f = c & 127, n = f >> 6, r = f & 63;
    return (c & ~127) + 32 * (r >> 4) + 8 * ((r >> 2) & 3) + 4 * n + (r & 3);
}
__device__ __forceinline__ void p0_transpose_item(const float* W, int K, int N, bf16* WT, int mode, LAS float* scr, int item, int lane) {
    const int nblk = N / 32, kb = item / nblk, nb = item % nblk, k0 = 64 * kb, n0 = 32 * nb;
    const int drow0 = mode == 0 ? n0 : 256 * (n0 >> 7) + (n0 & 127) + (mode == 2 ? 128 : 0);
    float wv[32];
#pragma unroll
    for (int i = 0; i < 32; ++i) { const int kk = 2 * i + (lane >> 5); wv[i] = W[(size_t)(k0 + kk) * N + n0 + (lane & 31)]; }
#pragma unroll
    for (int i = 0; i < 32; ++i) { const int kk = 2 * i + (lane >> 5); scr[kk * 33 + (lane & 31)] = wv[i]; }
    LDS_WAIT(); asm volatile("" ::: "memory");
    const int c = lane & 7;
#pragma unroll
    for (int j = 0; j < 4; ++j) { const int n = (lane >> 3) + 8 * j; const LAS float* s = scr + (8 * c) * 33 + n;
        v4u o; o.x = pk2(s[0 * 33], s[1 * 33]); o.y = pk2(s[2 * 33], s[3 * 33]); o.z = pk2(s[4 * 33], s[5 * 33]); o.w = pk2(s[6 * 33], s[7 * 33]);
        *(v4u*)(WT + (size_t)(mode == 3 ? win_row(n0 + n) : drow0 + n) * K + k0 + 8 * c) = o; }
    LDS_WAIT(); asm volatile("" ::: "memory");
}
constexpr int CV_A = 32 * 112, CV_B = 32 * 64, CV_C = 32 * 176, CV_D = 88 * 64, CV_PER_L = CV_A + CV_B + 2 * CV_C + CV_D;
__device__ __forceinline__ void convert_layer_items(const Args& a, int l, int lo, int hi, int gwl, int NGWL, LAS float* scr, int lane) {
    unsigned char* ws = a.ws;
    for (int it = lo + gwl; it < hi; it += NGWL) {
        int r = it;
        if (r < CV_A) { p0_transpose_item(a.in[I_WIN] + (size_t)l * DM * IN_W, DM, IN_W, (bf16*)(ws + WS_WIN) + (size_t)l * IN_W * DM, 3, scr, r, lane); continue; } r -= CV_A;
        if (r < CV_B) { p0_transpose_item(a.in[I_WOUT] + (size_t)l * DM * DM, DM, DM, (bf16*)(ws + WS_WOUT) + (size_t)l * DM * DM, 0, scr, r, lane); continue; } r -= CV_B;
        if (r < CV_C) { p0_transpose_item(a.in[I_WGATE] + (size_t)l * DM * FF, DM, FF, (bf16*)(ws + WS_WGU) + (size_t)l * NGU * DM, 1, scr, r, lane); continue; } r -= CV_C;
        if (r < CV_C) { p0_transpose_item(a.in[I_WUP] + (size_t)l * DM * FF, DM, FF, (bf16*)(ws + WS_WGU) + (size_t)l * NGU * DM, 2, scr, r, lane); continue; } r -= CV_C;
        p0_transpose_item(a.in[I_WDOWN] + (size_t)l * FF * DM, FF, DM, (bf16*)(ws + WS_WDN) + (size_t)l * DM * FF, 0, scr, r, lane);
    }
}
__device__ __forceinline__ void convert_in_tail(const Args& a, int l_next, int lo, int hi, int nunits, LAS unsigned char* lds, int G, const int wave_u) {
    unsigned lz_ = 0u; asm volatile("" : "+v"(lz_)); int lane_l = (int)__builtin_amdgcn_mbcnt_hi(~0u, __builtin_amdgcn_mbcnt_lo(~0u, lz_));
    const int rem = nunits % G, first = rem, nconv = G - rem;
    if ((int)blockIdx.x >= first) convert_layer_items(a, l_next, lo, hi, ((int)blockIdx.x - first) * NWAVES + wave_u, nconv * NWAVES, (LAS float*)(lds + wave_u * 8448), lane_l);
}
__device__ __forceinline__ void p0_prologue(const Args& a, LAS unsigned char* lds, int G, const int wave_u) {
    unsigned lz_ = 0u; asm volatile("" : "+v"(lz_)); int lane_l = (int)__builtin_amdgcn_mbcnt_hi(~0u, __builtin_amdgcn_mbcnt_lo(~0u, lz_)); const int lane = lane_l, wave = wave_u, tid = wave_u * 64 + lane_l; (void)tid; (void)lane; (void)wave;
    unsigned char* ws = a.ws;
    if ((int)blockIdx.x < DEPTH * 48) {
        LAS float* sl = (LAS float*)lds;
        LAS float* red = (LAS float*)(lds + 73728);
        for (int i = tid; i < NMODROW * DM; i += NWAVES * 64) { const int mb = i >> 11, k = i & 2047; const float x = mb == 0 ? a.in[I_CCTX][k] : a.in[I_C][(mb - 1) * DM + k]; sl[i] = x / (1.0f + expf(-x)); }
        __syncthreads();
        float* mod = (float*)(ws + WS_MOD);
        for (int item = blockIdx.x; item < DEPTH * 48; item += G) {
            const int l = item / 48, cb = item % 48;
            const float* W = a.in[I_WADA] + (size_t)l * DM * MODW + cb * 256 + 4 * lane;
            f32x4 acc[NMODROW];
#pragma unroll
            for (int mb = 0; mb < NMODROW; ++mb) acc[mb] = (f32x4){0.f, 0.f, 0.f, 0.f};
            const int k0 = wave * 256;
            for (int kb = 0; kb < 256; kb += 16) { f32x4 w[16];
#pragma unroll
                for (int q = 0; q < 16; ++q) w[q] = *(const f32x4*)(W + (size_t)(k0 + kb + q) * MODW);
#pragma unroll
                for (int q = 0; q < 16; ++q)
#pragma unroll
                    for (int mb = 0; mb < NMODROW; ++mb) { const float s = sl[mb * DM + k0 + kb + q]; acc[mb] += w[q] * s; } }
#pragma unroll
            for (int pass = 0; pass < 2; ++pass) { const int m0 = pass * 5, nm = pass ? 4 : 5;
#pragma unroll
                for (int mm = 0; mm < 5; ++mm) if (mm < nm) *(LAS f32x4*)(red + ((wave * 5 + mm) * 256 + 4 * lane)) = acc[m0 + mm];
                __syncthreads();
                for (int t = tid; t < nm * 256; t += NWAVES * 64) { const int mm = t >> 8, cc = t & 255; float s = a.in[I_BADA][l * MODW + cb * 256 + cc];
#pragma unroll
                    for (int w8 = 0; w8 < NWAVES; ++w8) s += red[(w8 * 5 + mm) * 256 + cc];
                    mod[(size_t)(l * NMODROW + m0 + mm) * MODW + cb * 256 + cc] = s; }
                __syncthreads(); }
        }
    }
    __syncthreads();
    convert_layer_items(a, 0, 0, CV_PER_L, blockIdx.x * NWAVES + wave, G * NWAVES, (LAS float*)(lds + wave * 8448), lane);
    {
        const size_t gt = (size_t)blockIdx.x * (NWAVES * 64) + tid, NT = (size_t)G * (NWAVES * 64);
        constexpr size_t PER = 2097152 / 8;
        for (size_t i = gt; i < 4 * PER; i += NT) { const int which = (int)(i / PER); const size_t j = i % PER;
            const float* src = a.in[I_CAK + which] + j * 8; const f32x4 x0 = *(const f32x4*)src, x1 = *(const f32x4*)(src + 4);
            v4u o; o.x = pk2(x0[0], x0[1]); o.y = pk2(x0[2], x0[3]); o.z = pk2(x1[0], x1[1]); o.w = pk2(x1[2], x1[3]);
            *(v4u*)((bf16*)(ws + WS_CACHE) + (size_t)which * 2097152 + j * 8) = o; }
        for (size_t i = gt; i < DEPTH * 512; i += NT) { const int l = (int)(i >> 9), ty = (int)(i >> 7) & 3, d = (int)(i & 127); ((float*)(ws + WS_GAINS))[i] = a.in[I_QGA + ty][l * 128 + d] * ((ty & 1) ? 1.0f : att::QSCALE); }
    }
}

__device__ __forceinline__ void norm_mod_phase(const float* xc, const float* xl, const bf16* xb  , const float* g, const float* modl, int sh_idx, int sc_idx, bf16* H, int G, const int wave_u) {
    unsigned lz_ = 0u; asm volatile("" : "+v"(lz_)); int lane_l = (int)__builtin_amdgcn_mbcnt_hi(~0u, __builtin_amdgcn_mbcnt_lo(~0u, lz_)); const int lane = lane_l, wave = wave_u, tid = wave_u * 64 + lane_l; (void)tid; (void)lane; (void)wave;
    const int gw = blockIdx.x * NWAVES + wave, NGW = G * NWAVES;
    float A[32], S[32];
    for (int base = gw * 18; base < M_ALL; base += NGW * 18) {
        int cur = -1;
        for (int r = base; r < base + 18; ++r) {
            const int mb = r < M_CTX ? 0 : 1 + ((r - M_CTX) >> 12);
            if (mb != cur) { cur = mb;
                const float* scp = modl + (size_t)mb * MODW + sc_idx * DM; const float* shp = modl + (size_t)mb * MODW + sh_idx * DM;
#pragma unroll
                for (int j = 0; j < 4; ++j)
#pragma unroll
                    for (int h = 0; h < 2; ++h) { const int c = 512 * j + 8 * lane + 4 * h; const f32x4 gv = *(const f32x4*)(g + c), sv = *(const f32x4*)(scp + c), hv = *(const f32x4*)(shp + c);
#pragma unroll
                        for (int e = 0; e < 4; ++e) { A[j * 8 + h * 4 + e] = gv[e] * (1.0f + sv[e]); S[j * 8 + h * 4 + e] = hv[e]; } } }
            f32x4 v[8]; float ss = 0.f;
            if (xb) { const bf16* xr = xb + (size_t)r * DM + 8 * lane; v4u w[4];
#pragma unroll
                for (int j = 0; j < 4; ++j) w[j] = *(const v4u*)(xr + 512 * j);
#pragma unroll
                for (int j = 0; j < 4; ++j) { v[2 * j] = (f32x4){bflo(w[j].x), bfhi(w[j].x), bflo(w[j].y), bfhi(w[j].y)}; v[2 * j + 1] = (f32x4){bflo(w[j].z), bfhi(w[j].z), bflo(w[j].w), bfhi(w[j].w)}; } }
            else { const float* xr = (r < M_CTX ? xc : xl) + (size_t)r * DM + 8 * lane;
#pragma unroll
                for (int j = 0; j < 4; ++j) { v[2 * j] = *(const f32x4*)(xr + 512 * j); v[2 * j + 1] = *(const f32x4*)(xr + 512 * j + 4); } }
#pragma unroll
            for (int q = 0; q < 8; ++q) ss += (v[q][0] * v[q][0] + v[q][1] * v[q][1]) + (v[q][2] * v[q][2] + v[q][3] * v[q][3]);
            const float rstd = __builtin_amdgcn_rsqf(wave_sum(ss) * (1.0f / DM) + EPS);
            bf16* hr = H + (size_t)r * DM + 8 * lane;
#pragma unroll
            for (int j = 0; j < 4; ++j) { float y[8];
#pragma unroll
                for (int e = 0; e < 8; ++e) y[e] = v[2 * j + (e >> 2)][e & 3] * rstd * A[j * 8 + e] + S[j * 8 + e];
                v4u o; o.x = pk2(y[0], y[1]); o.y = pk2(y[2], y[3]); o.z = pk2(y[4], y[5]); o.w = pk2(y[6], y[7]);
                *(v4u*)(hr + 512 * j) = o; }
        }
    }
}

struct QkvRaw { v4u w1[3], w2[3], wv, wg; f32x4 ca, cb, sa, sb; };
template <bool CTX>
__device__ __forceinline__ void qkv_load(const Args& a, const bf16* Z, int r, int lane, QkvRaw& q) {
    const int hs = lane >> 3, i8 = lane & 7;
    const bf16* zr = Z + (size_t)r * IN_W;
#pragma unroll
    for (int it = 0; it < 3; ++it) { const int seg = it * 8 + hs; const bf16* p1 = zr + (seg < 20 ? seg : 0) * 128 + 8 * i8; q.w1[it] = *(const v4u*)p1; q.w2[it] = *(const v4u*)(p1 + 64); }
    q.wv = *(const v4u*)(zr + COL_CV + 8 * lane); q.wg = *(const v4u*)(zr + COL_CG + 8 * lane);
    if constexpr (!CTX) { const float* rc = (const float*)(a.ws + WS_ROPE); const float* rs = rc + 4096 * 64; const int t = (r - M_CTX) & 4095;
        q.ca = *(const f32x4*)(rc + t * 64 + 8 * i8); q.cb = *(const f32x4*)(rc + t * 64 + 8 * i8 + 4); q.sa = *(const f32x4*)(rs + t * 64 + 8 * i8); q.sb = *(const f32x4*)(rs + t * 64 + 8 * i8 + 4); }
}
template <bool CTX>
__device__ __forceinline__ void qkv_row(const Args& a, int l, const QkvRaw& q, bf16* Zo, int r, int lane, const float* qga, const float* kga, const float* qgb, const float* kgb) {
    const int hs = lane >> 3, i8 = lane & 7;
    bf16* zo = Zo + (size_t)r * IN_W;
    const v4u* w1 = q.w1; const v4u* w2 = q.w2; const v4u wv = q.wv, wg = q.wg;
    float cs[8], sn[8];
#pragma unroll
    for (int e = 0; e < 8; ++e) { cs[e] = 1.f; sn[e] = 0.f; }
    if constexpr (!CTX) {
#pragma unroll
        for (int e = 0; e < 4; ++e) { cs[e] = q.ca[e]; cs[4 + e] = q.cb[e]; sn[e] = q.sa[e]; sn[4 + e] = q.sb[e]; } }
#pragma unroll
    for (int it = 0; it < 3; ++it) {
        const int seg = it * 8 + hs;
        const bool active = (it < 2) || hs < 4;
        const bool isK = (it == 0) ? (hs == 4 || hs == 5) : (it == 2 ? hs < 2 : false);
        const bool isV = (it == 0) ? (hs >= 6) : (it == 2 ? (hs == 2 || hs == 3) : false);
        const float* gp = (it == 0) ? (hs < 4 ? qga : kga) : (it == 1 ? qgb : kgb);
        const unsigned u1[4] = {w1[it].x, w1[it].y, w1[it].z, w1[it].w}, u2[4] = {w2[it].x, w2[it].y, w2[it].z, w2[it].w};
        float x1[8], x2[8];
#pragma unroll
        for (int e = 0; e < 4; ++e) { x1[2 * e] = bflo(u1[e]); x1[2 * e + 1] = bfhi(u1[e]); x2[2 * e] = bflo(u2[e]); x2[2 * e + 1] = bfhi(u2[e]); }
        float ss = 0.f;
#pragma unroll
        for (int e = 0; e < 8; ++e) ss += x1[e] * x1[e] + x2[e] * x2[e];
        ss += dpp_mov<0xB1>(ss); ss += dpp_mov<0x4E>(ss); ss += dpp_mov<0x141>(ss);
        const float rstd = __builtin_amdgcn_rsqf(ss * (1.0f / 128.0f) + EPS);
        const f32x4 g1a = *(const f32x4*)(gp + 8 * i8), g1b = *(const f32x4*)(gp + 8 * i8 + 4), g2a = *(const f32x4*)(gp + 64 + 8 * i8), g2b = *(const f32x4*)(gp + 64 + 8 * i8 + 4);
        float y1[8], y2[8];
#pragma unroll
        for (int e = 0; e < 8; ++e) { const float ga = e < 4 ? g1a[e & 3] : g1b[e & 3], gb = e < 4 ? g2a[e & 3] : g2b[e & 3]; y1[e] = isV ? x1[e] : x1[e] * rstd * ga; y2[e] = isV ? x2[e] : x2[e] * rstd * gb; }
        if constexpr (CTX) {
            if (it != 1 && (isK || isV)) {
                const int b = r >> 8, s = r & 255, kv = hs & 1;
                float* op = a.out + (it == 0 ? (isV ? OUT_AV : OUT_AK) : (isV ? OUT_BV : OUT_BK)) + ((((size_t)b * DEPTH + l) * 256 + s) * 2 + kv) * 128 + 8 * i8;
                *(f32x4*)op = (f32x4){y1[0], y1[1], y1[2], y1[3]}; *(f32x4*)(op + 4) = (f32x4){y1[4], y1[5], y1[6], y1[7]};
                *(f32x4*)(op + 64) = (f32x4){y2[0], y2[1], y2[2], y2[3]}; *(f32x4*)(op + 68) = (f32x4){y2[4], y2[5], y2[6], y2[7]};
            }
        }
        if (active && !isV) {
            float o1[8], o2[8];
#pragma unroll
            for (int e = 0; e < 8; ++e) { o1[e] = y1[e] * cs[e] - y2[e] * sn[e]; o2[e] = y2[e] * cs[e] + y1[e] * sn[e]; }
            bf16* p1 = zo + seg * 128 + 8 * i8;
            *(v4u*)p1 = (v4u){pk2(o1[0], o1[1]), pk2(o1[2], o1[3]), pk2(o1[4], o1[5]), pk2(o1[6], o1[7])};
            *(v4u*)(p1 + 64) = (v4u){pk2(o2[0], o2[1]), pk2(o2[2], o2[3]), pk2(o2[4], o2[5]), pk2(o2[6], o2[7])};
        }
    }
    { const unsigned vv[4] = {wv.x, wv.y, wv.z, wv.w}, gg[4] = {wg.x, wg.y, wg.z, wg.w}; unsigned oo[4];
#pragma unroll
      for (int e = 0; e < 4; ++e) { const float g0 = bflo(gg[e]), g1 = bfhi(gg[e]);
          oo[e] = pk2(bflo(vv[e]) * __builtin_amdgcn_rcpf(1.0f + __expf(-g0)), bfhi(vv[e]) * __builtin_amdgcn_rcpf(1.0f + __expf(-g1))); }
      *(v4u*)(zo + COL_CV + 8 * lane) = (v4u){oo[0], oo[1], oo[2], oo[3]}; }
}
__device__ __forceinline__ void qkv_post_phase(const Args& a, int l, bf16* Z, bf16* Zo, int G, const int wave_u) {
    unsigned lz_ = 0u; asm volatile("" : "+v"(lz_)); int lane_l = (int)__builtin_amdgcn_mbcnt_hi(~0u, __builtin_amdgcn_mbcnt_lo(~0u, lz_)); const int lane = lane_l, wave = wave_u;
    const int gw = blockIdx.x * NWAVES + wave, NGW = G * NWAVES;
    const float* qga = a.in[I_QGA] + l * 128; const float* kga = a.in[I_KGA] + l * 128; const float* qgb = a.in[I_QGB] + l * 128; const float* kgb = a.in[I_KGB] + l * 128;
    { QkvRaw cur, nxt; int r = gw; if (r < M_CTX) qkv_load<true>(a, Z, r, lane, cur);
      for (; r < M_CTX; r += NGW) { const int rn = r + NGW; if (rn < M_CTX) qkv_load<true>(a, Z, rn, lane, nxt); qkv_row<true>(a, l, cur, Zo, r, lane, qga, kga, qgb, kgb); cur = nxt; } }
    { QkvRaw cur, nxt; int r = M_CTX + gw; if (r < M_ALL) qkv_load<false>(a, Z, r, lane, cur);
      for (; r < M_ALL; r += NGW) { const int rn = r + NGW; if (rn < M_ALL) qkv_load<false>(a, Z, rn, lane, nxt); qkv_row<false>(a, l, cur, Zo, r, lane, qga, kga, qgb, kgb); cur = nxt; } }
}

constexpr int DYN_CTX = 192, DYN_END = DYN_CTX + M_ALL / 64;
__device__ __forceinline__ void conv_phase(const Args& a, int l, const bf16* Z, bf16* MIX, LAS unsigned char* lds, unsigned* qctr, int first, const int wave_u) {
    if (first >= DYN_END) return;
    unsigned lz_ = 0u; asm volatile("" : "+v"(lz_)); int lane_l = (int)__builtin_amdgcn_mbcnt_hi(~0u, __builtin_amdgcn_mbcnt_lo(~0u, lz_)); const int lane = lane_l, wave = wave_u, tid = wave_u * 64 + lane_l; (void)tid; (void)lane; (void)wave;
    LAS float* cw = (LAS float*)lds;
    volatile LAS unsigned* qslot = (volatile LAS unsigned*)(lds + MISC_OFF + 80);
    for (int i = tid; i < CONV_W * C_CH; i += NWAVES * 64) cw[i] = a.in[I_CONVW][(size_t)l * CONV_W * C_CH + i];
    __syncthreads();
    float cb[8], lg[8], lb[8];
    { const float* p = a.in[I_CONVB] + l * C_CH + 8 * lane; const float* q = a.in[I_CLNG] + l * C_CH + 8 * lane; const float* s = a.in[I_CLNB] + l * C_CH + 8 * lane;
#pragma unroll
      for (int e = 0; e < 8; ++e) { cb[e] = p[e]; lg[e] = q[e]; lb[e] = s[e]; } }
    int sl = 0;
    for (int cur = first; cur < DYN_END; ) {
        unsigned pulled = 0u; if (tid == 0) pulled = atomicAdd(qctr, 1u);
        const int item = (cur - DYN_CTX) * NWAVES + wave;
        {

        const int R0 = item * 8;
        const int s0 = R0 < M_CTX ? (R0 & ~255) : M_CTX + ((R0 - M_CTX) & ~4095), s1 = s0 + (R0 < M_CTX ? 256 : 4096);
        f32x2 acc[8][4];
#pragma unroll
        for (int i = 0; i < 8; ++i)
#pragma unroll
            for (int e = 0; e < 4; ++e) acc[i][e] = (f32x2){cb[2 * e], cb[2 * e + 1]};
        v4u raw[2][8];
#define CV_LOADB(b_, buf_) do { _Pragma("unroll") for (int q = 0; q < 8; ++q) { const int p = 8 * (b_) + q; if (p > 37) continue; const int row = R0 - 15 + p; const bool ok = row >= s0 && row < s1; const int rowc = ok ? row : R0; \
            raw[buf_][q] = *(const v4u*)(Z + (size_t)rowc * IN_W + COL_CV + 8 * lane); if (!ok) raw[buf_][q] = (v4u){0u, 0u, 0u, 0u}; } } while (0)
#define CV_WA(j_) (*(const LAS f32x4*)(cw + (j_) * C_CH + 8 * lane))
#define CV_WB(j_) (*(const LAS f32x4*)(cw + (j_) * C_CH + 8 * lane + 4))
#define CV_COMP(b_, buf_) do { f32x2 U[8][4]; \
            _Pragma("unroll") for (int q = 0; q < 8; ++q) { if (8 * (b_) + q > 37) continue; const v4u w = raw[buf_][q]; \
                U[q][0] = (f32x2){bflo(w.x), bfhi(w.x)}; U[q][1] = (f32x2){bflo(w.y), bfhi(w.y)}; U[q][2] = (f32x2){bflo(w.z), bfhi(w.z)}; U[q][3] = (f32x2){bflo(w.w), bfhi(w.w)}; } \
            constexpr int jlo_ = 8 * (b_) - 7 < 0 ? 0 : 8 * (b_) - 7, jhi_ = 8 * (b_) + 7 >= CONV_W ? CONV_W - 1 : 8 * (b_) + 7; \
            f32x4 wan_ = CV_WA(jlo_), wbn_ = CV_WB(jlo_);         \
            _Pragma("unroll") for (int jj = 0; jj < 15; ++jj) { const int j = 8 * (b_) - 7 + jj; if (j < jlo_ || j > jhi_) continue; \
                const f32x4 wa = wan_, wb = wbn_; if (j + 1 <= jhi_) { wan_ = CV_WA(j + 1); wbn_ = CV_WB(j + 1); } __builtin_amdgcn_sched_barrier(0); \
                const f32x2 w2[4] = {(f32x2){wa[0], wa[1]}, (f32x2){wa[2], wa[3]}, (f32x2){wb[0], wb[1]}, (f32x2){wb[2], wb[3]}}; \
                _Pragma("unroll") for (int i = 0; i < 8; ++i) { const int p = j + i, q = p - 8 * (b_); if (q < 0 || q >= 8 || p > 37) continue; \
                    _Pragma("unroll") for (int e = 0; e < 4; ++e) acc[i][e] = __builtin_elementwise_fma(U[q][e], w2[e], acc[i][e]); } \
                __builtin_amdgcn_sched_barrier(0); } } while (0)
#define CV_SB() __builtin_amdgcn_sched_barrier(0)
        CV_LOADB(0, 0); CV_SB();
        CV_LOADB(1, 1); CV_SB(); CV_COMP(0, 0); CV_SB();
        CV_LOADB(2, 0); CV_SB(); CV_COMP(1, 1); CV_SB();
        CV_LOADB(3, 1); CV_SB(); CV_COMP(2, 0); CV_SB();
        CV_LOADB(4, 0); CV_SB(); CV_COMP(3, 1); CV_SB();
        CV_COMP(4, 0); CV_SB();
#undef CV_SB
#undef CV_LOADB
#undef CV_COMP
#undef CV_WA
#undef CV_WB
#pragma unroll
        for (int i = 0; i < 8; ++i) {
            float av[8];
#pragma unroll
            for (int e = 0; e < 4; ++e) { av[2 * e] = acc[i][e].x; av[2 * e + 1] = acc[i][e].y; }
            float s = 0.f;
#pragma unroll
            for (int e = 0; e < 8; ++e) s += av[e];
            const float mean = wave_sum(s) * (1.0f / C_CH); float q = 0.f;
#pragma unroll
            for (int e = 0; e < 8; ++e) { const float d = av[e] - mean; q += d * d; }
            const float rstd = __builtin_amdgcn_rsqf(wave_sum(q) * (1.0f / C_CH) + EPS);
            float y[8];
#pragma unroll
            for (int e = 0; e < 8; ++e) { const float t = (av[e] - mean) * rstd * lg[e] + lb[e]; y[e] = t * __builtin_amdgcn_rcpf(1.0f + __builtin_amdgcn_exp2f(t * -1.4426950408889634f)); }
            v4u o; o.x = pk2(y[0], y[1]); o.y = pk2(y[2], y[3]); o.z = pk2(y[4], y[5]); o.w = pk2(y[6], y[7]);
            *(v4u*)(MIX + (size_t)(R0 + i) * DM + MIX_OC + 8 * lane) = o;
        }
        }
        if (tid == 0) qslot[sl] = pulled;
        __syncthreads();
        cur = __builtin_amdgcn_readfirstlane((int)qslot[sl]); sl ^= 1;
    }
}

struct ADec {
    const bf16* Z; bf16* MIX; const bf16* cache; const float* sink; int l;
    __device__ __forceinline__ void operator()(const int L, att::AUnit& u) const {
        if (L < 1024) {
            const int x = L & 7, j = (L >> 3) & 31, i = L >> 8, pair = 2 * x + (i >> 1), uu = (i & 1) * 32 + j, b = pair >> 1, kvh = pair & 1, h = kvh * 4 + (uu >> 4), qb = uu & 15;
            const size_t row0 = (size_t)M_CTX + (size_t)b * 4096;
            u.Q = Z + (row0 + qb * 256) * IN_W + COL_QB + h * 128;
            u.K0 = cache + (size_t)2 * 2097152 + ((size_t)(b * DEPTH + l) * 256 * 2 + kvh) * 128; u.nt0 = 4;
            u.K1 = Z + row0 * IN_W + COL_KB + kvh * 128; u.nt1 = 64;
            u.O = MIX + (row0 + qb * 256) * DM + MIX_OB + h * 128;
            u.sink_l2 = -__builtin_inff(); u.mask = 0; u.qk0 = 0;
        } else if (L < 1536) {
            const int Lp = L - 1024, x = Lp & 7, j = (Lp >> 3) & 31, i = Lp >> 8, pair = 2 * x + i, b = pair >> 1, kvh = pair & 1, h = kvh * 2 + (j >> 4), qb = j & 15;
            const size_t row0 = (size_t)M_CTX + (size_t)b * 4096;
            const int q0 = qb * 256, ks = q0 - 128 < 0 ? 0 : q0 - 128, ke = q0 + 384 > 4096 ? 4096 : q0 + 384;
            u.Q = Z + (row0 + q0) * IN_W + COL_QA + h * 128;
            u.K0 = cache + ((size_t)(b * DEPTH + l) * 256 * 2 + kvh) * 128; u.nt0 = 4;
            u.K1 = Z + (row0 + ks) * IN_W + COL_KA + kvh * 128; u.nt1 = (ke - ks) / 64;
            u.O = MIX + (row0 + q0) * DM + MIX_OA + h * 128;
            u.sink_l2 = sink[h] * att::LOG2E; u.mask = 1; u.qk0 = q0 - ks;
        } else if (L < 1664) {
            const int Lp = L - 1536, b = Lp >> 3, h = Lp & 7, kvh = h >> 2; const size_t row0 = (size_t)b * 256;
            u.Q = Z + row0 * IN_W + COL_QB + h * 128;
            u.K1 = Z + row0 * IN_W + COL_KB + kvh * 128; u.nt1 = 4; u.K0 = u.K1; u.nt0 = 0;
            u.O = MIX + row0 * DM + MIX_OB + h * 128;
            u.sink_l2 = -__builtin_inff(); u.mask = 0; u.qk0 = 0;
        } else {
            const int Lp = L - 1664, b = Lp >> 2, h = Lp & 3, kvh = h >> 1; const size_t row0 = (size_t)b * 256;
            u.Q = Z + row0 * IN_W + COL_QA + h * 128;
            u.K1 = Z + row0 * IN_W + COL_KA + kvh * 128; u.nt1 = 4; u.K0 = u.K1; u.nt0 = 0;
            u.O = MIX + row0 * DM + MIX_OA + h * 128;
            u.sink_l2 = sink[h] * att::LOG2E; u.mask = 0; u.qk0 = 0;
        }
    }
};
__device__ __forceinline__ int attn_phase(const Args& a, int l, const bf16* Z, bf16* MIX, LAS unsigned char* lds, unsigned* qctr, int G, const int wave_u) {
    const ADec D{Z, MIX, (const bf16*)(a.ws + WS_CACHE), a.in[I_SINK] + l * 4, l};
    unsigned lz_ = 0u; asm volatile("" : "+v"(lz_)); const int tid = wave_u * 64 + (int)__builtin_amdgcn_mbcnt_hi(~0u, __builtin_amdgcn_mbcnt_lo(~0u, lz_));
    volatile LAS unsigned* qslot = (volatile LAS unsigned*)(lds + MISC_OFF + 80);
    int L = (int)blockIdx.x, sl = 0;
    if (L >= 1536) { if (tid == 0) qslot[0] = atomicAdd(qctr, 1u); __syncthreads(); const int v = __builtin_amdgcn_readfirstlane((int)qslot[0]); __syncthreads(); if (v >= DYN_CTX) return v; L = 1536 + v; }
    bool pre = false; att::bf16x8 qr[8]; att::AStage st[2];
    for (;;) {
        const int Ln = (L < 1536 && L + G < 1536) ? L + G : -1;
        att::AUnit u; D(L, u);
        pre = att::attn_unit(u, D, Ln, pre, qr, st, (ATT_LAS char*)lds, wave_u);
        if (Ln < 0 && tid == 0) qslot[sl] = atomicAdd(qctr, 1u);
        __syncthreads();
        if (Ln >= 0) { L = Ln; continue; }
        const int v = __builtin_amdgcn_readfirstlane((int)qslot[sl]); sl ^= 1;
        if (v >= DYN_CTX) return v;
        L = 1536 + v;
    }
}

#ifndef ALIGN_RESID
#define ALIGN_RESID true
#endif
#ifndef P8_REV
#define P8_REV false
#endif
#ifndef P7_WGM
#define P7_WGM 8
#endif
#ifndef P7_ALIGN
#define P7_ALIGN true
#endif
#ifndef P7_SP2
#define P7_SP2 true
#endif
#ifdef PROBE_DIL
#if PROBE_DIL == 1
#define DIL_NOW() ((unsigned long long)clock64())
#else
#define DIL_NOW() ((unsigned long long)wall_clock64())
#endif
#define DIL_BEGIN(ph) unsigned long long dil_t0_ = 0ull; if (l == 1 && blockIdx.x == 0 && wave_u == 0) dil_t0_ = DIL_NOW()
#define DIL_END(ph) do { if (l == 1 && blockIdx.x == 0 && wave_u == 0) { const unsigned long long d_ = DIL_NOW() - dil_t0_; *(LAS unsigned long long*)(lds + MISC_OFF + 64) = d_; } } while (0)
#ifndef DIL_PH
#define DIL_PH 8
#endif
#if DIL_PH == 8
#define DIL_BEGIN8() DIL_BEGIN(8)
#define DIL_END8() DIL_END(8)
#define DIL_BEGIN4() do { } while (0)
#define DIL_END4() do { } while (0)
#else
#define DIL_BEGIN4() DIL_BEGIN(4)
#define DIL_END4() DIL_END(4)
#define DIL_BEGIN8() do { } while (0)
#define DIL_END8() do { } while (0)
#endif
#else
#define DIL_BEGIN4() do { } while (0)
#define DIL_END4() do { } while (0)
#define DIL_BEGIN8() do { } while (0)
#define DIL_END8() do { } while (0)
#endif
#if defined(PROBE_DIL) && defined(DIL_IV)
#undef DIL_BEGIN4
#undef DIL_END4
#undef DIL_BEGIN8
#undef DIL_END8
#define DIL_BEGIN4() do { } while (0)
#define DIL_END4() do { } while (0)
#define DIL_BEGIN8() do { } while (0)
#define DIL_END8() do { } while (0)
#define DIL_MARK(k) do { if (l == 1 && blockIdx.x == 0 && wave_u == 0) { if ((k) == DIL_IV - 1) dil_tm = DIL_NOW(); if ((k) == DIL_IV) { const unsigned long long d_ = DIL_NOW() - dil_tm; *(LAS unsigned long long*)(lds + MISC_OFF + 64) = d_; } } } while (0)
#else
#define DIL_MARK(k) do { } while (0)
#endif
#ifndef PROBE_WGSTAT_THR
#define PROBE_WGSTAT_THR 80000
#endif
#define NREP2 2
#ifdef PROBE_P7X2
#define NREP_P7 NREP2
#else
#define NREP_P7 1
#endif
#ifdef PROBE_P4X2
#define NREP_P4 NREP2
#else
#define NREP_P4 1
#endif
#ifdef PROBE_P2X2
#define NREP_P2 NREP2
#else
#define NREP_P2 1
#endif
#ifdef PROBE_P5X2
#define NREP_P5 NREP2
#else
#define NREP_P5 1
#endif
#ifdef PROBE_P8X2
#define NREP_P8 NREP2
#else
#define NREP_P8 1
#endif
#ifdef PROBE_P3X2
#define NREP_P3 NREP2
#else
#define NREP_P3 1
#endif
#ifdef PROBE_CONVX2
#define NREP_CONV NREP2
#else
#define NREP_CONV 1
#endif
#ifdef PROBE_P0X2
#define NREP_P0 NREP2
#else
#define NREP_P0 NREP_TH
#endif
#ifdef PROBE_THINX2
#define NREP_TH NREP2
#else
#define NREP_TH 1
#endif
#ifndef PH_MASK
#define PH_MASK 0x3ff
#endif
#define PH(n) ((PH_MASK >> (n)) & 1)
__global__ void __launch_bounds__(NWAVES * 64, 2) fwd_kernel(Args args) {
    extern __shared__ __attribute__((aligned(16))) unsigned char lds_raw[];
    LAS unsigned char* lds = (LAS unsigned char*)lds_raw;
    const int tid = threadIdx.x, G = gridDim.x, wave_u = __builtin_amdgcn_readfirstlane(tid >> 6);
    unsigned char* ws = args.ws;
    for (int u = tid; u < (LDS_BYTES - LDSCTL_OFF) / 4; u += NWAVES * 64) ((LAS unsigned*)(lds + LDSCTL_OFF))[u] = 0u;
    __syncthreads();
    XcdBarrier bar = xcd_barrier_post((unsigned*)(ws + WS_CTL) + CW_BAR, (volatile LAS unsigned*)(lds + MISC_OFF) + 8);

    bf16* H = (bf16*)(ws + WS_H); bf16* Z = (bf16*)(ws + WS_Z); bf16* MIX = (bf16*)(ws + WS_MIX); bf16* ACT = (bf16*)(ws + WS_ACT); bf16* XB = (bf16*)(ws + WS_XB);
    float* out = args.out;

#if defined(PROBE_DIL) && defined(DIL_P0)
    if (blockIdx.x == 0 && wave_u == 0) *(LAS unsigned long long*)(lds + MISC_OFF + 72) = DIL_NOW();
#endif
    for (int rep = 0; rep < NREP_P0; ++rep) { if (rep) xcd_barrier(bar);
    if (PH(0)) p0_prologue(args, lds, G, wave_u); }
    xcd_barrier(bar);
#if defined(PROBE_DIL) && defined(DIL_P0)
    if (blockIdx.x == 0 && wave_u == 0) { asm volatile("s_waitcnt lgkmcnt(0)" ::: "memory"); *(LAS unsigned long long*)(lds + MISC_OFF + 64) = DIL_NOW() - *(LAS unsigned long long*)(lds + MISC_OFF + 72); }
#endif

#if defined(PROBE_DIL) && defined(DIL_IV)
    unsigned long long dil_tm = 0ull;
#endif
    for (int l = 0; l < DEPTH; ++l) {
        DIL_MARK(0);
        const float* modl = (const float*)(ws + WS_MOD) + (size_t)l * NMODROW * MODW;
        const float* xc = args.in[I_XP];
        const float* xl = args.in[I_XS] - (size_t)M_CTX * DM;
        for (int rep = 0; rep < NREP_TH; ++rep) { if (rep) xcd_barrier(bar);
        if (PH(1)) norm_mod_phase(xc, xl, l == 0 ? (const bf16*)nullptr : XB, args.in[I_N1G] + l * DM, modl, 0, 1, H, G, wave_u); }
        xcd_barrier(bar);
        DIL_MARK(1);
        if (PH(2)) { pg8::Gemm g{H, (const bf16*)(ws + WS_WIN) + (size_t)l * IN_W * DM, M_ALL, IN_W, DM}; pg8::StaticOrderC<M_ALL / 256, IN_W / 256> S; S.init(G, (int)blockIdx.x);
          pg8::EpiQKV E{Z, out, (const float*)(ws + WS_GAINS) + l * 512, l, (LAS float*)(lds + XCH_OFF)};
          for (int rep = 0; rep < NREP_P2; ++rep) { if (rep) xcd_barrier(bar); pg8::gemm_phase<pg8::EpiQKV, pg8::StaticOrderC<M_ALL / 256, IN_W / 256>, true, true>(lds, g, S, E, wave_u); }
#ifdef PROBE_P2NULL
          xcd_barrier(bar); { pg8::EpiNull En{(float*)(ws + WS_CTL + 49152)}; pg8::gemm_phase<pg8::EpiNull, pg8::StaticOrderC<M_ALL / 256, IN_W / 256>, PROBE_P2NULL == 1, true>(lds, g, S, En, wave_u); }
#endif
        }
        xcd_barrier(bar);
        DIL_MARK(2);
        DIL_BEGIN4();
#if defined(PROBE_WGSTAT) && (!defined(PROBE_WGSTAT_PH) || PROBE_WGSTAT_PH == 4)
        if (l == 1 && wave_u == 0) { *(LAS unsigned long long*)(lds + MISC_OFF + 72) = (unsigned long long)wall_clock64(); }
#endif
        for (int rep = 0; rep < NREP_P4; ++rep) { if (rep) xcd_barrier(bar);
#pragma nounroll
        for (int crep = 0; crep < NREP_CONV; ++crep)
        { unsigned* qctr = (unsigned*)(ws + WS_CTL + 32768) + l * 16;
          const int cfirst = attn_phase(args, l, Z, MIX, lds, qctr, G, wave_u);
          conv_phase(args, l, Z, MIX, lds, qctr, cfirst, wave_u); } }
        DIL_END4();
#if defined(PROBE_WGSTAT) && (!defined(PROBE_WGSTAT_PH) || PROBE_WGSTAT_PH == 4)
        if (l == 1 && wave_u == 0) { asm volatile("s_waitcnt lgkmcnt(0)" ::: "memory"); const unsigned long long d_ = (unsigned long long)wall_clock64() - *(LAS unsigned long long*)(lds + MISC_OFF + 72);
            unsigned lz2_ = 0u; asm volatile("" : "+v"(lz2_)); if (__builtin_amdgcn_mbcnt_hi(~0u, __builtin_amdgcn_mbcnt_lo(~0u, lz2_)) == 0) { unsigned long long* st_ = (unsigned long long*)(ws + WS_CTL + 65536);
                atomicMax(st_, (d_ << 16) | (unsigned long long)blockIdx.x); atomicMax(st_ + 1, ((0xffffffffull - d_) << 16) | (unsigned long long)blockIdx.x); if (d_ > (unsigned long long)PROBE_WGSTAT_THR) atomicAdd(st_ + 2, 1ull); } }
#endif
        xcd_barrier(bar);
        DIL_MARK(3);
        if (PH(6)) { pg8::Gemm g{MIX, (const bf16*)(ws + WS_WOUT) + (size_t)l * DM * DM, M_ALL, DM, DM}; pg8::StaticOrderC<M_ALL / 256, DM / 256> S; S.init(G, (int)blockIdx.x);
#pragma nounroll
          for (int rep = NREP_P5 - 1; rep >= 0; --rep) { pg8::EpiResidB E{xc, xl, XB, rep ? (bf16*)(ws + WS_END) : XB, out, modl + 2 * DM, l == 0 ? 0 : 1};
            pg8::gemm_phase<pg8::EpiResidB, pg8::StaticOrderC<M_ALL / 256, DM / 256>, ALIGN_RESID, true>(lds, g, S, E, wave_u); if (rep) xcd_barrier(bar); }
          if (l + 1 < DEPTH) convert_in_tail(args, l + 1, 0, CV_A + CV_B, (M_ALL / 256) * (DM / 256), lds, G, wave_u); }
        xcd_barrier(bar);
        DIL_MARK(4);
        for (int rep = 0; rep < NREP_TH; ++rep) { if (rep) xcd_barrier(bar);
        if (PH(7)) norm_mod_phase(xc, xl, XB, args.in[I_N2G] + l * DM, modl, 3, 4, H, G, wave_u); }
        xcd_barrier(bar);
        DIL_MARK(5);
        DIL_BEGIN8();
#if defined(PROBE_WGSTAT) && defined(PROBE_WGSTAT_PH) && PROBE_WGSTAT_PH == 8
        if (l == 1 && wave_u == 0) { *(LAS unsigned long long*)(lds + MISC_OFF + 72) = (unsigned long long)wall_clock64(); }
#endif
        if (PH(8)) { pg8::Gemm g{H, (const bf16*)(ws + WS_WGU) + (size_t)l * NGU * DM, M_ALL, NGU, DM}; pg8::StaticOrderC<M_ALL / 256, NGU / 256, P7_WGM> S; S.init(G, (int)blockIdx.x);
          pg8::EpiSwiGLU E{ACT, FF};
          for (int rep = 0; rep < NREP_P7; ++rep) { if (rep) xcd_barrier(bar); pg8::gemm_phase<pg8::EpiSwiGLU, pg8::StaticOrderC<M_ALL / 256, NGU / 256, P7_WGM>, P7_ALIGN, P7_SP2>(lds, g, S, E, wave_u); }

        }
        DIL_END8();
#if defined(PROBE_WGSTAT) && defined(PROBE_WGSTAT_PH) && PROBE_WGSTAT_PH == 8
        if (l == 1 && wave_u == 0) { asm volatile("s_waitcnt lgkmcnt(0)" ::: "memory"); const unsigned long long d_ = (unsigned long long)wall_clock64() - *(LAS unsigned long long*)(lds + MISC_OFF + 72);
            unsigned lz2_ = 0u; asm volatile("" : "+v"(lz2_)); if (__builtin_amdgcn_mbcnt_hi(~0u, __builtin_amdgcn_mbcnt_lo(~0u, lz2_)) == 0) { unsigned long long* st_ = (unsigned long long*)(ws + WS_CTL + 65536);
                atomicMax(st_, (d_ << 16) | (unsigned long long)blockIdx.x); atomicMax(st_ + 1, ((0xffffffffull - d_) << 16) | (unsigned long long)blockIdx.x); if (d_ > (unsigned long long)PROBE_WGSTAT_THR) atomicAdd(st_ + 2, 1ull); } }
#endif
        xcd_barrier(bar);
        DIL_MARK(6);
        if (PH(9)) { pg8::Gemm g{ACT, (const bf16*)(ws + WS_WDN) + (size_t)l * DM * FF, M_ALL, DM, FF}; pg8::StaticOrderC<M_ALL / 256, DM / 256, pg8::WGM, P8_REV> S; S.init(G, (int)blockIdx.x);
#pragma nounroll
          for (int rep = NREP_P8 - 1; rep >= 0; --rep) { pg8::EpiResidB E{xc, xl, XB, rep ? (bf16*)(ws + WS_END) : XB, rep ? (float*)(ws + WS_END) : out, modl + 5 * DM, l + 1 < DEPTH ? 1 : 2};
            pg8::gemm_phase<pg8::EpiResidB, pg8::StaticOrderC<M_ALL / 256, DM / 256, pg8::WGM, P8_REV>, ALIGN_RESID, true>(lds, g, S, E, wave_u); if (rep) xcd_barrier(bar); }
          if (l + 1 < DEPTH) convert_in_tail(args, l + 1, CV_A + CV_B, CV_PER_L, (M_ALL / 256) * (DM / 256), lds, G, wave_u); }
        if (l + 1 < DEPTH) xcd_barrier(bar);
        DIL_MARK(7);
    }
#ifdef PROBE_WGSTAT
    if (blockIdx.x == 0 && wave_u == 0) { const unsigned long long* st_ = (const unsigned long long*)(ws + WS_CTL + 65536);
        const unsigned long long mx_ = __atomic_load_n(st_, __ATOMIC_RELAXED), mi_ = __atomic_load_n(st_ + 1, __ATOMIC_RELAXED), mn_ = ((0xffffffffull - (mi_ >> 16)) << 16) | (mi_ & 0xffffull), cnt_ = __atomic_load_n(st_ + 2, __ATOMIC_RELAXED);
        unsigned long long ticks = 0;
        if (PROBE_WGSTAT == 1) ticks = (mx_ >> 16) * 4ull;
        else if (PROBE_WGSTAT == 2) ticks = (mx_ & 0xffffull) * 1000ull;
        else if (PROBE_WGSTAT == 3) ticks = cnt_ * 1000ull;
        else if (PROBE_WGSTAT == 4) ticks = (mn_ >> 16) * 4ull;
        else ticks = (mn_ & 0xffffull) * 1000ull;
        const unsigned long long t0 = wall_clock64(); while ((unsigned long long)wall_clock64() - t0 < ticks) __builtin_amdgcn_s_sleep(32); }
#endif
#ifdef PROBE_DIL
    if (blockIdx.x == 0 && wave_u == 0) { asm volatile("s_waitcnt lgkmcnt(0)" ::: "memory"); const unsigned long long d_ = *(LAS unsigned long long*)(lds + MISC_OFF + 64);
        const unsigned long long ticks = (PROBE_DIL == 1) ? d_ * 4ull / 24ull : d_ * 4ull;
        const unsigned long long t0 = wall_clock64(); while ((unsigned long long)wall_clock64() - t0 < ticks) __builtin_amdgcn_s_sleep(32); }
#endif
}

extern "C" void kernel_launch(void* const* d_in, const int* in_sizes, int n_in, void* d_out, int out_size, void* d_ws, size_t ws_size, hipStream_t stream) {
    static int grid = 0;
    if (grid == 0) {
        if (n_in != 26 || in_sizes[0] != M_CTX * DM || in_sizes[1] != M_LAT * DM || (size_t)out_size != OUT_TOTAL || ws_size < WS_END) {
            fprintf(stderr, "kernel_launch: shape mismatch: n_in %d in0 %d in1 %d out %d ws %zu (need >= %zu); nothing launched\n", n_in, n_in > 0 ? in_sizes[0] : -1, n_in > 1 ? in_sizes[1] : -1, out_size, ws_size, (size_t)WS_END); grid = -1; return; }
        int dev = 0, cus = 0, per_cu = 0;
        if (hipGetDevice(&dev) != hipSuccess || hipDeviceGetAttribute(&cus, hipDeviceAttributeMultiprocessorCount, dev) != hipSuccess) { fprintf(stderr, "kernel_launch: device query failed\n"); grid = -1; return; }
        if (hipFuncSetAttribute((const void*)fwd_kernel, hipFuncAttributeMaxDynamicSharedMemorySize, LDS_BYTES) != hipSuccess) { fprintf(stderr, "kernel_launch: hipFuncSetAttribute failed\n"); grid = -1; return; }
        if (hipOccupancyMaxActiveBlocksPerMultiprocessor(&per_cu, (const void*)fwd_kernel, NWAVES * 64, LDS_BYTES) != hipSuccess || per_cu < 1)
            fprintf(stderr, "kernel_launch: note: occupancy query reports %d workgroups per CU\n", per_cu);
        (void)hipGetLastError();
        grid = cus;
    }
    if (grid < 0) return;
    if (hipMemsetAsync((char*)d_ws + WS_CTL, 0, CTL_ZERO_BYTES, stream) != hipSuccess) { fprintf(stderr, "kernel_launch: memset failed\n"); return; }
    Args a{};
    for (int i = 0; i < 26; ++i) a.in[i] = (const float*)d_in[i];
    a.out = (float*)d_out; a.ws = (unsigned char*)d_ws;
    hipLaunchKernelGGL(fwd_kernel, dim3(grid), dim3(NWAVES * 64), LDS_BYTES, stream, a);
    const hipError_t le = hipPeekAtLastError();
    if (le != hipSuccess) fprintf(stderr, "kernel_launch: launch failed: %s\n", hipGetErrorName(le));
}
```
